# Optimizing an MI355X kernel written in HIP

```python
import jax, jax.numpy as jnp
from jax import lax
import numpy as np

D_MODEL = 2048
BATCH = 1
SEQ = 8192
DEPTH = 1

GMLP_WIDTH = 1024
GMLP_GROUPS = 8
GMLP_GROUP_DIM = GMLP_WIDTH // GMLP_GROUPS
CHUNK = 128
ATTN_HEADS = 8
HEAD_DIM = 128
ATTN_WIDTH = ATTN_HEADS * HEAD_DIM
Q_LORA_RANK = 512
IDX_HEADS = 16
IDX_HEAD_DIM = 64
IDX_ROPE_DIM = 32
INDEX_TOPK = 256
QUERY_BLOCK = 128
ROPE_THETA = 10000.0
FFN_HIDDEN = -(-8 * D_MODEL // (3 * 256)) * 256
N_MOD = 6
NORM_EPS = 1e-6

COL_UV = 0
COL_QLAT = COL_UV + 2 * GMLP_WIDTH
COL_K = COL_QLAT + Q_LORA_RANK
COL_V = COL_K + ATTN_WIDTH
COL_KIDX = COL_V + ATTN_WIDTH
COL_IDXW = COL_KIDX + IDX_HEAD_DIM
COL_GATE = COL_IDXW + IDX_HEADS
IN_COLS = COL_GATE + 2 * D_MODEL

kernel_name = "hybrid_gmlp_dsa_gated_block"


def rms_norm(x, g):
    xf = x.astype(jnp.float32)
    y = xf * lax.rsqrt(jnp.mean(xf * xf, axis=-1, keepdims=True) + NORM_EPS)
    return (y * g.astype(jnp.float32)).astype(x.dtype)


def layer_norm(x, g, b):
    xf = x.astype(jnp.float32)
    mu = jnp.mean(xf, axis=-1, keepdims=True)
    xc = xf - mu
    var = jnp.mean(xc * xc, axis=-1, keepdims=True)
    return (xc * lax.rsqrt(var + NORM_EPS) * g.astype(jnp.float32) + b.astype(jnp.float32)).astype(x.dtype)


def rope_tables(seq, dim):
    inv = 1.0 / (ROPE_THETA ** (jnp.arange(0, dim, 2, dtype=jnp.float32) / dim))
    ang = jnp.arange(seq, dtype=jnp.float32)[:, None] * inv[None, :]
    return jnp.cos(ang), jnp.sin(ang)


def apply_rope(x, cos, sin):
    xf = x.astype(jnp.float32)
    half = xf.shape[-1] // 2
    x1, x2 = xf[..., :half], xf[..., half:]
    c = cos[None, :, None, :]
    s = sin[None, :, None, :]
    return jnp.concatenate([x1 * c - x2 * s, x2 * c + x1 * s], axis=-1).astype(x.dtype)


def apply_partial_rope(x, cos, sin):
    return jnp.concatenate([apply_rope(x[..., :IDX_ROPE_DIM], cos, sin), x[..., IDX_ROPE_DIM:]], axis=-1)


def gmlp_spatial_gating(uv, ln_g, ln_b, w_s, b_s):
    B, S, _ = uv.shape
    z = jax.nn.gelu(uv)
    u, v = z[..., :GMLP_WIDTH], z[..., GMLP_WIDTH:]
    v = layer_norm(v, ln_g, ln_b)
    v = v.reshape(B, S // CHUNK, CHUNK, GMLP_GROUPS, GMLP_GROUP_DIM)
    causal = jnp.tril(jnp.ones((CHUNK, CHUNK), dtype=bool))
    w = jnp.where(causal[None], w_s, 0).astype(v.dtype)
    sv = jnp.einsum('gts,bcsgd->bctgd', w, v) + b_s.T.astype(v.dtype)[None, None, :, :, None]
    return u * sv.reshape(B, S, GMLP_WIDTH)


def dsa_attention(q, k, v, q_idx, k_idx, idx_w):
    B, S, H, Dh = q.shape
    topk = min(INDEX_TOPK, S // 4)
    n_blocks = S // QUERY_BLOCK
    key_pos = jnp.arange(S)
    scale = HEAD_DIM ** -0.5
    gather = jax.vmap(lambda kk, ii: kk[ii])

    def one_block(i):
        t0 = i * QUERY_BLOCK
        qb = lax.dynamic_slice_in_dim(q, t0, QUERY_BLOCK, axis=1)
        qib = lax.dynamic_slice_in_dim(q_idx, t0, QUERY_BLOCK, axis=1)
        wb = lax.dynamic_slice_in_dim(idx_w, t0, QUERY_BLOCK, axis=1)
        q_pos = t0 + jnp.arange(QUERY_BLOCK)
        causal = key_pos[None, :] <= q_pos[:, None]
        logits = jnp.einsum('bqhd,bsd->bqhs', qib, k_idx).astype(jnp.float32)
        score = jnp.einsum('bqhs,bqh->bqs', jax.nn.relu(logits), wb.astype(jnp.float32))
        score = jnp.where(causal[None], score, -jnp.inf)
        _, sel = lax.top_k(score, topk)
        valid = sel <= q_pos[None, :, None]
        k_sel = gather(k, sel)
        v_sel = gather(v, sel)
        att = jnp.einsum('bqhd,bqkhd->bhqk', qb, k_sel).astype(jnp.float32) * scale
        att = jnp.where(valid[:, None], att, -jnp.inf)
        p = jax.nn.softmax(att, axis=-1).astype(v.dtype)
        return jnp.einsum('bhqk,bqkhd->bqhd', p, v_sel)

    out = lax.map(one_block, jnp.arange(n_blocks))
    return out.transpose(1, 0, 2, 3, 4).reshape(B, S, H * Dh)


def setup_inputs(seed: int = 0) -> dict:
    key = jax.random.key(seed)
    ks = iter(jax.random.split(key, 32))
    f32 = jnp.float32

    def nrm(shape, scale):
        return jax.random.normal(next(ks), shape, f32) * scale

    def gain(shape):
        return 1.0 + 0.1 * jax.random.normal(next(ks), shape, f32)

    L = DEPTH
    return {
        "x": nrm((BATCH, SEQ, D_MODEL), 1.0),
        "c": nrm((BATCH, D_MODEL), 1.0),
        "w_mod": nrm((L, D_MODEL, N_MOD * D_MODEL), 0.5 * D_MODEL ** -0.5),
        "b_mod": nrm((L, N_MOD * D_MODEL), 0.01),
        "g_pre_mix": gain((L, D_MODEL)),
        "g_post_mix": gain((L, D_MODEL)),
        "w_in": nrm((L, D_MODEL, IN_COLS), D_MODEL ** -0.5),
        "gmlp_ln_g": gain((L, GMLP_WIDTH)),
        "gmlp_ln_b": nrm((L, GMLP_WIDTH), 0.02),
        "gmlp_w_s": nrm((L, GMLP_GROUPS, CHUNK, CHUNK), CHUNK ** -0.5),
        "gmlp_b_s": gain((L, GMLP_GROUPS, CHUNK)),
        "q_lat_norm_g": gain((L, Q_LORA_RANK)),
        "w_q_up": nrm((L, Q_LORA_RANK, ATTN_WIDTH), Q_LORA_RANK ** -0.5),
        "w_qidx_up": nrm((L, Q_LORA_RANK, IDX_HEADS * IDX_HEAD_DIM), Q_LORA_RANK ** -0.5),
        "kidx_ln_g": gain((L, IDX_HEAD_DIM)),
        "kidx_ln_b": nrm((L, IDX_HEAD_DIM), 0.02),
        "w_proj_a": nrm((L, GMLP_WIDTH, D_MODEL), GMLP_WIDTH ** -0.5),
        "w_proj_b": nrm((L, ATTN_WIDTH, D_MODEL), ATTN_WIDTH ** -0.5),
        "w_out": nrm((L, D_MODEL, D_MODEL), D_MODEL ** -0.5),
        "g_pre_ffn": gain((L, D_MODEL)),
        "g_post_ffn": gain((L, D_MODEL)),
        "w_ffn_gate": nrm((L, D_MODEL, FFN_HIDDEN), D_MODEL ** -0.5),
        "w_ffn_up": nrm((L, D_MODEL, FFN_HIDDEN), D_MODEL ** -0.5),
        "w_ffn_down": nrm((L, FFN_HIDDEN, D_MODEL), FFN_HIDDEN ** -0.5),
    }


def reference(x, c, w_mod, b_mod, g_pre_mix, g_post_mix, w_in, gmlp_ln_g, gmlp_ln_b, gmlp_w_s, gmlp_b_s,
              q_lat_norm_g, w_q_up, w_qidx_up, kidx_ln_g, kidx_ln_b, w_proj_a, w_proj_b, w_out,
              g_pre_ffn, g_post_ffn, w_ffn_gate, w_ffn_up, w_ffn_down):
    B, S, D = x.shape
    cos_a, sin_a = rope_tables(S, HEAD_DIM)
    cos_i, sin_i = rope_tables(S, IDX_ROPE_DIM)
    idx_w_scale = (IDX_HEADS ** -0.5) * (IDX_HEAD_DIM ** -0.5)

    for l in range(DEPTH):
        mod = (c @ w_mod[l] + b_mod[l]).reshape(B, N_MOD, D)
        shift_m, scale_m, gate_m = mod[:, 0, None], mod[:, 1, None], mod[:, 2, None]
        shift_f, scale_f, gate_f = mod[:, 3, None], mod[:, 4, None], mod[:, 5, None]

        h = rms_norm(x, g_pre_mix[l]) * (1 + scale_m) + shift_m
        proj = h @ w_in[l]

        y_a = gmlp_spatial_gating(proj[..., COL_UV:COL_QLAT], gmlp_ln_g[l], gmlp_ln_b[l],
                                  gmlp_w_s[l], gmlp_b_s[l])

        q_lat = rms_norm(proj[..., COL_QLAT:COL_K], q_lat_norm_g[l])
        q = apply_rope((q_lat @ w_q_up[l]).reshape(B, S, ATTN_HEADS, HEAD_DIM), cos_a, sin_a)
        k = apply_rope(proj[..., COL_K:COL_V].reshape(B, S, ATTN_HEADS, HEAD_DIM), cos_a, sin_a)
        v = proj[..., COL_V:COL_KIDX].reshape(B, S, ATTN_HEADS, HEAD_DIM)
        q_idx = apply_partial_rope((q_lat @ w_qidx_up[l]).reshape(B, S, IDX_HEADS, IDX_HEAD_DIM), cos_i, sin_i)
        k_idx = layer_norm(proj[..., COL_KIDX:COL_IDXW], kidx_ln_g[l], kidx_ln_b[l])
        k_idx = apply_partial_rope(k_idx[:, :, None, :], cos_i, sin_i)[:, :, 0, :]
        idx_w = proj[..., COL_IDXW:COL_GATE] * idx_w_scale
        y_b = dsa_attention(q, k, v, q_idx, k_idx, idx_w)

        gates = jax.nn.sigmoid(proj[..., COL_GATE:])
        merged = gates[..., :D] * (y_a @ w_proj_a[l]) + gates[..., D:] * (y_b @ w_proj_b[l])
        mix_out = merged @ w_out[l]
        x = x + gate_m * rms_norm(mix_out, g_post_mix[l])

        h2 = rms_norm(x, g_pre_ffn[l]) * (1 + scale_f) + shift_f
        f = (jax.nn.silu(h2 @ w_ffn_gate[l]) * (h2 @ w_ffn_up[l])) @ w_ffn_down[l]
        x = x + gate_f * rms_norm(f, g_post_ffn[l])

    return x
```

```cpp
#include <hip/hip_runtime.h>
#include <math.h>
#include <stdint.h>
#include <stdio.h>

namespace {
constexpr int S = 8192, D = 2048, GW = 1024, QL = 512, AW = 1024, NH = 8, HD = 128, IH = 16, IDH = 64, FF = 5632;
constexpr int COL_QLAT = 2048, COL_K = 2560, COL_V = 3584, COL_KIDX = 4608, COL_IDXW = 4672, COL_GATE = 4688, INC = 8784;
constexpr int TOPK = 256;
constexpr float EPS = 1e-6f;

__device__ __forceinline__ float wave_sum(float v) {
#pragma unroll
    for (int o = 1; o < 64; o <<= 1) v += __shfl_xor(v, o);
    return v;
}
__device__ __forceinline__ float wave_max(float v) {
#pragma unroll
    for (int o = 1; o < 64; o <<= 1) v = fmaxf(v, __shfl_xor(v, o));
    return v;
}
__device__ __forceinline__ float block_sum(float v, float* red) {
    v = wave_sum(v);
    __syncthreads();
    if ((threadIdx.x & 63) == 0) red[threadIdx.x >> 6] = v;
    __syncthreads();
    return (red[0] + red[1]) + (red[2] + red[3]);
}
__device__ __forceinline__ float gelu_tanh(float x) {
    const float u = 0.7978845608028654f * (x + 0.044715f * x * x * x);
    return 0.5f * x * (1.f + tanhf(u));
}
__device__ __forceinline__ float sigmoidf_(float x) { return 1.f / (1.f + expf(-x)); }

__global__ void __launch_bounds__(256) k_mod_partial(const float* __restrict__ c, const float* __restrict__ w, float* __restrict__ part) {
    const int n = blockIdx.x * 256 + threadIdx.x, kc = blockIdx.y;
    float acc = 0.f;
    for (int k = kc * 128; k < kc * 128 + 128; ++k) acc += c[k] * w[(size_t)k * (6 * D) + n];
    part[(size_t)kc * (6 * D) + n] = acc;
}
__global__ void __launch_bounds__(256) k_mod_final(const float* __restrict__ part, const float* __restrict__ b, float* __restrict__ mod) {
    const int n = blockIdx.x * 256 + threadIdx.x;
    float acc = b[n];
    for (int kc = 0; kc < 16; ++kc) acc += part[(size_t)kc * (6 * D) + n];
    mod[n] = acc;
}
__global__ void k_rope_tables(float* cosA, float* sinA, float* cosI, float* sinI) {
    const int t = blockIdx.x, i = threadIdx.x;
    {
        const float inv = 1.0f / powf(10000.0f, (float)(2 * i) / 128.0f);
        const float ang = (float)t * inv;
        cosA[t * 64 + i] = (float)cos((double)ang); sinA[t * 64 + i] = (float)sin((double)ang);
    }
    if (i < 16) {
        const float inv = 1.0f / powf(10000.0f, (float)(2 * i) / 32.0f);
        const float ang = (float)t * inv;
        cosI[t * 16 + i] = (float)cos((double)ang); sinI[t * 16 + i] = (float)sin((double)ang);
    }
}
__global__ void __launch_bounds__(256) k_prenorm(const float* __restrict__ x, const float* __restrict__ g, const float* __restrict__ shift, const float* __restrict__ scale, float* __restrict__ out) {
    __shared__ float red[8];
    const int t = blockIdx.x, tid = threadIdx.x;
    const float* xr = x + (size_t)t * D;
    float v[8]; float ss = 0.f;
#pragma unroll
    for (int i = 0; i < 8; ++i) { v[i] = xr[tid + 256 * i]; ss += v[i] * v[i]; }
    ss = block_sum(ss, red);
    const float r = rsqrtf(ss / D + EPS);
#pragma unroll
    for (int i = 0; i < 8; ++i) { const int n = tid + 256 * i; out[(size_t)t * D + n] = v[i] * r * g[n] * (1.f + scale[n]) + shift[n]; }
}
template <int MODE>
__global__ void __launch_bounds__(256) k_sgemm(const float* __restrict__ A, int lda, const float* __restrict__ B, int ldb, float* C, int ldc, int N, int K, const float* __restrict__ G, int ldg) {
    __shared__ float As[16][128 + 4];
    __shared__ float Bs[16][128 + 4];
    const int tid = threadIdx.x, tx = tid & 15, ty = tid >> 4;
    const int m0 = blockIdx.y * 128, n0 = blockIdx.x * 128;
    float acc[8][8];
#pragma unroll
    for (int i = 0; i < 8; ++i)
#pragma unroll
        for (int j = 0; j < 8; ++j) acc[i][j] = 0.f;
    for (int k0 = 0; k0 < K; k0 += 16) {
#pragma unroll
        for (int i = 0; i < 2; ++i) {
            const int idx = tid + 256 * i, row = idx >> 2, c4 = idx & 3;
            const float4 a = *(const float4*)(A + (size_t)(m0 + row) * lda + k0 + c4 * 4);
            As[c4 * 4 + 0][row] = a.x; As[c4 * 4 + 1][row] = a.y; As[c4 * 4 + 2][row] = a.z; As[c4 * 4 + 3][row] = a.w;
        }
#pragma unroll
        for (int i = 0; i < 2; ++i) {
            const int idx = tid + 256 * i, kr = idx >> 5, c4 = idx & 31;
            float4 b = make_float4(0.f, 0.f, 0.f, 0.f);
            if (n0 + c4 * 4 < N) b = *(const float4*)(B + (size_t)(k0 + kr) * ldb + n0 + c4 * 4);
            *(float4*)&Bs[kr][c4 * 4] = b;
        }
        __syncthreads();
#pragma unroll
        for (int k = 0; k < 16; ++k) {
            float a[8], b[8];
            *(float4*)&a[0] = *(const float4*)&As[k][ty * 8]; *(float4*)&a[4] = *(const float4*)&As[k][ty * 8 + 4];
            *(float4*)&b[0] = *(const float4*)&Bs[k][tx * 8]; *(float4*)&b[4] = *(const float4*)&Bs[k][tx * 8 + 4];
#pragma unroll
            for (int i = 0; i < 8; ++i)
#pragma unroll
                for (int j = 0; j < 8; ++j) acc[i][j] += a[i] * b[j];
        }
        __syncthreads();
    }
#pragma unroll
    for (int i = 0; i < 8; ++i) {
        const int m = m0 + ty * 8 + i;
#pragma unroll
        for (int j4 = 0; j4 < 2; ++j4) {
            const int n = n0 + tx * 8 + j4 * 4;
            if (n < N) {
                float4 r = make_float4(acc[i][j4 * 4 + 0], acc[i][j4 * 4 + 1], acc[i][j4 * 4 + 2], acc[i][j4 * 4 + 3]);
                float* cp = C + (size_t)m * ldc + n;
                if (MODE == 1 || MODE == 2) {
                    const float4 g = *(const float4*)(G + (size_t)m * ldg + n);
                    r.x *= sigmoidf_(g.x); r.y *= sigmoidf_(g.y); r.z *= sigmoidf_(g.z); r.w *= sigmoidf_(g.w);
                    if (MODE == 2) { const float4 o = *(const float4*)cp; r.x += o.x; r.y += o.y; r.z += o.z; r.w += o.w; }
                }
                if (MODE == 3) {
                    const float4 o = *(const float4*)cp;
                    r.x *= o.x * sigmoidf_(o.x); r.y *= o.y * sigmoidf_(o.y); r.z *= o.z * sigmoidf_(o.z); r.w *= o.w * sigmoidf_(o.w);
                }
                *(float4*)cp = r;
            }
        }
    }
}
__global__ void __launch_bounds__(256) k_tok_post(float* proj, const float* __restrict__ ln_g, const float* __restrict__ ln_b, const float* __restrict__ qg,
                                                   const float* __restrict__ kg, const float* __restrict__ kb, const float* __restrict__ cosA, const float* __restrict__ sinA,
                                                   const float* __restrict__ cosI, const float* __restrict__ sinI) {
    __shared__ float red[8];
    __shared__ float kbuf[64];
    const int t = blockIdx.x, tid = threadIdx.x;
    float* row = proj + (size_t)t * INC;
#pragma unroll
    for (int i = 0; i < 4; ++i) { const int n = tid + 256 * i; row[n] = gelu_tanh(row[n]); }
    {
        float z[4]; float s = 0.f;
#pragma unroll
        for (int i = 0; i < 4; ++i) { z[i] = gelu_tanh(row[GW + tid + 256 * i]); s += z[i]; }
        const float mu = block_sum(s, red) / GW;
        float q = 0.f;
#pragma unroll
        for (int i = 0; i < 4; ++i) { z[i] -= mu; q += z[i] * z[i]; }
        const float r = rsqrtf(block_sum(q, red) / GW + EPS);
#pragma unroll
        for (int i = 0; i < 4; ++i) { const int n = tid + 256 * i; row[GW + n] = z[i] * r * ln_g[n] + ln_b[n]; }
    }
    {
        float z[2]; float s = 0.f;
#pragma unroll
        for (int i = 0; i < 2; ++i) { z[i] = row[COL_QLAT + tid + 256 * i]; s += z[i] * z[i]; }
        const float r = rsqrtf(block_sum(s, red) / QL + EPS);
#pragma unroll
        for (int i = 0; i < 2; ++i) { const int n = tid + 256 * i; row[COL_QLAT + n] = z[i] * r * qg[n]; }
    }
#pragma unroll
    for (int i = 0; i < 2; ++i) {
        const int p = tid + 256 * i, h = p >> 6, ii = p & 63;
        float* a = row + COL_K + h * HD + ii; float* b = a + 64;
        const float c = cosA[t * 64 + ii], s = sinA[t * 64 + ii];
        const float x1 = *a, x2 = *b;
        *a = x1 * c - x2 * s; *b = x2 * c + x1 * s;
    }
    if (tid < 64) {
        const float z = row[COL_KIDX + tid];
        const float mu = wave_sum(z) / 64.f;
        const float d = z - mu;
        const float r = rsqrtf(wave_sum(d * d) / 64.f + EPS);
        kbuf[tid] = d * r * kg[tid] + kb[tid];
    }
    __syncthreads();
    if (tid < 64) {
        float o;
        if (tid < 16) { o = kbuf[tid] * cosI[t * 16 + tid] - kbuf[tid + 16] * sinI[t * 16 + tid]; }
        else if (tid < 32) { const int i = tid - 16; o = kbuf[tid] * cosI[t * 16 + i] + kbuf[i] * sinI[t * 16 + i]; }
        else o = kbuf[tid];
        row[COL_KIDX + tid] = o;
    }
    if (tid < 16) row[COL_IDXW + tid] *= 0.03125f;
}
__global__ void __launch_bounds__(256) k_spatial(float* proj, const float* __restrict__ w_s, const float* __restrict__ b_s) {
    __shared__ float Vs[128][128];
    const int c = blockIdx.x, g = blockIdx.y, tid = threadIdx.x;
    for (int i = tid; i < 128 * 128; i += 256) { const int s = i >> 7, d = i & 127; Vs[s][d] = proj[(size_t)(c * 128 + s) * INC + GW + g * 128 + d]; }
    __syncthreads();
    const int d = tid & 127, th = tid >> 7;
    const float* W = w_s + (size_t)g * 128 * 128;
    for (int tt = 0; tt < 64; ++tt) {
        const int t = th * 64 + tt;
        float acc = 0.f;
        for (int s = 0; s <= t; ++s) acc += W[t * 128 + s] * Vs[s][d];
        float* up = proj + (size_t)(c * 128 + t) * INC + g * 128 + d;
        *up = *up * (acc + b_s[g * 128 + t]);
    }
}
__global__ void __launch_bounds__(256) k_rope_q(float* q, float* qi, const float* __restrict__ cosA, const float* __restrict__ sinA, const float* __restrict__ cosI, const float* __restrict__ sinI) {
    const int t = blockIdx.x, tid = threadIdx.x;
#pragma unroll
    for (int i = 0; i < 2; ++i) {
        const int p = tid + 256 * i, h = p >> 6, ii = p & 63;
        float* a = q + (size_t)t * AW + h * HD + ii; float* b = a + 64;
        const float c = cosA[t * 64 + ii], s = sinA[t * 64 + ii];
        const float x1 = *a, x2 = *b;
        *a = x1 * c - x2 * s; *b = x2 * c + x1 * s;
    }
    {
        const int h = tid >> 4, ii = tid & 15;
        float* a = qi + (size_t)t * 1024 + h * IDH + ii; float* b = a + 16;
        const float c = cosI[t * 16 + ii], s = sinI[t * 16 + ii];
        const float x1 = *a, x2 = *b;
        *a = x1 * c - x2 * s; *b = x2 * c + x1 * s;
    }
}
__device__ __forceinline__ unsigned f2key(float f) { const unsigned b = __float_as_uint(f); return b ^ ((b >> 31) ? 0xFFFFFFFFu : 0x80000000u); }
__global__ void __launch_bounds__(256) k_indexer(const float* __restrict__ qi, const float* __restrict__ proj, unsigned long long* __restrict__ mask) {
    __shared__ float qs[1024];
    __shared__ float ws[16];
    __shared__ unsigned keys[S];
    __shared__ unsigned cnt[2];
    const int t = blockIdx.x, tid = threadIdx.x, lane = tid & 63, wv = tid >> 6;
    for (int i = tid; i < 1024; i += 256) qs[i] = qi[(size_t)t * 1024 + i];
    if (tid < 16) ws[tid] = proj[(size_t)t * INC + COL_IDXW + tid];
    __syncthreads();
    const int nch = (t >> 8) + 1;
    for (int j = 0; j < nch; ++j) {
        const int s = tid + 256 * j;
        unsigned key = 0u;
        if (s <= t) {
            float kr[64];
            const float4* kp = (const float4*)(proj + (size_t)s * INC + COL_KIDX);
#pragma unroll
            for (int i = 0; i < 16; ++i) { const float4 v = kp[i]; kr[4 * i] = v.x; kr[4 * i + 1] = v.y; kr[4 * i + 2] = v.z; kr[4 * i + 3] = v.w; }
            float sc = 0.f;
            for (int h = 0; h < 16; ++h) {
                float dsum = 0.f;
#pragma unroll
                for (int i = 0; i < 64; ++i) dsum += qs[h * 64 + i] * kr[i];
                sc += ws[h] * fmaxf(dsum, 0.f);
            }
            sc += 0.0f;
            key = f2key(sc);
        }
        keys[s] = key;
    }
    __syncthreads();
    unsigned long long* mrow = mask + (size_t)t * 128;
    if (t < TOPK) {
        for (int j = 0; j < 32; ++j) {
            const int s = tid + 256 * j;
            const unsigned long long b = __ballot(s <= t);
            if (lane == 0) mrow[4 * j + wv] = b;
        }
        return;
    }
    unsigned T = 0u;
    for (int bit = 31; bit >= 0; --bit) {
        const unsigned cand = T | (1u << bit);
        if (tid == 0) cnt[bit & 1] = 0u;
        __syncthreads();
        int c = 0;
        for (int j = 0; j < nch; ++j) c += (keys[tid + 256 * j] >= cand) ? 1 : 0;
        c = (int)wave_sum((float)c);
        if (lane == 0) atomicAdd(&cnt[bit & 1], (unsigned)c);
        __syncthreads();
        if (cnt[bit & 1] >= (unsigned)TOPK) T = cand;
    }
    if (tid == 0) { cnt[0] = 0u; cnt[1] = 0u; }
    __syncthreads();
    {
        int cg = 0, ce = 0;
        for (int j = 0; j < nch; ++j) { const unsigned k = keys[tid + 256 * j]; cg += (k > T); ce += (k == T); }
        cg = (int)wave_sum((float)cg); ce = (int)wave_sum((float)ce);
        if (lane == 0) { atomicAdd(&cnt[0], (unsigned)cg); atomicAdd(&cnt[1], (unsigned)ce); }
    }
    __syncthreads();
    const int n_gt = (int)cnt[0], n_eq = (int)cnt[1], need = TOPK - n_gt;
    __syncthreads();
    if (n_eq > need) {
        if (tid == 0) {
            int surplus = n_eq - need;
            for (int s = t; s >= 0 && surplus > 0; --s) if (keys[s] == T) { keys[s] = 0u; --surplus; }
        }
        __syncthreads();
    }
    for (int j = 0; j < 32; ++j) {
        const int s = tid + 256 * j;
        const bool sel = (j < nch) && (keys[s] >= T) && (s <= t);
        const unsigned long long b = __ballot(sel);
        if (lane == 0) mrow[4 * j + wv] = b;
    }
}
__global__ void __launch_bounds__(256) k_attn(const float* __restrict__ q, const float* __restrict__ proj, const unsigned long long* __restrict__ mask, float* __restrict__ yb) {
    __shared__ float qs[1024];
    __shared__ int list[256];
    __shared__ int pre[129];
    __shared__ float p[8][256];
    const int t = blockIdx.x, tid = threadIdx.x, lane = tid & 63, wv = tid >> 6;
    for (int i = tid; i < 1024; i += 256) qs[i] = q[(size_t)t * AW + i];
    unsigned long long w = 0ull;
    if (tid < 128) { w = mask[(size_t)t * 128 + tid]; pre[tid + 1] = __popcll(w); }
    if (tid == 0) pre[0] = 0;
    __syncthreads();
    if (tid == 0) { for (int i = 1; i <= 128; ++i) pre[i] += pre[i - 1]; }
    __syncthreads();
    const int n = pre[128];
    if (tid < 128) { int o = pre[tid]; while (w) { const int b = __ffsll((long long)w) - 1; list[o++] = tid * 64 + b; w &= w - 1; } }
    __syncthreads();
    if (tid < n) {
        const int key = list[tid];
        const float* kp = proj + (size_t)key * INC + COL_K;
        for (int h = 0; h < 8; ++h) {
            float dsum = 0.f;
            for (int d4 = 0; d4 < 32; ++d4) {
                const float4 kv = *(const float4*)(kp + h * 128 + d4 * 4);
                const float4 qv = *(const float4*)&qs[h * 128 + d4 * 4];
                dsum += kv.x * qv.x + kv.y * qv.y + kv.z * qv.z + kv.w * qv.w;
            }
            p[h][tid] = dsum * 0.08838834764831845f;
        }
    } else {
        for (int h = 0; h < 8; ++h) p[h][tid] = -INFINITY;
    }
    __syncthreads();
    for (int hh = 0; hh < 2; ++hh) {
        const int h = wv * 2 + hh;
        float v[4]; float m = -INFINITY;
#pragma unroll
        for (int i = 0; i < 4; ++i) { v[i] = p[h][lane + 64 * i]; m = fmaxf(m, v[i]); }
        m = wave_max(m);
        float s = 0.f;
#pragma unroll
        for (int i = 0; i < 4; ++i) { v[i] = expf(v[i] - m); s += v[i]; }
        s = wave_sum(s);
        const float r = 1.f / s;
#pragma unroll
        for (int i = 0; i < 4; ++i) p[h][lane + 64 * i] = v[i] * r;
    }
    __syncthreads();
    float acc[4] = {0.f, 0.f, 0.f, 0.f};
    for (int j = 0; j < n; ++j) {
        const float* vp = proj + (size_t)list[j] * INC + COL_V;
#pragma unroll
        for (int i = 0; i < 4; ++i) { const int o = tid + 256 * i; acc[i] += p[o >> 7][j] * vp[o]; }
    }
#pragma unroll
    for (int i = 0; i < 4; ++i) yb[(size_t)t * AW + tid + 256 * i] = acc[i];
}
template <bool H2>
__global__ void __launch_bounds__(256) k_post(const float* xin, const float* y, const float* __restrict__ gpost, const float* __restrict__ gate, float* xout,
                                               const float* __restrict__ g2, const float* __restrict__ shift, const float* __restrict__ scale, float* h2) {
    __shared__ float red[8];
    const int t = blockIdx.x, tid = threadIdx.x;
    float v[8], xo[8]; float ss = 0.f;
#pragma unroll
    for (int i = 0; i < 8; ++i) { v[i] = y[(size_t)t * D + tid + 256 * i]; ss += v[i] * v[i]; }
    const float r = rsqrtf(block_sum(ss, red) / D + EPS);
    float s2 = 0.f;
#pragma unroll
    for (int i = 0; i < 8; ++i) { const int n = tid + 256 * i; xo[i] = xin[(size_t)t * D + n] + gate[n] * (v[i] * r * gpost[n]); s2 += xo[i] * xo[i]; }
    if (H2) {
        const float r2 = rsqrtf(block_sum(s2, red) / D + EPS);
#pragma unroll
        for (int i = 0; i < 8; ++i) { const int n = tid + 256 * i; h2[(size_t)t * D + n] = xo[i] * r2 * g2[n] * (1.f + scale[n]) + shift[n]; }
    }
#pragma unroll
    for (int i = 0; i < 8; ++i) xout[(size_t)t * D + tid + 256 * i] = xo[i];
}
}

extern "C" void kernel_launch(void* const* d_in, const int* in_sizes, int n_in, void* d_out, int out_size, void* d_ws, size_t ws_size, hipStream_t stream) {
    const float* x = (const float*)d_in[0]; const float* c = (const float*)d_in[1]; const float* w_mod = (const float*)d_in[2]; const float* b_mod = (const float*)d_in[3];
    const float* g_pre_mix = (const float*)d_in[4]; const float* g_post_mix = (const float*)d_in[5]; const float* w_in = (const float*)d_in[6];
    const float* ln_g = (const float*)d_in[7]; const float* ln_b = (const float*)d_in[8]; const float* w_s = (const float*)d_in[9]; const float* b_s = (const float*)d_in[10];
    const float* qg = (const float*)d_in[11]; const float* w_q_up = (const float*)d_in[12]; const float* w_qidx_up = (const float*)d_in[13];
    const float* kg = (const float*)d_in[14]; const float* kb = (const float*)d_in[15]; const float* w_proj_a = (const float*)d_in[16]; const float* w_proj_b = (const float*)d_in[17];
    const float* w_out = (const float*)d_in[18]; const float* g_pre_ffn = (const float*)d_in[19]; const float* g_post_ffn = (const float*)d_in[20];
    const float* w_gate = (const float*)d_in[21]; const float* w_up = (const float*)d_in[22]; const float* w_down = (const float*)d_in[23];
    float* out = (float*)d_out;
    char* ws = (char*)d_ws;
    const size_t MiB = 1u << 20;
    size_t off = 0;
    float* mod = (float*)(ws + off); off += 1 * MiB;
    float* modpart = (float*)(ws + off); off += 1 * MiB;
    float* cosA = (float*)(ws + off); off += 2 * MiB; float* sinA = (float*)(ws + off); off += 2 * MiB;
    float* cosI = (float*)(ws + off); off += 1 * MiB; float* sinI = (float*)(ws + off); off += 1 * MiB;
    unsigned long long* mask = (unsigned long long*)(ws + off); off += 8 * MiB;
    float* regA = (float*)(ws + off); off += 64 * MiB;
    float* proj = (float*)(ws + off); off += (size_t)S * INC * 4;
    if (off > ws_size) { fprintf(stderr, "kernel_launch: workspace too small (%zu needed, %zu given)\n", off, ws_size); return; }
    float* q = regA; float* qi = regA + (size_t)S * AW;
    const float* shift_m = mod, *scale_m = mod + D, *gate_m = mod + 2 * D, *shift_f = mod + 3 * D, *scale_f = mod + 4 * D, *gate_f = mod + 5 * D;

    k_mod_partial<<<dim3(48, 16), 256, 0, stream>>>(c, w_mod, modpart);
    k_mod_final<<<48, 256, 0, stream>>>(modpart, b_mod, mod);
    k_rope_tables<<<S, 64, 0, stream>>>(cosA, sinA, cosI, sinI);
    k_prenorm<<<S, 256, 0, stream>>>(x, g_pre_mix, shift_m, scale_m, regA);
    k_sgemm<0><<<dim3((INC + 127) / 128, S / 128), 256, 0, stream>>>(regA, D, w_in, INC, proj, INC, INC, D, nullptr, 0);
    k_tok_post<<<S, 256, 0, stream>>>(proj, ln_g, ln_b, qg, kg, kb, cosA, sinA, cosI, sinI);
    k_spatial<<<dim3(S / 128, 8), 256, 0, stream>>>(proj, w_s, b_s);
    k_sgemm<0><<<dim3(AW / 128, S / 128), 256, 0, stream>>>(proj + COL_QLAT, INC, w_q_up, AW, q, AW, AW, QL, nullptr, 0);
    k_sgemm<0><<<dim3(1024 / 128, S / 128), 256, 0, stream>>>(proj + COL_QLAT, INC, w_qidx_up, 1024, qi, 1024, 1024, QL, nullptr, 0);
    k_rope_q<<<S, 256, 0, stream>>>(q, qi, cosA, sinA, cosI, sinI);
    k_indexer<<<S, 256, 0, stream>>>(qi, proj, mask);
    k_attn<<<S, 256, 0, stream>>>(q, proj, mask, q  );
    k_sgemm<1><<<dim3(D / 128, S / 128), 256, 0, stream>>>(proj, INC, w_proj_a, D, out, D, D, GW, proj + COL_GATE, INC);
    k_sgemm<2><<<dim3(D / 128, S / 128), 256, 0, stream>>>(q, AW, w_proj_b, D, out, D, D, AW, proj + COL_GATE + D, INC);
    k_sgemm<0><<<dim3(D / 128, S / 128), 256, 0, stream>>>(out, D, w_out, D, regA, D, D, D, nullptr, 0);
    k_post<true><<<S, 256, 0, stream>>>(x, regA, g_post_mix, gate_m, out, g_pre_ffn, shift_f, scale_f, regA);
    float* a = proj;
    k_sgemm<0><<<dim3(FF / 128, S / 128), 256, 0, stream>>>(regA, D, w_gate, FF, a, FF, FF, D, nullptr, 0);
    k_sgemm<3><<<dim3(FF / 128, S / 128), 256, 0, stream>>>(regA, D, w_up, FF, a, FF, FF, D, nullptr, 0);
    k_sgemm<0><<<dim3(D / 128, S / 128), 256, 0, stream>>>(a, FF, w_down, D, regA, D, D, FF, nullptr, 0);
    k_post<false><<<S, 256, 0, stream>>>(out, regA, g_post_ffn, gate_f, out, nullptr, nullptr, nullptr, nullptr);
}
```

```cpp
#include <hip/hip_runtime.h>
#include <cstdio>
#include <cstdint>
#include <cmath>
#define MK_N_LAUNCHES 1
namespace pg8 {
#define PG8_LAS __attribute__((address_space(3)))
typedef unsigned short bf16_t;
typedef short bf16x8 __attribute__((ext_vector_type(8)));
typedef float f32x4 __attribute__((ext_vector_type(4)));
typedef unsigned u32x4 __attribute__((ext_vector_type(4)));
constexpr int BM = 256, BK = 64, HALF = 128, HTB = HALF * BK * 2  , STAGE_BYTES = 8 * HTB, NXCD = 8, WGM = 8;

__host__ __device__ __forceinline__ int lds_byte(int r, int c) { const int st = (r >> 4) * 2 + (c >> 5), rr = r & 15, cc = c & 31, ob = rr * 64 + cc * 2; return st * 1024 + (ob ^ (((ob >> 9) & 1) << 5)); }
__host__ __device__ __forceinline__ void stage_rc(int b, int& R, int& C) { const int st = b / 1024, sb = b % 1024, swz = sb ^ (((sb >> 9) & 1) << 5); R = (st >> 1) * 16 + swz / 64; C = (st & 1) * 32 + (swz % 64) / 2; }
__host__ __device__ __forceinline__ int perm32(int rho) { const int n = rho >> 4, i = rho & 15; return 8 * (i >> 2) + 4 * n + (i & 3); }

struct Unit { int pm, pn, seg; };
struct Gemm { const bf16_t* A; const bf16_t* Bt; int M, N, K; const bf16_t* A2 = nullptr; const bf16_t* Bt2 = nullptr; };

struct StaticOrder {
    int nM, nN, nwg, G, c;
    __host__ __device__ __forceinline__ void init(int M, int N, int G_, int c_) { nM = M / BM; nN = N / BM; nwg = nM * nN; G = G_; c = c_; }
    __host__ __device__ __forceinline__ bool next(int i, Unit& u) const {
        const long L = (long)i * G + c; if (L >= nwg) return false;
        int wgid = (int)L; { const int q = nwg / NXCD, r = nwg % NXCD, xcd = wgid % NXCD, off = wgid / NXCD; wgid = (xcd < r ? xcd * (q + 1) : r * (q + 1) + (xcd - r) * q) + off; }
        const int nig = WGM * nN, gid = wgid / nig, fm = gid * WGM, gsz = (nM - fm) < WGM ? (nM - fm) : WGM;
        u.pm = fm + ((wgid % nig) % gsz); u.pn = (wgid % nig) / gsz; u.seg = 0; return true;
    }
    __device__ __forceinline__ void a_ready(const Unit&) const {}
    __device__ __forceinline__ void done(const Unit&) const {}
};
struct PairOrder {
    StaticOrder base;
    __host__ __device__ __forceinline__ void init(int M, int N, int G_, int c_) { base.init(M, N, G_, c_); }
    __host__ __device__ __forceinline__ bool next(int i, Unit& u) const { if (!base.next(i >> 1, u)) return false; u.seg = i & 1; return true; }
    __device__ __forceinline__ void a_ready(const Unit&) const {}
    __device__ __forceinline__ void done(const Unit&) const {}
};
typedef float f32x2 __attribute__((ext_vector_type(2)));
typedef __bf16 bf16x2_t __attribute__((ext_vector_type(2)));
__device__ __forceinline__ unsigned cvt_pk_bf16(float lo, float hi) { const f32x2 v = {lo, hi}; const bf16x2_t b = __builtin_convertvector(v, bf16x2_t); return __builtin_bit_cast(unsigned, b); }
__device__ __forceinline__ float fast_sigmoid(float x) { return __builtin_amdgcn_rcpf(1.0f + __builtin_amdgcn_exp2f(-1.4426950408889634f * x)); }
__device__ __forceinline__ float fast_gelu_tanh(float x) { const float u2 = 1.5957691216057308f * (x + 0.044715f * x * x * x); return x * fast_sigmoid(u2); }
__device__ __forceinline__ void store8_bf16(bf16_t* p, const f32x4& v0, const f32x4& v1) {
    u32x4 w; w.x = cvt_pk_bf16(v0[0], v0[1]); w.y = cvt_pk_bf16(v0[2], v0[3]); w.z = cvt_pk_bf16(v1[0], v1[1]); w.w = cvt_pk_bf16(v1[2], v1[3]); *(u32x4*)p = w;
}
__device__ __forceinline__ float bf_lo(unsigned w) { return __builtin_bit_cast(float, w << 16); }
__device__ __forceinline__ float bf_hi(unsigned w) { return __builtin_bit_cast(float, w & 0xffff0000u); }
__device__ __forceinline__ void rope4(f32x4& v0, f32x4& v1, const f32x4 c, const f32x4 s) {
    const float a0 = v0[0], b0 = v0[1], a1 = v0[2], b1 = v0[3], a2 = v1[0], b2 = v1[1], a3 = v1[2], b3 = v1[3];
    v0[0] = a0 * c[0] - b0 * s[0]; v0[1] = b0 * c[0] + a0 * s[0]; v0[2] = a1 * c[1] - b1 * s[1]; v0[3] = b1 * c[1] + a1 * s[1];
    v1[0] = a2 * c[2] - b2 * s[2]; v1[1] = b2 * c[2] + a2 * s[2]; v1[2] = a3 * c[3] - b3 * s[3]; v1[3] = b3 * c[3] + a3 * s[3];
}
struct EpiProj {
    static constexpr bool PERM = true, AFTER_DRAIN = false;
    bf16_t *U, *Vg, *QLAT, *Kb, *Vb, *GATE, *SMALL; float* stats; float* stats2; const float* cosA; const float* sinA;
    __device__ __forceinline__ void operator()(const f32x4 (&acc)[2][2][4][2], const Unit& u, int wr, int wc, int fr, int fq) const {
        const int pn = u.pn; int mode, ld, c0; bf16_t* dst;
        if (pn < 4) { mode = 1; dst = U; ld = 1024; c0 = pn * 256; }
        else if (pn < 8) { mode = 2; dst = Vg; ld = 1024; c0 = (pn - 4) * 256; }
        else if (pn < 10) { mode = 5; dst = QLAT; ld = 512; c0 = (pn - 8) * 256; }
        else if (pn < 14) { mode = 3; dst = Kb; ld = 1024; c0 = (pn - 10) * 256; }
        else if (pn < 18) { mode = 0; dst = Vb; ld = 1024; c0 = (pn - 14) * 256; }
        else if (pn < 34) { mode = 4; dst = GATE; ld = 4096; c0 = (pn - 18) * 256; }
        else { mode = 0; dst = SMALL; ld = 256; c0 = 0; }
        const int row0 = u.pm * BM + wr * 64 + fr, cl = wc * 32 + 8 * fq;
#pragma unroll
        for (int ai = 0; ai < 2; ++ai)
#pragma unroll
            for (int m = 0; m < 4; ++m) {
                const int row = row0 + ai * HALF + m * 16;
                f32x4 v[2][2];
#pragma unroll
                for (int bj = 0; bj < 2; ++bj) { v[bj][0] = acc[ai][bj][m][0]; v[bj][1] = acc[ai][bj][m][1]; }
                if (mode == 1 || mode == 2) {
#pragma unroll
                    for (int bj = 0; bj < 2; ++bj)
#pragma unroll
                        for (int n = 0; n < 2; ++n)
#pragma unroll
                            for (int e = 0; e < 4; ++e) v[bj][n][e] = fast_gelu_tanh(v[bj][n][e]);
                    if (mode == 2) {
                        float s = 0.f, q = 0.f;
#pragma unroll
                        for (int bj = 0; bj < 2; ++bj)
#pragma unroll
                            for (int n = 0; n < 2; ++n)
#pragma unroll
                                for (int e = 0; e < 4; ++e) { s += v[bj][n][e]; q += v[bj][n][e] * v[bj][n][e]; }
                        s += __shfl_xor(s, 16); s += __shfl_xor(s, 32); q += __shfl_xor(q, 16); q += __shfl_xor(q, 32);
                        if (fq == 0) { f32x2 o; o.x = s; o.y = q; *(f32x2*)(stats + ((size_t)row * 16 + (pn - 4) * 4 + wc) * 2) = o; }
                    }
                } else if (mode == 5) {
                    float q = 0.f;
#pragma unroll
                    for (int bj = 0; bj < 2; ++bj)
#pragma unroll
                        for (int n = 0; n < 2; ++n)
#pragma unroll
                            for (int e = 0; e < 4; ++e) q += v[bj][n][e] * v[bj][n][e];
                    q += __shfl_xor(q, 16); q += __shfl_xor(q, 32);
                    if (fq == 0) stats2[(size_t)row * 8 + (pn - 8) * 4 + wc] = q;
                } else if (mode == 3) {
                    const f32x4 c = *(const f32x4*)(cosA + (size_t)row * 64 + 16 * wc + 4 * fq), s = *(const f32x4*)(sinA + (size_t)row * 64 + 16 * wc + 4 * fq);
                    rope4(v[0][0], v[0][1], c, s); rope4(v[1][0], v[1][1], c, s);
                } else if (mode == 4) {
#pragma unroll
                    for (int bj = 0; bj < 2; ++bj)
#pragma unroll
                        for (int n = 0; n < 2; ++n)
#pragma unroll
                            for (int e = 0; e < 4; ++e) v[bj][n][e] = fast_sigmoid(v[bj][n][e]);
                }
                bf16_t* rowp = dst + (size_t)row * ld + c0 + cl;
                store8_bf16(rowp, v[0][0], v[0][1]); store8_bf16(rowp + HALF, v[1][0], v[1][1]);
            }
    }
};
struct EpiQ {
    static constexpr bool PERM = true, AFTER_DRAIN = false;
    bf16_t *Q, *QIDX; const PG8_LAS float* rt; const float *cosA, *sinA, *cosI, *sinI; float qscale;
    __device__ __forceinline__ void operator()(const f32x4 (&acc)[2][2][4][2], const Unit& u, int wr, int wc, int fr, int fq) const {
        const int pn = u.pn; const bool isq = pn < 4;
        bf16_t* dst = isq ? Q : QIDX; const int c0 = (isq ? pn : pn - 4) * 256 + wc * 32 + 8 * fq;
#pragma unroll
        for (int ai = 0; ai < 2; ++ai)
#pragma unroll
            for (int m = 0; m < 4; ++m) {
                const int lrow = ai * HALF + wr * 64 + m * 16 + fr, row = u.pm * BM + lrow;
                const float sc = rt[lrow] * (isq ? qscale : 1.0f);
                f32x4 v[2][2];
#pragma unroll
                for (int bj = 0; bj < 2; ++bj) { v[bj][0] = acc[ai][bj][m][0] * sc; v[bj][1] = acc[ai][bj][m][1] * sc; }
                if (isq) {
                    const f32x4 c = *(const f32x4*)(cosA + (size_t)row * 64 + 16 * wc + 4 * fq), s = *(const f32x4*)(sinA + (size_t)row * 64 + 16 * wc + 4 * fq);
                    rope4(v[0][0], v[0][1], c, s); rope4(v[1][0], v[1][1], c, s);
                } else if ((wc & 1) == 0) {
                    const f32x4 c = *(const f32x4*)(cosI + (size_t)row * 16 + 4 * fq), s = *(const f32x4*)(sinI + (size_t)row * 16 + 4 * fq);
                    rope4(v[0][0], v[0][1], c, s); rope4(v[1][0], v[1][1], c, s);
                }
                bf16_t* rowp = dst + (size_t)row * 1024 + c0;
                store8_bf16(rowp, v[0][0], v[0][1]); store8_bf16(rowp + HALF, v[1][0], v[1][1]);
            }
    }
};
struct EpiGate2 {
    static constexpr bool PERM = true, AFTER_DRAIN = false;
    const bf16_t* GATE; bf16_t* MERGED;
    __device__ __forceinline__ void operator()(f32x4 (&acc)[2][2][4][2], const Unit& u, int wr, int wc, int fr, int fq) const {
        const int row0 = u.pm * BM + wr * 64 + fr, col0 = u.pn * BM + wc * 32 + 8 * fq;
#pragma unroll
        for (int ai = 0; ai < 2; ++ai)
#pragma unroll
            for (int m = 0; m < 4; ++m) {
                const int row = row0 + ai * HALF + m * 16;
#pragma unroll
                for (int bj = 0; bj < 2; ++bj) {
                    const int col = col0 + bj * HALF;
                    const u32x4 gb = *(const u32x4*)(GATE + (size_t)row * 4096 + 2048 + col);
                    f32x4 b0 = {bf_lo(gb.x), bf_hi(gb.x), bf_lo(gb.y), bf_hi(gb.y)}, b1 = {bf_lo(gb.z), bf_hi(gb.z), bf_lo(gb.w), bf_hi(gb.w)};
                    if (u.seg == 0) {
                        const u32x4 ga = *(const u32x4*)(GATE + (size_t)row * 4096 + col);
                        const f32x4 a0 = {bf_lo(ga.x), bf_hi(ga.x), bf_lo(ga.y), bf_hi(ga.y)}, a1 = {bf_lo(ga.z), bf_hi(ga.z), bf_lo(ga.w), bf_hi(ga.w)};
#pragma unroll
                        for (int e = 0; e < 4; ++e) { acc[ai][bj][m][0][e] *= a0[e] * __builtin_amdgcn_rcpf(b0[e]); acc[ai][bj][m][1][e] *= a1[e] * __builtin_amdgcn_rcpf(b1[e]); }
                    } else {
                        store8_bf16(MERGED + (size_t)row * 2048 + col, acc[ai][bj][m][0] * b0, acc[ai][bj][m][1] * b1);
                    }
                }
            }
    }
};
struct EpiOutBf16 {
    static constexpr bool PERM = true, AFTER_DRAIN = false;
    bf16_t* O;
    __device__ __forceinline__ void operator()(const f32x4 (&acc)[2][2][4][2], const Unit& u, int wr, int wc, int fr, int fq) const {
        const int row0 = u.pm * BM + wr * 64 + fr, col0 = u.pn * BM + wc * 32 + 8 * fq;
#pragma unroll
        for (int ai = 0; ai < 2; ++ai)
#pragma unroll
            for (int m = 0; m < 4; ++m)
#pragma unroll
                for (int bj = 0; bj < 2; ++bj) store8_bf16(O + (size_t)(row0 + ai * HALF + m * 16) * 2048 + col0 + bj * HALF, acc[ai][bj][m][0], acc[ai][bj][m][1]);
    }
};
struct EpiSwiGLU {
    static constexpr bool PERM = true, AFTER_DRAIN = false;
    bf16_t* ACT; int ld;
    __device__ __forceinline__ void operator()(const f32x4 (&acc)[2][2][4][2], const Unit& u, int wr, int wc, int fr, int fq) const {
        const int row0 = u.pm * BM + wr * 64 + fr, col0 = u.pn * HALF + wc * 32 + 8 * fq;
#pragma unroll
        for (int ai = 0; ai < 2; ++ai)
#pragma unroll
            for (int m = 0; m < 4; ++m) {
                f32x4 o[2];
#pragma unroll
                for (int n = 0; n < 2; ++n)
#pragma unroll
                    for (int e = 0; e < 4; ++e) { const float g = acc[ai][0][m][n][e]; o[n][e] = g * fast_sigmoid(g) * acc[ai][1][m][n][e]; }
                store8_bf16(ACT + (size_t)(row0 + ai * HALF + m * 16) * ld + col0, o[0], o[1]);
            }
    }
};
template <class Epi, class Sched, bool ALIGN_EPI = false, bool SP2 = false>
__device__ __forceinline__ void gemm_phase(PG8_LAS unsigned char* lds, const Gemm g, const Sched& S, const Epi& E) {
    const int tid = threadIdx.x, wid = __builtin_amdgcn_readfirstlane(tid >> 6), lane = tid & 63, wr = wid >> 2, wc = wid & 3, fr = lane & 15, fq = lane >> 4;
    const int K = g.K, nt = K / BK;
    unsigned voffA[2], voffB[2];
#pragma unroll
    for (int i = 0; i < 2; ++i) { int R, C; stage_rc(tid * 16 + i * 8192, R, C); const int Rb = Epi::PERM ? ((R & ~31) + perm32(R & 31)) : R;
        voffA[i] = (unsigned)(R * K + C) * 2u; voffB[i] = (unsigned)(Rb * K + C) * 2u; }
    const size_t kstep = (size_t)(BK * 2);
    const size_t hstep = (size_t)HALF * K * 2;
    const size_t tstep = 2 * hstep;
    const unsigned ldsw = (unsigned)wid * 1024u;
    const int aoff = lds_byte(wr * 64 + fr, fq * 8), boff = lds_byte(wc * 32 + fr, fq * 8);
#define PG8_SA(b, h) (((b) * 2 + (h)) * HTB)
#define PG8_SB(b, h) ((4 + (b) * 2 + (h)) * HTB)
#define PG8_STAGE(bufoff, gbase, voff) do { _Pragma("unroll") for (int _i = 0; _i < 2; ++_i) \
        __builtin_amdgcn_global_load_lds((const unsigned*)((const char*)(gbase) + (voff)[_i]), (PG8_LAS unsigned*)(lds + (bufoff) + ldsw + _i * 8192), 16, 0, 0); } while (0)
#define PG8_LDA(dst, b, h) do { _Pragma("unroll") for (int m = 0; m < 4; ++m) _Pragma("unroll") for (int k = 0; k < 2; ++k) dst[m][k] = *(const PG8_LAS bf16x8*)(lds + PG8_SA(b, h) + aoff + m * 2048 + k * 1024); } while (0)
#define PG8_LDB(dst, b, h) do { _Pragma("unroll") for (int n = 0; n < 2; ++n) _Pragma("unroll") for (int k = 0; k < 2; ++k) dst[n][k] = *(const PG8_LAS bf16x8*)(lds + PG8_SB(b, h) + boff + n * 2048 + k * 1024); } while (0)
#define PG8_MMA(ai, bj, At, Bt) do { __builtin_amdgcn_s_setprio(1); _Pragma("unroll") for (int m = 0; m < 4; ++m) _Pragma("unroll") for (int n = 0; n < 2; ++n) _Pragma("unroll") for (int k = 0; k < 2; ++k) \
        acc[ai][bj][m][n] = __builtin_amdgcn_mfma_f32_16x16x32_bf16(Bt[n][k], At[m][k], acc[ai][bj][m][n], 0, 0, 0); __builtin_amdgcn_s_setprio(0); } while (0)
#define PG8_WAIT_V(n) asm volatile("s_waitcnt vmcnt(" #n ")" ::: "memory")
#define PG8_WAIT_L(n) asm volatile("s_waitcnt lgkmcnt(" #n ")" ::: "memory")
#define PG8_BAR __builtin_amdgcn_s_barrier()
#define PG8_SCHED __builtin_amdgcn_sched_barrier(0)
    Unit cur, nxt; int ui = 0;
    if (!S.next(0, cur)) return;
    f32x4 acc[2][2][4][2];
#pragma unroll
    for (int a = 0; a < 2; ++a)
#pragma unroll
        for (int b = 0; b < 2; ++b)
#pragma unroll
            for (int m = 0; m < 4; ++m)
#pragma unroll
                for (int n = 0; n < 2; ++n) acc[a][b][m][n] = (f32x4){0.f, 0.f, 0.f, 0.f};
    bf16x8 At[4][2], B0[2][2], B1[2][2];
    const char* cA = (const char*)(cur.seg ? g.A2 : g.A) + (size_t)cur.pm * tstep; const char* cB = (const char*)(cur.seg ? g.Bt2 : g.Bt) + (size_t)cur.pn * tstep;
    S.a_ready(cur);
    if constexpr (SP2) {
        PG8_STAGE(PG8_SB(0, 0), cB, voffB); PG8_STAGE(PG8_SB(0, 1), cB + hstep, voffB); PG8_STAGE(PG8_SA(0, 0), cA, voffA); PG8_STAGE(PG8_SA(0, 1), cA + hstep, voffA);
        if (wr == 1) PG8_BAR;
        PG8_WAIT_V(2); PG8_BAR;
        PG8_STAGE(PG8_SB(1, 0), cB + kstep, voffB); PG8_STAGE(PG8_SA(1, 0), cA + kstep, voffA); PG8_STAGE(PG8_SB(1, 1), cB + hstep + kstep, voffB);
        PG8_WAIT_V(6); PG8_BAR;
    } else {
        PG8_STAGE(PG8_SB(0, 0), cB, voffB); PG8_STAGE(PG8_SA(0, 0), cA, voffA); PG8_STAGE(PG8_SB(0, 1), cB + hstep, voffB); PG8_STAGE(PG8_SA(0, 1), cA + hstep, voffA);
        if (wr == 1) PG8_BAR;
        PG8_WAIT_V(4); PG8_BAR;
        PG8_STAGE(PG8_SB(1, 0), cB + kstep, voffB); PG8_STAGE(PG8_SA(1, 0), cA + kstep, voffA); PG8_STAGE(PG8_SB(1, 1), cB + hstep + kstep, voffB);
        PG8_WAIT_V(6); PG8_BAR;
    }
    for (;;) {
        const bool has_next = S.next(ui + 1, nxt);
        const char* nA = has_next ? (const char*)(nxt.seg ? g.A2 : g.A) + (size_t)nxt.pm * tstep : cA; const char* nB = has_next ? (const char*)(nxt.seg ? g.Bt2 : g.Bt) + (size_t)nxt.pn * tstep : cB;
        for (int t = 0; t < nt; t += 2) {
            const bool last = (t == nt - 2);
            const char* a1 = cA + (size_t)(t + 1) * kstep;
            const char* a2 = last ? nA : cA + (size_t)(t + 2) * kstep; const char* b2 = last ? nB : cB + (size_t)(t + 2) * kstep;
            const char* a3 = a2 + kstep; const char* b3 = b2 + kstep;
            if (last && has_next) S.a_ready(nxt);
            if constexpr (SP2) {
            PG8_LDB(B0, 0, 0); PG8_LDB(B1, 0, 1); PG8_SCHED; PG8_LDA(At, 0, 0); PG8_STAGE(PG8_SA(1, 1), a1 + hstep, voffA);
            PG8_WAIT_V(8); PG8_WAIT_L(0); PG8_BAR; PG8_MMA(0, 0, At, B0); PG8_MMA(0, 1, At, B1); PG8_BAR; PG8_SCHED;
            PG8_LDA(At, 0, 1); PG8_STAGE(PG8_SB(0, 0), b2, voffB); PG8_STAGE(PG8_SB(0, 1), b2 + hstep, voffB); PG8_STAGE(PG8_SA(0, 0), a2, voffA);
            PG8_WAIT_V(8); PG8_WAIT_L(0); PG8_BAR; PG8_MMA(1, 0, At, B0); PG8_MMA(1, 1, At, B1); PG8_BAR; PG8_SCHED;
            PG8_LDB(B0, 1, 0); PG8_LDB(B1, 1, 1); PG8_SCHED; PG8_LDA(At, 1, 0); PG8_STAGE(PG8_SA(0, 1), a2 + hstep, voffA);
            PG8_WAIT_V(8); PG8_WAIT_L(0); PG8_BAR; PG8_MMA(0, 0, At, B0); PG8_MMA(0, 1, At, B1); PG8_BAR; PG8_SCHED;
            PG8_LDA(At, 1, 1); PG8_STAGE(PG8_SB(1, 0), b3, voffB); PG8_STAGE(PG8_SB(1, 1), b3 + hstep, voffB); PG8_STAGE(PG8_SA(1, 0), a3, voffA);
            PG8_WAIT_V(8); PG8_WAIT_L(0); PG8_BAR; PG8_MMA(1, 0, At, B0); PG8_MMA(1, 1, At, B1); PG8_BAR; PG8_SCHED;
            } else {
            PG8_LDB(B0, 0, 0); PG8_SCHED; PG8_LDA(At, 0, 0); PG8_STAGE(PG8_SA(1, 1), a1 + hstep, voffA);
            PG8_WAIT_L(8); PG8_BAR; PG8_WAIT_L(0); PG8_MMA(0, 0, At, B0); PG8_BAR; PG8_SCHED;
            PG8_LDB(B1, 0, 1); PG8_STAGE(PG8_SB(0, 0), b2, voffB);
            PG8_BAR; PG8_WAIT_L(0); PG8_MMA(0, 1, At, B1); PG8_BAR;
            PG8_LDA(At, 0, 1); PG8_STAGE(PG8_SA(0, 0), a2, voffA);
            PG8_BAR; PG8_WAIT_L(0); PG8_MMA(1, 0, At, B0); PG8_BAR; PG8_SCHED;
            PG8_STAGE(PG8_SB(0, 1), b2 + hstep, voffB);
            PG8_WAIT_V(6); PG8_BAR; PG8_MMA(1, 1, At, B1); PG8_BAR;
            PG8_LDB(B0, 1, 0); PG8_SCHED; PG8_LDA(At, 1, 0); PG8_STAGE(PG8_SA(0, 1), a2 + hstep, voffA);
            PG8_WAIT_L(8); PG8_BAR; PG8_WAIT_L(0); PG8_MMA(0, 0, At, B0); PG8_BAR; PG8_SCHED;
            PG8_LDB(B1, 1, 1); PG8_STAGE(PG8_SB(1, 0), b3, voffB);
            PG8_BAR; PG8_WAIT_L(0); PG8_MMA(0, 1, At, B1); PG8_BAR;
            PG8_LDA(At, 1, 1); PG8_STAGE(PG8_SA(1, 0), a3, voffA);
            PG8_BAR; PG8_WAIT_L(0); PG8_MMA(1, 0, At, B0); PG8_BAR; PG8_SCHED;
            PG8_STAGE(PG8_SB(1, 1), b3 + hstep, voffB);
            PG8_WAIT_V(6); PG8_BAR; PG8_MMA(1, 1, At, B1); PG8_BAR;
            }
        }
        if constexpr (ALIGN_EPI) { if (wr == 0) PG8_BAR; }
        if constexpr (!Epi::AFTER_DRAIN) { E(acc, cur, wr, wc, fr, fq); S.done(cur); }
        if (!has_next) break;
        if (nxt.seg == 0)
#pragma unroll
        for (int a = 0; a < 2; ++a)
#pragma unroll
            for (int b = 0; b < 2; ++b)
#pragma unroll
                for (int m = 0; m < 4; ++m)
#pragma unroll
                    for (int n = 0; n < 2; ++n) acc[a][b][m][n] = (f32x4){0.f, 0.f, 0.f, 0.f};
        cur = nxt; cA = nA; cB = nB; ++ui;
        if constexpr (ALIGN_EPI) { if (wr == 1) PG8_BAR; }
    }
    PG8_WAIT_V(0);
    if constexpr (!ALIGN_EPI) { if (wr == 0) PG8_BAR; }
    PG8_BAR;
    if constexpr (Epi::AFTER_DRAIN) { E.fused(acc, cur, wr, wc, fr, fq, lds, wid, lane); S.done(cur); }
#undef PG8_SA
#undef PG8_SB
#undef PG8_STAGE
#undef PG8_LDA
#undef PG8_LDB
#undef PG8_MMA
#undef PG8_WAIT_V
#undef PG8_WAIT_L
#undef PG8_BAR
#undef PG8_SCHED
}
}
#define GAS __attribute__((address_space(1)))
#define LAS __attribute__((address_space(3)))
typedef unsigned short bf16;
typedef unsigned v4u __attribute__((ext_vector_type(4)));
typedef float f32x4 __attribute__((ext_vector_type(4)));
typedef short bf16x8 __attribute__((ext_vector_type(8)));
typedef GAS unsigned gu32;
typedef GAS unsigned long long gu64;
#define RLX_AGENT __ATOMIC_RELAXED, __HIP_MEMORY_SCOPE_AGENT
#define LDS_WAIT() asm volatile("s_waitcnt lgkmcnt(0)" ::: "memory")
#define VM_WAIT() asm volatile("s_waitcnt vmcnt(0)" ::: "memory")
__device__ __forceinline__ unsigned long long rt() { return __builtin_amdgcn_s_memrealtime(); }
__device__ __forceinline__ unsigned f2bf(float f) { unsigned u = __builtin_bit_cast(unsigned, f); return (u + 0x7fffu + ((u >> 16) & 1u)) >> 16; }
__device__ __forceinline__ unsigned pk2(float lo, float hi) { return f2bf(lo) | (f2bf(hi) << 16); }
#define XB_TMO      128
#define XB_XCNT(j)  (256  + 64 * (j))
#define XB_XSUB(j)  (1280 + 64 * (j))
#define XB_XGEN(j)  (2304 + 64 * (j))
#define XB_TOP      3328
#define XB_TOPGEN   3392
#define XCD_BAR_WORDS 3456
#define XB_SPIN_CAP (1u << 18)

__device__ __forceinline__ unsigned xb_ld(unsigned* p)              { return __hip_atomic_load(p, __ATOMIC_RELAXED, __HIP_MEMORY_SCOPE_AGENT); }
__device__ __forceinline__ unsigned xb_add(unsigned* p, unsigned v) { return __hip_atomic_fetch_add(p, v, __ATOMIC_RELAXED, __HIP_MEMORY_SCOPE_AGENT); }
__device__ __forceinline__ unsigned xb_xcc_id() { return (unsigned)__builtin_amdgcn_s_getreg((3 << 11) | 20) & 0xFu; }
#define XB_SPIN(cond, bar) do { unsigned _sp = 0; while (cond) { __builtin_amdgcn_s_sleep(1); \
    if ((++_sp & 255u) == 0u) { if (xb_ld(&(bar)[XB_TMO])) break; if (_sp > XB_SPIN_CAP) { atomicAdd(&(bar)[XB_TMO], 1u); break; } } } } while (0)

struct XcdBarrier {
    unsigned* bar; unsigned x;
    volatile LAS unsigned* st;
};

__device__ __forceinline__ XcdBarrier xcd_barrier_post(unsigned* bar, volatile LAS unsigned* st) {
    XcdBarrier b; b.bar = bar; b.x = xb_xcc_id(); b.st = st;
    if (threadIdx.x == 0) (void)xb_add(&bar[XB_XCNT(b.x)], 1u);
    return b;
}
__device__ __forceinline__ void xcd_barrier_complete(unsigned* bar, unsigned x, unsigned& nloc, unsigned& nx) {
    const unsigned G = gridDim.x * gridDim.y * gridDim.z;
    unsigned sum, cnt, mine, sp = 0u;
    for (;;) {
        sum = 0u; cnt = 0u; mine = 0u;
#pragma unroll
        for (unsigned j = 0; j < 16; ++j) { const unsigned c = xb_ld(&bar[XB_XCNT(j)]); sum += c; cnt += (c > 0u) ? 1u : 0u; mine = (j == x) ? c : mine; }
        if (sum == G) break;
        __builtin_amdgcn_s_sleep(1);
        if ((++sp & 255u) == 0u) { if (xb_ld(&bar[XB_TMO])) break; if (sp > XB_SPIN_CAP) { atomicAdd(&bar[XB_TMO], 1u); break; } }
    }
    nloc = mine > 0u ? mine : 1u; nx = cnt > 0u ? cnt : 1u;
}

__device__ __forceinline__ void xcd_barrier(const XcdBarrier& b) {
    asm volatile("s_waitcnt vmcnt(0)" ::: "memory");
    __syncthreads();
    if (threadIdx.x == 0) {
        unsigned* bar = b.bar;
        __builtin_amdgcn_s_waitcnt(0);
        unsigned nloc = b.st[0], nx = b.st[1];
        if (nloc == 0u) { xcd_barrier_complete(bar, b.x, nloc, nx); b.st[0] = nloc; b.st[1] = nx; }
        const unsigned old = xb_add(&bar[XB_XSUB(b.x)], 1u);
        const unsigned gen = old / nloc;
        if (old + 1u == (gen + 1u) * nloc) {
            __builtin_amdgcn_fence(__ATOMIC_RELEASE, "agent");
            asm volatile("s_waitcnt vmcnt(0)" ::: "memory");
            const unsigned og = xb_add(&bar[XB_TOP], 1u);
            const unsigned tg = og / nx;
            if (og + 1u == (tg + 1u) * nx) xb_add(&bar[XB_TOPGEN], 1u);
            else XB_SPIN(xb_ld(&bar[XB_TOPGEN]) == tg, bar);
            __builtin_amdgcn_fence(__ATOMIC_ACQUIRE, "agent");
            xb_add(&bar[XB_XGEN(b.x)], 1u);
            asm volatile("s_waitcnt vmcnt(0)" ::: "memory");
        } else {
            XB_SPIN(xb_ld(&bar[XB_XGEN(b.x)]) == gen, bar);
            __builtin_amdgcn_fence(__ATOMIC_ACQUIRE, "agent");
            asm volatile("s_waitcnt vmcnt(0)" ::: "memory");
        }
    }
    __syncthreads();
}
constexpr int NWAVES = 8;
#ifndef MK_N_LAUNCHES
#define MK_N_LAUNCHES 1
#endif
constexpr int N_PHASES = 13;
constexpr int N_LAUNCHES = MK_N_LAUNCHES;

constexpr int S = 8192, D = 2048, GW = 1024, QL = 512, AW = 1024, FF = 5632;
constexpr int NPROJ = 8960;
constexpr int SRC_INC = 8784;
constexpr float NORM_EPS = 1e-6f;
constexpr float QSCALE = 0.08838834764831845f * 1.4426950408889634f;

constexpr size_t MiB = 1u << 20;
constexpr size_t WS_CTL = 0, CTL_ZERO_BYTES = 128 * 1024;
constexpr size_t WS_MOD = 1 * MiB, WS_COSA = 2 * MiB, WS_SINA = 4 * MiB, WS_COSI = 6 * MiB, WS_SINI = 6 * MiB + 512 * 1024, WS_STATS = 7 * MiB, WS_IDXW = 8 * MiB, WS_KIDX = 8 * MiB + 512 * 1024, WS_WM = 9 * MiB + 512 * 1024, WS_STATS2 = 9 * MiB + 768 * 1024;
constexpr size_t WS_WIN = 10 * MiB, WS_WQQ = 45 * MiB, WS_WPA = 47 * MiB, WS_WPB = 51 * MiB, WS_WOUT = 55 * MiB, WS_WGU = 63 * MiB, WS_WDOWN = 107 * MiB;
constexpr size_t WS_H = 129 * MiB;
constexpr size_t WS_U = 161 * MiB, WS_VG = 177 * MiB, WS_QLAT = 193 * MiB, WS_K = 201 * MiB, WS_V = 217 * MiB, WS_GATE = 233 * MiB, WS_SMALL = 297 * MiB;
constexpr size_t WS_ACT = 161 * MiB;
constexpr size_t WS_Q = 301 * MiB, WS_QIDX = 317 * MiB, WS_YB = 341 * MiB;
constexpr size_t WS_MASKB0 = WS_H, WS_MASKB1 = WS_WIN + 2 * MiB;
constexpr size_t WS_X1 = 249 * MiB;
constexpr size_t WS_F2 = 333 * MiB;
constexpr size_t WS_F = 301 * MiB;
constexpr size_t WS_END = 365 * MiB;
static_assert(WS_WIN + (size_t)NPROJ * D * 2 <= WS_WQQ && WS_WGU + (size_t)2 * FF * D * 2 <= WS_WDOWN && WS_WDOWN + (size_t)D * FF * 2 <= WS_H && WS_ACT + (size_t)S * FF * 2 <= WS_Q, "d_ws map");
constexpr int CW_TMO = 0, CW_CODE = 1, CW_BAR = 4096, CW_ATT = 16384;
static_assert((size_t)(CW_ATT + 256 * 64) * 4 <= CTL_ZERO_BYTES, "every polled word inside the memset region");

constexpr int RING_OFF = 0, RING_BYTES = 131072;
constexpr int LDSCTL_OFF = RING_BYTES, MISC_OFF = LDSCTL_OFF + 320;
constexpr int AUX_OFF = RING_BYTES + 1024;
constexpr int LDS_BYTES = 163840;
struct Frame {
    LAS unsigned char* lds;
    volatile LAS unsigned* MISC;
    gu32* ctl;
    int tid, lane, wave;
    int vcu, G;
    const float* in[24];
    float* out; unsigned char* ws;
};
__device__ __forceinline__ float wave_sum(float v) {
#pragma unroll
    for (int o = 1; o < 64; o <<= 1) v += __shfl_xor(v, o);
    return v;
}
__device__ __forceinline__ float wave_max(float v) {
#pragma unroll
    for (int o = 1; o < 64; o <<= 1) v = fmaxf(v, __shfl_xor(v, o));
    return v;
}
__device__ __forceinline__ float bf2f(bf16 b) { return __builtin_bit_cast(float, (unsigned)b << 16); }
__device__ __forceinline__ float bflo(unsigned w) { return __builtin_bit_cast(float, w << 16); }
__device__ __forceinline__ float bfhi(unsigned w) { return __builtin_bit_cast(float, w & 0xffff0000u); }

enum { MAT_WIN = 0, MAT_WQ, MAT_WQI, MAT_WPA, MAT_WPB, MAT_WOUT, MAT_WGATE, MAT_WUP, MAT_WDOWN };
__device__ __forceinline__ int dst_of(int mat, int c) {
    switch (mat) {
    case MAT_WIN:
        if (c < 2560) return c;
        if (c < 3584) { const int h = (c - 2560) >> 7, d = (c - 2560) & 127; return 2560 + h * 128 + (d < 64 ? 2 * d : 2 * (d - 64) + 1); }
        if (c < 4608) return c;
        if (c < 4688) return 8704 + (c - 4608);
        return c - 4688 + 4608;
    case MAT_WQ: { const int h = c >> 7, d = c & 127; return h * 128 + (d < 64 ? 2 * d : 2 * (d - 64) + 1); }
    case MAT_WQI: { const int h = c >> 6, d = c & 63; return 1024 + h * 64 + (d < 32 ? (d < 16 ? 2 * d : 2 * (d - 16) + 1) : d); }
    case MAT_WGATE: return (c >> 7) * 256 + (c & 127);
    case MAT_WUP: return (c >> 7) * 256 + 128 + (c & 127);
    default: return c;
    }
}
__device__ __forceinline__ void p0_transpose_item(int mat, const float* __restrict__ W, int K, int N, bf16* WT, const float* ksc, LAS unsigned char* scr, int item, int lane) {
    const int nblk = (N + 63) / 64, kb = item / nblk, nb = item % nblk, k0 = 64 * kb, c0 = 64 * nb;
    const int kq = lane >> 4, nq = lane & 15;
    const bool colok = (c0 + 4 * nq) < N;
    f32x4 v[16];
#pragma unroll
    for (int i = 0; i < 16; ++i) { const int k = k0 + 16 * (i >> 2) + 4 * kq + (i & 3); v[i] = colok ? *(const f32x4*)(W + (size_t)k * N + c0 + 4 * nq) : (f32x4){0.f, 0.f, 0.f, 0.f}; }
    if (ksc) {
#pragma unroll
        for (int i = 0; i < 16; ++i) v[i] = v[i] * ksc[k0 + 16 * (i >> 2) + 4 * kq + (i & 3)];
    }
#pragma unroll
    for (int j = 0; j < 4; ++j)
#pragma unroll
        for (int e = 0; e < 4; ++e) {
            const unsigned lo = pk2(v[4 * j][e], v[4 * j + 1][e]), hi = pk2(v[4 * j + 2][e], v[4 * j + 3][e]);
            *(LAS unsigned long long*)(scr + (4 * nq + e) * 144 + (16 * j + 4 * kq) * 2) = (unsigned long long)lo | ((unsigned long long)hi << 32);
        }
    LDS_WAIT(); asm volatile("" ::: "memory");
#pragma unroll
    for (int j = 0; j < 8; ++j) {
        const int ch = lane + 64 * j, cl = ch >> 3, k8 = ch & 7;
        const v4u o = *(const LAS v4u*)(scr + cl * 144 + k8 * 16);
        if (c0 + cl < N) *(GAS v4u*)(WT + (size_t)dst_of(mat, c0 + cl) * K + k0 + 8 * k8) = o;
    }
    LDS_WAIT(); asm volatile("" ::: "memory");
}
__device__ __forceinline__ void p0_prologue(const Frame& F) {
    unsigned char* ws = F.ws;
    LAS unsigned char* scr = F.lds + RING_OFF + F.wave * 16384;
    const int gw = F.vcu * NWAVES + F.wave, NGW = F.G * NWAVES;
    constexpr int I_WIN = (D / 64) * ((SRC_INC + 63) / 64), I_WQ = (QL / 64) * (1024 / 64);
    constexpr int NITEMS = I_WIN + 2 * I_WQ;
    for (int it = gw; it < NITEMS; it += NGW) {
        int r = it;
        if (r < I_WIN) { p0_transpose_item(MAT_WIN, F.in[6], D, SRC_INC, (bf16*)(ws + WS_WIN), nullptr, scr, r, F.lane); continue; } r -= I_WIN;
        if (r < I_WQ) { p0_transpose_item(MAT_WQ, F.in[12], QL, 1024, (bf16*)(ws + WS_WQQ), F.in[11], scr, r, F.lane); continue; } r -= I_WQ;
        p0_transpose_item(MAT_WQI, F.in[13], QL, 1024, (bf16*)(ws + WS_WQQ), F.in[11], scr, r, F.lane);
    }
    {
        v4u* z = (v4u*)(ws + WS_WIN + (size_t)8784 * D * 2);
        for (int i = F.vcu * 512 + F.tid; i < (NPROJ - 8784) * D * 2 / 16; i += F.G * 512) z[i] = (v4u){0u, 0u, 0u, 0u};
    }
    {
        const float* wsrc = F.in[9]; bf16* wm = (bf16*)(ws + WS_WM);
        for (int i = (F.vcu * 512 + F.tid); i < 8 * 128 * 128; i += F.G * 512) { const int t = (i >> 7) & 127, s = i & 127; wm[i] = (bf16)f2bf(s <= t ? wsrc[i] : 0.f); }
    }
    {
        float* cosA = (float*)(ws + WS_COSA); float* sinA = (float*)(ws + WS_SINA); float* cosI = (float*)(ws + WS_COSI); float* sinI = (float*)(ws + WS_SINI);
        for (int i = F.vcu * 512 + F.tid; i < S * 64; i += F.G * 512) {
            const int t = i >> 6, k = i & 63;
            const float inv = 1.0f / powf(10000.0f, (float)(2 * k) / 128.0f); const float ang = (float)t * inv;
            { const double a = (double)ang, rr = a - 6.283185307179586476925 * rint(a * 0.15915494309189533577); float sn, cs; sincosf((float)rr, &sn, &cs); cosA[i] = cs; sinA[i] = sn; }
            if (k < 16) { const float inv2 = 1.0f / powf(10000.0f, (float)(2 * k) / 32.0f); const float ang2 = (float)t * inv2;
                const double a = (double)ang2, rr = a - 6.283185307179586476925 * rint(a * 0.15915494309189533577); float sn, cs; sincosf((float)rr, &sn, &cs); cosI[t * 16 + k] = cs; sinI[t * 16 + k] = sn; }
        }
    }
    {
        __syncthreads();
        LAS f32x4* red = (LAS f32x4*)(F.lds + RING_OFF);
        const float* cv = F.in[1]; const float* wmod = F.in[2]; const float* bmod = F.in[3]; float* mod = (float*)(ws + WS_MOD);
        for (int cb = F.vcu; cb < 256; cb += F.G) {
            const int kg = F.tid / 12, c4 = F.tid % 12;
            if (kg < 42) {
                f32x4 acc = {0.f, 0.f, 0.f, 0.f};
#pragma unroll 8
                for (int k = kg; k < D; k += 42) acc += *(const f32x4*)(wmod + (size_t)k * (6 * D) + cb * 48 + 4 * c4) * cv[k];
                red[kg * 12 + c4] = acc;
            }
            __syncthreads();
            if (F.tid < 48) { float a = bmod[cb * 48 + F.tid]; const LAS float* rf = (const LAS float*)red; for (int g = 0; g < 42; ++g) a += rf[g * 48 + F.tid]; mod[cb * 48 + F.tid] = a; }
            __syncthreads();
        }
    }
}
__device__ __forceinline__ void p_late_convert(const Frame& F, int part, int widx, int nwg) {
    unsigned char* ws = F.ws;
    LAS unsigned char* scr = F.lds + RING_OFF + F.wave * 16384;
    constexpr int I_WPA = (GW / 64) * (D / 64), I_WOUT = (D / 64) * (D / 64), I_WG = (D / 64) * (FF / 64), I_WDOWN = (FF / 64) * (D / 64);
    const int n = part == 0 ? 2 * I_WPA + I_WOUT + 2 * I_WG : I_WDOWN;
    for (int it = widx * NWAVES + F.wave; it < n; it += nwg * NWAVES) {
        if (part == 1) { p0_transpose_item(MAT_WDOWN, F.in[23], FF, D, (bf16*)(ws + WS_WDOWN), nullptr, scr, it, F.lane); continue; }
        int r = it;
        if (r < I_WPA) { p0_transpose_item(MAT_WPA, F.in[16], GW, D, (bf16*)(ws + WS_WPA), nullptr, scr, r, F.lane); continue; } r -= I_WPA;
        if (r < I_WPA) { p0_transpose_item(MAT_WPB, F.in[17], AW, D, (bf16*)(ws + WS_WPB), nullptr, scr, r, F.lane); continue; } r -= I_WPA;
        if (r < I_WOUT) { p0_transpose_item(MAT_WOUT, F.in[18], D, D, (bf16*)(ws + WS_WOUT), nullptr, scr, r, F.lane); continue; } r -= I_WOUT;
        if (r < I_WG) { p0_transpose_item(MAT_WGATE, F.in[21], D, FF, (bf16*)(ws + WS_WGU), nullptr, scr, r, F.lane); continue; } r -= I_WG;
        p0_transpose_item(MAT_WUP, F.in[22], D, FF, (bf16*)(ws + WS_WGU), nullptr, scr, r, F.lane);
    }
}
__device__ __forceinline__ void p1_prenorm(const Frame& F) {
    const int gw = F.vcu * NWAVES + F.wave, NGW = F.G * NWAVES;
    const float* x = F.in[0]; const float* g = F.in[4]; const float* mod = (const float*)(F.ws + WS_MOD); bf16* H = (bf16*)(F.ws + WS_H);
    for (int m = gw; m < S; m += NGW) {
        const f32x4* xr = (const f32x4*)(x + (size_t)m * D) + F.lane;
        f32x4 v[8]; float ss = 0.f;
#pragma unroll
        for (int j = 0; j < 8; ++j) { v[j] = xr[64 * j]; ss += (v[j].x * v[j].x + v[j].y * v[j].y) + (v[j].z * v[j].z + v[j].w * v[j].w); }
        const float r = rsqrtf(wave_sum(ss) * (1.f / D) + NORM_EPS);
        unsigned long long* o8 = (unsigned long long*)(H + (size_t)m * D) + F.lane;
#pragma unroll
        for (int j = 0; j < 8; ++j) {
            const int n = 4 * F.lane + 256 * j;
            const f32x4 gg = *(const f32x4*)(g + n), sh = *(const f32x4*)(mod + n), sc = *(const f32x4*)(mod + D + n);
            const f32x4 o = v[j] * r * gg * (sc + 1.0f) + sh;
            o8[64 * j] = (unsigned long long)pk2(o.x, o.y) | ((unsigned long long)pk2(o.z, o.w) << 32);
        }
    }
}
__device__ __forceinline__ void p3_spatial_item(const Frame& F, int c, int g) {
    constexpr int VP = 136;
    LAS bf16* VT = (LAS bf16*)(F.lds + RING_OFF);
    const bf16* Vg = (const bf16*)(F.ws + WS_VG); bf16* U = (bf16*)(F.ws + WS_U); const bf16* WM = (const bf16*)(F.ws + WS_WM) + (size_t)g * 128 * 128;
    const float* stats = (const float*)(F.ws + WS_STATS); const float* gam = F.in[7] + g * 128; const float* bet = F.in[8] + g * 128; const float* bs = F.in[10] + g * 128;
    const int w = F.wave, fr = F.lane & 15, fq = F.lane >> 4;
    bf16x8 bw[8][4];
#pragma unroll
    for (int ks = 0; ks < 4; ++ks)
#pragma unroll
        for (int nt = 0; nt < 8; ++nt) if (nt >= 2 * ks) bw[nt][ks] = *(const bf16x8*)(WM + (size_t)(16 * nt + fr) * 128 + 32 * ks + 8 * fq);
    {
        const int s = F.tid >> 2, dq = F.tid & 3, row = c * 128 + s;
        float sm = 0.f, sq = 0.f;
#pragma unroll
        for (int k = 0; k < 16; ++k) { const float2 p = *(const float2*)(stats + ((size_t)row * 16 + k) * 2); sm += p.x; sq += p.y; }
        const float mu = sm * (1.f / GW), var = sq * (1.f / GW) - mu * mu, r = rsqrtf(fmaxf(var, 0.f) + NORM_EPS);
        const v4u* vp = (const v4u*)(Vg + (size_t)row * GW + g * 128 + dq * 32);
#pragma unroll
        for (int i = 0; i < 4; ++i) {
            const v4u w = vp[i];
            const unsigned ww[4] = {w.x, w.y, w.z, w.w};
#pragma unroll
            for (int e = 0; e < 4; ++e) {
                const int d = dq * 32 + i * 8 + e * 2;
                const float a = (bflo(ww[e]) - mu) * r * gam[d] + bet[d], b = (bfhi(ww[e]) - mu) * r * gam[d + 1] + bet[d + 1];
                VT[d * VP + s] = (bf16)f2bf(a); VT[(d + 1) * VP + s] = (bf16)f2bf(b);
            }
        }
    }
    __syncthreads();
    {
        f32x4 acc[8];
#pragma unroll
        for (int nt = 0; nt < 8; ++nt) acc[nt] = (f32x4){0.f, 0.f, 0.f, 0.f};
#pragma unroll
        for (int ks = 0; ks < 4; ++ks) {
            const bf16x8 a = *(const LAS bf16x8*)(VT + (16 * w + fr) * VP + 32 * ks + 8 * fq);
#pragma unroll
            for (int nt = 0; nt < 8; ++nt) if (nt >= 2 * ks) acc[nt] = __builtin_amdgcn_mfma_f32_16x16x32_bf16(a, bw[nt][ks], acc[nt], 0, 0, 0);
        }
#pragma unroll
        for (int nt = 0; nt < 8; ++nt) {
            const int t = 16 * nt + fr; const float bb = bs[t];
            unsigned long long* up = (unsigned long long*)(U + (size_t)(c * 128 + t) * GW + g * 128 + 16 * w + 4 * fq);
            const unsigned long long uu = *up; const unsigned lo = (unsigned)uu, hi = (unsigned)(uu >> 32);
            const float o0 = bflo(lo) * (acc[nt][0] + bb), o1 = bfhi(lo) * (acc[nt][1] + bb), o2 = bflo(hi) * (acc[nt][2] + bb), o3 = bfhi(hi) * (acc[nt][3] + bb);
            *up = (unsigned long long)pk2(o0, o1) | ((unsigned long long)pk2(o2, o3) << 32);
        }
    }
    __syncthreads();
}
__device__ __forceinline__ void p3_kidx(const Frame& F) {
    const int gw = F.vcu * NWAVES + F.wave, NGW = F.G * NWAVES, l = F.lane;
    const bf16* SM = (const bf16*)(F.ws + WS_SMALL); bf16* KIDX = (bf16*)(F.ws + WS_KIDX); float* IDXW = (float*)(F.ws + WS_IDXW);
    const float* kg = F.in[14]; const float* kb = F.in[15]; const float* cosI = (const float*)(F.ws + WS_COSI); const float* sinI = (const float*)(F.ws + WS_SINI);
    for (int t0 = gw; t0 < S; t0 += 4 * NGW) {
        float z[4], cs[4], sn[4], wv[4];
#pragma unroll
        for (int u = 0; u < 4; ++u) { const int t = (t0 + u * NGW < S) ? t0 + u * NGW : t0; z[u] = bf2f(SM[(size_t)t * 256 + l]); cs[u] = cosI[t * 16 + (l & 15)]; sn[u] = sinI[t * 16 + (l & 15)]; wv[u] = bf2f(SM[(size_t)t * 256 + 64 + (l & 15)]); }
        const float gl = kg[l], bl = kb[l];
#pragma unroll
        for (int u = 0; u < 4; ++u) {
            const int t = t0 + u * NGW;
            const float mu = wave_sum(z[u]) * (1.f / 64.f); const float dd = z[u] - mu;
            const float r = rsqrtf(wave_sum(dd * dd) * (1.f / 64.f) + NORM_EPS);
            const float y = dd * r * gl + bl;
            const float yp = __shfl(y, (l < 16) ? l + 16 : ((l < 32) ? l - 16 : l));
            float o; int pos;
            if (l < 16) { o = y * cs[u] - yp * sn[u]; pos = 2 * l; } else if (l < 32) { o = y * cs[u] + yp * sn[u]; pos = 2 * (l - 16) + 1; } else { o = y; pos = l; }
            if (t < S) {
                KIDX[(size_t)(t >> 5) * 2048 + (pos >> 4) * 512 + (((pos >> 3) & 1) * 32 + (t & 31)) * 8 + (pos & 7)] = (bf16)f2bf(o);
                if (l < 16) IDXW[t * 16 + l] = wv[u] * 0.03125f;
            }
        }
    }
}
__device__ __forceinline__ void p3_rt(const Frame& F, int pm, LAS float* rt) {
    const float* st2 = (const float*)(F.ws + WS_STATS2);
    if (F.tid < 256) {
        const f32x4 a = *(const f32x4*)(st2 + (size_t)(pm * 256 + F.tid) * 8), b = *(const f32x4*)(st2 + (size_t)(pm * 256 + F.tid) * 8 + 4);
        const float ss = ((a.x + a.y) + (a.z + a.w)) + ((b.x + b.y) + (b.z + b.w));
        rt[F.tid] = rsqrtf(ss * (1.f / QL) + NORM_EPS);
    }
}
typedef float f32x16 __attribute__((ext_vector_type(16)));
__device__ __forceinline__ float key2f(unsigned k) { return __uint_as_float((k & 0x80000000u) ? (k ^ 0x80000000u) : ~k); }
__device__ __forceinline__ unsigned f2key(float f) { const unsigned b = __float_as_uint(f); return b ^ ((b >> 31) ? 0xFFFFFFFFu : 0x80000000u); }
__device__ __forceinline__ int wave_isum(int v) {
#pragma unroll
    for (int o = 1; o < 64; o <<= 1) v += __shfl_xor(v, o);
    return v;
}
__device__ __forceinline__ int idx_count_ge(const LAS f32x4* row4, int n256, float p, int lane) {
    int c = 0;
    for (int it = 0; it < n256; ++it) { const f32x4 v = row4[it * 64 + lane]; c += (v.x >= p ? 1 : 0) + (v.y >= p ? 1 : 0) + (v.z >= p ? 1 : 0) + (v.w >= p ? 1 : 0); }
    return wave_isum(c);
}
constexpr int IDX_NBIN = 1024;
constexpr float IDX_ZOOM = 4.0f;
__device__ __forceinline__ float relu_asm(float x) { const int b = __float_as_int(x); return __int_as_float(b > 0 ? b : 0); }
__device__ __forceinline__ float idx_kmax(const Frame& F) {
    const float g = fabsf(F.in[14][F.lane]), b = F.in[15][F.lane];
    return wave_max(g) * 8.0f + sqrtf(wave_sum(b * b));
}
template <bool FIRST>
__device__ __forceinline__ void p_rows(const Frame& F) {
    const int gw = F.vcu * NWAVES + F.wave, NGW = F.G * NWAVES;
    const float* mod = (const float*)(F.ws + WS_MOD);
    const float* gpost = F.in[5]; const float* gate = mod + 2 * D;
    const bf16* ysrc = (const bf16*)(F.ws + WS_F); const float* xsrc = F.in[0];
    bf16* H2 = (bf16*)(F.ws + WS_H);
    for (int m = gw; m < S; m += NGW) {
        const unsigned long long* yr = (const unsigned long long*)(ysrc + (size_t)m * D) + F.lane; const f32x4* xr = (const f32x4*)(xsrc + (size_t)m * D) + F.lane;
        f32x4 v[8]; float ss = 0.f;
#pragma unroll
        for (int j = 0; j < 8; ++j) { const unsigned long long yw = yr[64 * j]; const unsigned ylo = (unsigned)yw, yhi = (unsigned)(yw >> 32);
            v[j] = (f32x4){bflo(ylo), bfhi(ylo), bflo(yhi), bfhi(yhi)}; ss += (v[j].x * v[j].x + v[j].y * v[j].y) + (v[j].z * v[j].z + v[j].w * v[j].w); }
        f32x4 f[8]; float sf = 0.f;
        if (!FIRST) {
            const unsigned long long* fr = (const unsigned long long*)((const bf16*)(F.ws + WS_F2) + (size_t)m * D) + F.lane;
#pragma unroll
            for (int j = 0; j < 8; ++j) { const unsigned long long yw = fr[64 * j]; const unsigned ylo = (unsigned)yw, yhi = (unsigned)(yw >> 32);
                f[j] = (f32x4){bflo(ylo), bfhi(ylo), bflo(yhi), bfhi(yhi)}; sf += (f[j].x * f[j].x + f[j].y * f[j].y) + (f[j].z * f[j].z + f[j].w * f[j].w); }
        }
        const float r = rsqrtf(wave_sum(ss) * (1.f / D) + NORM_EPS);
        float s2 = 0.f;
#pragma unroll
        for (int j = 0; j < 8; ++j) {
            const int n = 4 * F.lane + 256 * j;
            const f32x4 gg = *(const f32x4*)(gpost + n), gt = *(const f32x4*)(gate + n);
            v[j] = xr[64 * j] + gt * (v[j] * r * gg);
            s2 += (v[j].x * v[j].x + v[j].y * v[j].y) + (v[j].z * v[j].z + v[j].w * v[j].w);
        }
        if (FIRST) {
            const float r2 = rsqrtf(wave_sum(s2) * (1.f / D) + NORM_EPS);
            const float* g2 = F.in[19];
            unsigned long long* o8 = (unsigned long long*)(H2 + (size_t)m * D) + F.lane;
#pragma unroll
            for (int j = 0; j < 8; ++j) {
                const int n = 4 * F.lane + 256 * j;
                const f32x4 gg = *(const f32x4*)(g2 + n), sh = *(const f32x4*)(mod + 3 * D + n), sc = *(const f32x4*)(mod + 4 * D + n);
                const f32x4 o = v[j] * r2 * gg * (sc + 1.0f) + sh;
                o8[64 * j] = (unsigned long long)pk2(o.x, o.y) | ((unsigned long long)pk2(o.z, o.w) << 32);
            }
        } else {
            const float rf = rsqrtf(wave_sum(sf) * (1.f / D) + NORM_EPS);
            const float* gpf = F.in[20]; const float* gatef = mod + 5 * D;
            f32x4* orow = (f32x4*)(F.out + (size_t)m * D) + F.lane;
#pragma unroll
            for (int j = 0; j < 8; ++j) {
                const int n = 4 * F.lane + 256 * j;
                const f32x4 gg = *(const f32x4*)(gpf + n), gt = *(const f32x4*)(gatef + n);
                orow[64 * j] = v[j] + gt * (f[j] * rf * gg);
            }
        }
    }
}
constexpr int X8_CAP = 128;
constexpr int X8_HIST_OFF = AUX_OFF, X8_MASKW_OFF = X8_HIST_OFF + 8 * (IDX_NBIN / 2) * 4, X8_CI_OFF = X8_MASKW_OFF + 8 * 128 * 8, X8_CX_OFF = X8_CI_OFF + 8 * X8_CAP * 2, X8_END = X8_CX_OFF + 8 * X8_CAP * 4;
constexpr int X8_SCALE_OFF = LDSCTL_OFF + 512, X8_CNT_OFF = X8_SCALE_OFF + 32, X8_FB_OFF = X8_CNT_OFF + 32;
constexpr int X8_WQ_OFF = X8_END;
static_assert(X8_WQ_OFF + 512 <= LDS_BYTES && X8_END <= LDS_BYTES && 8 * 8192 * 2 <= RING_BYTES && X8_FB_OFF + 32 <= LDSCTL_OFF + 640, "8-query indexer LDS map");
struct X8Regs { bf16x8 a[4][4]; f32x4 wq[4][4]; bf16x8 bA[4], bB[4], bC[4]; };
#define X8_ZERO16 ((f32x16){0.f, 0.f, 0.f, 0.f, 0.f, 0.f, 0.f, 0.f, 0.f, 0.f, 0.f, 0.f, 0.f, 0.f, 0.f, 0.f})
#define X8_HEADSUM(S_, WQ_, DD_) do { S_ = 0.f; _Pragma("unroll") for (int i_ = 0; i_ < 16; ++i_) S_ = __builtin_fmaf((WQ_)[i_ >> 2][i_ & 3], relu_asm((DD_)[i_]), S_); S_ += 0.0f; } while (0)
__device__ __forceinline__ unsigned x8_y16(float s, float scale64) { const unsigned u = (unsigned)fmaxf(fmaf(s, scale64, 64.0f * (float)(IDX_NBIN / 2)), 0.0f); return u < 65535u ? u : 65535u; }
__device__ __forceinline__ void x8_prefetch(const Frame& F, int t0, X8Regs& R) {
    const bf16* QIDX = (const bf16*)(F.ws + WS_QIDX); const bf16* KIDX = (const bf16*)(F.ws + WS_KIDX);
    const int lane = F.lane, r = lane & 31, hh = lane >> 5, w = F.wave, NT = t0 / 32 + 1;
#define X8_LOAD0(B_, kt_) do { const int ktc_ = (kt_) < NT ? (kt_) : NT - 1; \
        _Pragma("unroll") for (int ks = 0; ks < 4; ++ks) B_[ks] = *(const bf16x8*)(KIDX + (size_t)ktc_ * 2048 + ks * 512 + lane * 8); } while (0)
    X8_LOAD0(R.bA, w); X8_LOAD0(R.bB, w + 8); X8_LOAD0(R.bC, w + 16);
#undef X8_LOAD0
#pragma unroll
    for (int m = 0; m < 4; ++m) {
        const int tq = t0 + 2 * m + ((r >> 2) & 1), head = (r & 3) + 4 * (r >> 3);
#pragma unroll
        for (int ks = 0; ks < 4; ++ks) R.a[m][ks] = *(const bf16x8*)(QIDX + (size_t)tq * 1024 + head * 64 + 16 * ks + 8 * hh);
    }
}
__device__ __forceinline__ void x8_stage_wq(const Frame& F, int t0) { if (F.tid < 128) ((LAS float*)(F.lds + X8_WQ_OFF))[F.tid] = ((const float*)(F.ws + WS_IDXW))[t0 * 16 + F.tid]; }
__device__ __forceinline__ void x8_fetch_wq(const Frame& F, X8Regs& R) {
    const LAS f32x4* wl = (const LAS f32x4*)(F.lds + X8_WQ_OFF) + (F.lane >> 5) * 4;
#pragma unroll
    for (int m = 0; m < 4; ++m)
#pragma unroll
        for (int i4 = 0; i4 < 4; ++i4) R.wq[m][i4] = wl[m * 8 + i4];
}
__device__ __forceinline__ float x8_score_q(const X8Regs& R, int qi, const bf16x8 (&Bg)[4]) {
    float s = 0.f;
#define X8_CASE(M_) { asm volatile("; x8 row tile %0" :: "n"(M_));     \
        f32x16 d_ = X8_ZERO16; _Pragma("unroll") for (int ks = 0; ks < 4; ++ks) d_ = __builtin_amdgcn_mfma_f32_32x32x16_bf16(R.a[M_][ks], Bg[ks], d_, 0, 0, 0); X8_HEADSUM(s, R.wq[M_], d_); asm volatile("; x8 row tile %0 done" :: "n"(M_), "v"(s)); }
    const int m = qi >> 1;
    if (m == 0) X8_CASE(0) else if (m == 1) X8_CASE(1) else if (m == 2) X8_CASE(2) else X8_CASE(3)
#undef X8_CASE
    return s;
}
template <int G>
__device__ __forceinline__ void x8_pass_group(const LAS unsigned short* rp, unsigned thrLo, unsigned thrHi, unsigned& hlo, unsigned& hhi, unsigned& clo, unsigned& chi) {
    unsigned xv[8];
#pragma unroll
    for (int u = 0; u < 8; ++u) xv[u] = rp[512 * G + 64 * u];
    __builtin_amdgcn_sched_barrier(0);
#define X8_W(u_) { const unsigned long long hiw = __ballot(xv[u_] >= thrHi), cw = __ballot(xv[u_] >= thrLo) & ~hiw; \
        asm("s_nop 0\n\tv_writelane_b32 %0, %4, %8\n\tv_writelane_b32 %1, %5, %8\n\tv_writelane_b32 %2, %6, %8\n\tv_writelane_b32 %3, %7, %8" \
            : "+v"(hlo), "+v"(hhi), "+v"(clo), "+v"(chi) : "s"((unsigned)hiw), "s"((unsigned)(hiw >> 32)), "s"((unsigned)cw), "s"((unsigned)(cw >> 32)), "n"((8 * G + u_) & 63)); }
    X8_W(0) X8_W(1) X8_W(2) X8_W(3) X8_W(4) X8_W(5) X8_W(6) X8_W(7)
#undef X8_W
}
__device__ __forceinline__ void x8_zero_hist(const Frame& F) { LAS unsigned* hist = (LAS unsigned*)(F.lds + X8_HIST_OFF); for (int i = F.tid; i < 8 * (IDX_NBIN / 2); i += 512) hist[i] = 0u; }
__device__ __forceinline__ void x8_item(const Frame& F, int t0, int t0n, float kmax, X8Regs& R) {
    LAS unsigned short* sc = (LAS unsigned short*)(F.lds + RING_OFF);
    LAS unsigned* hist = (LAS unsigned*)(F.lds + X8_HIST_OFF);
    LAS unsigned* ccount = (LAS unsigned*)(F.lds + X8_CNT_OFF);
    LAS unsigned* fbflag = (LAS unsigned*)(F.lds + X8_FB_OFF);
    const bf16* KIDX = (const bf16*)(F.ws + WS_KIDX);
    const int w = F.wave;
    const int NT = t0 / 32 + 1;
    {
        const int lane = F.lane, r = lane & 31, hh = lane >> 5;
        float bs[4];
        x8_fetch_wq(F, R);
        bf16x8 (&a)[4][4] = R.a; f32x4 (&wq)[4][4] = R.wq;
#pragma unroll
        for (int m = 0; m < 4; ++m) {
            const int tq = t0 + 2 * m + ((r >> 2) & 1), head = (r & 3) + 4 * (r >> 3);
            float ss = 0.f;
#pragma unroll
            for (int ks = 0; ks < 4; ++ks) { const v4u x = __builtin_bit_cast(v4u, a[m][ks]); const unsigned ww[4] = {x.x, x.y, x.z, x.w};
#pragma unroll
                for (int e = 0; e < 4; ++e) ss += bflo(ww[e]) * bflo(ww[e]) + bfhi(ww[e]) * bfhi(ww[e]); }
            ss += __shfl_xor(ss, 32);
            float term = sqrtf(ss) * fabsf(((const LAS float*)(F.lds + X8_WQ_OFF))[(tq - t0) * 16 + head]);
            term += __shfl_xor(term, 1); term += __shfl_xor(term, 2); term += __shfl_xor(term, 8); term += __shfl_xor(term, 16);
            const float scl = (float)(IDX_NBIN / 2 - 1) / (term * kmax * (1.03f / IDX_ZOOM) + 1e-30f);
            const float other = __shfl_xor(scl, 4);
            const float s_even = ((r >> 2) & 1) ? other : scl, s_odd = ((r >> 2) & 1) ? scl : other;
            bs[m] = 64.0f * (hh ? s_odd : s_even);
        }
#define X8_LOAD(B_, kt_) do { const int ktc_ = (kt_) < NT ? (kt_) : NT - 1;     \
        _Pragma("unroll") for (int ks = 0; ks < 4; ++ks) B_[ks] = *(const bf16x8*)(KIDX + (size_t)ktc_ * 2048 + ks * 512 + lane * 8); } while (0)
#define X8_COMP_(B_, kt_, MASKED_) do { \
            _Pragma("unroll") for (int m = 0; m < 4; ++m) { \
                f32x16 dd = X8_ZERO16;     \
                _Pragma("unroll") for (int ks = 0; ks < 4; ++ks) dd = __builtin_amdgcn_mfma_f32_32x32x16_bf16(a[m][ks], B_[ks], dd, 0, 0, 0); \
                float s; X8_HEADSUM(s, wq[m], dd); \
                const int key = 32 * (kt_) + r, q = 2 * m + hh; const bool ok = !(MASKED_) || key <= t0 + q; \
                const unsigned u = x8_y16(s, bs[m]); \
                sc[q * 8192 + key] = (unsigned short)(ok ? u : 0u); \
                if (ok) __hip_atomic_fetch_add(hist + q * (IDX_NBIN / 2) + (u >> 7), 1u + 0xFFFFu * ((u >> 6) & 1u), __ATOMIC_RELAXED, __HIP_MEMORY_SCOPE_WORKGROUP); \
                __builtin_amdgcn_sched_barrier(0); } } while (0)
#define X8_COMP(B_, kt_) do { if ((kt_) < NT - 1) X8_COMP_(B_, kt_, 0); else if ((kt_) < NT) X8_COMP_(B_, kt_, 1); } while (0)
#define X8_PIN() __builtin_amdgcn_sched_barrier(0)
        bf16x8 (&bA)[4] = R.bA, (&bB)[4] = R.bB, (&bC)[4] = R.bC;
        X8_PIN();
        for (int kt = w; kt < NT; kt += 24) {
            X8_COMP(bA, kt); X8_PIN(); X8_LOAD(bA, kt + 24); X8_PIN();
            X8_COMP(bB, kt + 8); X8_PIN(); X8_LOAD(bB, kt + 32); X8_PIN();
            X8_COMP(bC, kt + 16); X8_PIN(); X8_LOAD(bC, kt + 40); X8_PIN();
        }
        X8_PIN();
#undef X8_PIN
#undef X8_LOAD
#undef X8_COMP
#undef X8_COMP_
    }
    int lane_o = F.lane; asm volatile("" : "+v"(lane_o));
    const int lane = lane_o, r = lane & 31, hh = lane >> 5;
    if (F.tid < 8) { ccount[F.tid] = 0u; fbflag[F.tid] = 0u; }
    if ((NT & 1) && F.tid < 256) sc[(F.tid >> 5) * 8192 + 32 * NT + (F.tid & 31)] = 0;
    LDS_WAIT(); __syncthreads();
    const int q = w, t = t0 + q, n = t + 1, nw = (n + 63) >> 6;
    LAS unsigned long long* mw = (LAS unsigned long long*)(F.lds + X8_MASKW_OFF) + q * 128;
    LAS unsigned short* ci = (LAS unsigned short*)(F.lds + X8_CI_OFF) + q * X8_CAP;
    LAS float* cx = (LAS float*)(F.lds + X8_CX_OFF) + q * X8_CAP;
    {
        LAS unsigned* hq = hist + q * (IDX_NBIN / 2);
        int Bbin = 0, inB = 0, need = 0; bool usehist = false;
        constexpr int BPL = IDX_NBIN / 64;
        static_assert(BPL == 16, "16 bins = 8 packed words per lane");
        {
            LAS v4u* h4 = (LAS v4u*)hq + 2 * lane;
            int hv[BPL];
#pragma unroll
            for (int q4 = 0; q4 < 2; ++q4) { const v4u hh4 = h4[q4]; const unsigned pw[4] = {hh4.x, hh4.y, hh4.z, hh4.w};
#pragma unroll
                for (int e = 0; e < 4; ++e) { hv[8 * q4 + 2 * e] = (int)(pw[e] & 0xffffu); hv[8 * q4 + 2 * e + 1] = (int)(pw[e] >> 16); } }
            h4[0] = (v4u){0u, 0u, 0u, 0u}; h4[1] = (v4u){0u, 0u, 0u, 0u};
            if (t >= 256) {
                int mine = 0;
#pragma unroll
                for (int e = 0; e < BPL; ++e) mine += hv[e];
                int suf = mine;
#pragma unroll
                for (int o = 1; o < 64; o <<= 1) { const int v = __shfl_down(suf, o); if (lane + o < 64) suf += v; }
                const unsigned long long ge = __ballot(suf >= 256);
                const int L = 63 - __builtin_clzll(ge);
                int acc = suf - mine, bsel = 0, csel = 0, asel = 0; bool found = false;
#pragma unroll
                for (int e = BPL - 1; e >= 0; --e) { const bool hit = !found && (acc + hv[e] >= 256); bsel = hit ? e : bsel; csel = hit ? hv[e] : csel; asel = hit ? acc : asel; found = found || hit; acc += hv[e]; }
                Bbin = BPL * L + __builtin_amdgcn_readlane(bsel, L); inB = __builtin_amdgcn_readlane(csel, L);
                need = 256 - __builtin_amdgcn_readlane(asel, L);
                usehist = inB <= X8_CAP && Bbin >= 1;
            }
        }
        if (usehist) {
            const unsigned thrLo = (unsigned)Bbin << 6, thrHi = ((unsigned)Bbin + 1u) << 6;
            unsigned h0l = 0u, h0h = 0u, c0l = 0u, c0h = 0u, h1l = 0u, h1h = 0u, c1l = 0u, c1h = 0u;
            const LAS unsigned short* rp = sc + q * 8192 + lane;
#define X8_G0(G_) if (nw > 8 * (G_)) x8_pass_group<G_>(rp, thrLo, thrHi, h0l, h0h, c0l, c0h);
#define X8_G1(G_) if (nw > 8 * (G_)) x8_pass_group<G_>(rp, thrLo, thrHi, h1l, h1h, c1l, c1h);
            X8_G0(0) X8_G0(1) X8_G0(2) X8_G0(3) X8_G0(4) X8_G0(5) X8_G0(6) X8_G0(7) X8_G1(8) X8_G1(9) X8_G1(10) X8_G1(11) X8_G1(12) X8_G1(13) X8_G1(14) X8_G1(15)
#undef X8_G0
#undef X8_G1
            const bool v0 = lane < nw, v1 = 64 + lane < nw;
            mw[lane] = v0 ? (((unsigned long long)h0h << 32) | h0l) : 0ull; mw[64 + lane] = v1 ? (((unsigned long long)h1h << 32) | h1l) : 0ull;
            unsigned long long cw0 = v0 ? (((unsigned long long)c0h << 32) | c0l) : 0ull, cw1 = v1 ? (((unsigned long long)c1h << 32) | c1l) : 0ull;
            const int nc = __builtin_popcountll(cw0) + __builtin_popcountll(cw1);
            if (nc) {
                int off = (int)__hip_atomic_fetch_add(ccount + q, (unsigned)nc, __ATOMIC_RELAXED, __HIP_MEMORY_SCOPE_WORKGROUP);
                while (cw0) { ci[off++] = (unsigned short)(64 * lane + __builtin_ctzll(cw0)); cw0 &= cw0 - 1ull; }
                while (cw1) { ci[off++] = (unsigned short)(64 * (64 + lane) + __builtin_ctzll(cw1)); cw1 &= cw1 - 1ull; }
            }
            LDS_WAIT();
            const int cnt = (int)*(volatile LAS unsigned*)(ccount + q);
            for (int c0 = 0; c0 < cnt; c0 += 32) {
                const int idx = c0 + r; const int key = idx < cnt ? (int)ci[idx] : 0;
                const bf16* kp = KIDX + (size_t)(key >> 5) * 2048 + (hh * 32 + (key & 31)) * 8;
                bf16x8 Bg[4];
#pragma unroll
                for (int ks = 0; ks < 4; ++ks) Bg[ks] = *(const bf16x8*)(kp + ks * 512);
                const float s = x8_score_q(R, q, Bg);
                if (hh == (q & 1) && idx < cnt) cx[idx] = s;
            }
            LDS_WAIT();
            for (int i0 = 0; i0 < cnt; i0 += 64) {
                const int i = i0 + lane; const bool act = i < cnt;
                const int ii = act ? (int)ci[i] : 0; const float xi = act ? cx[i] : 0.f;
                int rank = 0;
                for (int cb = 0; cb < cnt; cb += 64) {
                    const int jl = cb + lane; const bool jact = jl < cnt; const int ijv = jact ? (int)ci[jl] : 0; const float xjv = jact ? cx[jl] : 0.f;
                    const int cn = (cnt - cb < 64) ? cnt - cb : 64;
                    for (int l = 0; l < cn; ++l) {
                        const float xj = __builtin_bit_cast(float, __builtin_amdgcn_readlane(__builtin_bit_cast(int, xjv), l)); const int ij = __builtin_amdgcn_readlane(ijv, l);
                        rank += (xj > xi || (xj == xi && ij < ii)) ? 1 : 0;
                    }
                }
                if (act && rank < need) __hip_atomic_fetch_or(mw + (ii >> 6), 1ull << (ii & 63), __ATOMIC_RELAXED, __HIP_MEMORY_SCOPE_WORKGROUP);
            }
        } else if (t < 256) {
#pragma unroll
            for (int hf = 0; hf < 2; ++hf) { const int j = 64 * hf + lane; unsigned long long wv = 0ull;
                if (64 * j <= t) wv = (t - 64 * j >= 63) ? ~0ull : ((1ull << (t - 64 * j + 1)) - 1ull);
                mw[j] = wv; }
        } else if (lane == 0) fbflag[q] = 1u;
    }
    LDS_WAIT(); __syncthreads();
    {
        unsigned anyfb = 0u;
#pragma unroll
        for (int qf = 0; qf < 8; ++qf) anyfb |= fbflag[qf];
        if (anyfb) {
            LAS float* row = (LAS float*)(F.lds + RING_OFF);
            for (int qf = 0; qf < 8; ++qf) {
                if (fbflag[qf] == 0u) continue;
                const int tf = t0 + qf, nf = tf + 1, nwf = (nf + 63) >> 6, n256 = (nf + 255) >> 8;
                for (int kt = w; kt < NT; kt += 8) {
                    bf16x8 Bg[4];
#pragma unroll
                    for (int ks = 0; ks < 4; ++ks) Bg[ks] = *(const bf16x8*)(KIDX + (size_t)kt * 2048 + ks * 512 + lane * 8);
                    const float s = x8_score_q(R, qf, Bg);
                    const int key = 32 * kt + r;
                    if (hh == (qf & 1)) row[key] = (key <= tf) ? s : -INFINITY;
                }
                for (int idx = 32 * NT + F.tid; idx < 256 * n256; idx += 512) row[idx] = -INFINITY;
                LDS_WAIT(); __syncthreads();
                if (w == 0) {
                    LAS unsigned long long* mwf = (LAS unsigned long long*)(F.lds + X8_MASKW_OFF) + qf * 128;
                    unsigned long long w0 = 0ull, w1 = 0ull;
                    const LAS f32x4* row4 = (const LAS f32x4*)row;
                    unsigned T = 0u; bool exact = false; float pf = 0.f;
                    for (int bit = 31; bit >= 0; --bit) {
                        const unsigned cand = T | (1u << bit);
                        const float p = key2f(cand);
                        const int c = idx_count_ge(row4, n256, p, lane);
                        if (c >= 256) { T = cand; pf = p; if (c == 256) { exact = true; break; } }
                    }
                    int need2 = 0;
                    if (!exact) {
                        int cg = 0;
                        for (int it = 0; it < n256; ++it) { const f32x4 v = row4[it * 64 + lane]; cg += (v.x > pf ? 1 : 0) + (v.y > pf ? 1 : 0) + (v.z > pf ? 1 : 0) + (v.w > pf ? 1 : 0); }
                        need2 = 256 - wave_isum(cg);
                    }
                    for (int j = 0; j < nwf; ++j) {
                        const float x = row[64 * j + lane];
                        unsigned long long b;
                        if (exact) b = __ballot(x >= pf);
                        else {
                            b = __ballot(x > pf);
                            unsigned long long eq = __ballot(x == pf);
                            while (need2 > 0 && eq) { const unsigned long long low = eq & (~eq + 1ull); b |= low; eq ^= low; --need2; }
                        }
                        if (lane == (j & 63)) { if (j < 64) w0 = b; else w1 = b; }
                    }
                    mwf[lane] = w0; mwf[64 + lane] = w1;
                }
                LDS_WAIT(); __syncthreads();
            }
        }
    }
    x8_prefetch(F, t0n, R);
    x8_stage_wq(F, t0n);
    {
        const LAS unsigned long long* mwa = (const LAS unsigned long long*)(F.lds + X8_MASKW_OFF);
        const int ntw = 4 * (t0 >> 8) + 4;
        for (int g = F.tid; g < ntw * 32; g += 512) {
            const int j = g >> 5, qq = (g >> 2) & 7, hs = g & 3;
            const unsigned nib = (unsigned)(mwa[qq * 128 + j] >> (32 * (hs & 1) + 4 * (hs >> 1)));
            v4u o;
#pragma unroll
            for (int k = 0; k < 4; ++k) { const unsigned b = (((nib >> (8 * k)) & 15u) * 0x00204081u) & 0x01010101u; o[k] = (b ^ 0x01010101u) * 0xFCu; }
            unsigned char* mb = F.ws + (j < 64 ? WS_MASKB0 : WS_MASKB1 - (size_t)64 * 524288) + (size_t)j * 524288 + (size_t)t0 * 64;
            *(v4u*)(mb + (g & 31) * 16) = o;
        }
    }
    __syncthreads();
}
namespace att {
constexpr int D = 128, PITCH = 1024, NW = 8, QBLK = 32, KVBLK = 64, QB = NW * QBLK;
constexpr int SHM_V = KVBLK * D * 2, SHM_K = KVBLK * D * 2;
constexpr int LDS_BYTES = 2 * SHM_V + 2 * SHM_K + NW * 64 * 4;
constexpr float SCALE = 0.08838834764831845f, THR = 8.f;
constexpr float C2 = 1.4426950408889634f * SCALE;
typedef unsigned short bf16;
typedef short bf16x8 __attribute__((ext_vector_type(8)));
typedef short s16x4 __attribute__((ext_vector_type(4)));
typedef float f32x16 __attribute__((ext_vector_type(16)));
typedef float f32x4 __attribute__((ext_vector_type(4)));
typedef float f32x2 __attribute__((ext_vector_type(2)));
typedef unsigned u32x4 __attribute__((ext_vector_type(4)));
typedef unsigned long long u64;
#define KSWZ(row, colB) ((row) * 256 + ((colB) ^ (((row) & 7) << 4)))
#define SBAR() __builtin_amdgcn_sched_barrier(0)
__device__ __forceinline__ int v_st(int k, int c) { const int kk = (k & ~0xC) | ((k & 4) << 1) | ((k & 8) >> 1); return ((kk >> 3) * 4 + (c >> 5)) * 512 + ((kk & 7) * 32 + (c & 31)) * 2; }
__device__ __forceinline__ int v_rd_base(int lane) { return ((lane & 3) << 3) | (((lane >> 2) & 3) << 6) | (((lane >> 4) & 1) << 5) | (((lane >> 5) & 1) << 8); }
constexpr int v_rd_off(int d0, int ks, int half) { return d0 * 512 + ks * 4096 + half * 2048; }
__device__ __forceinline__ int crow(int r, int hi) { return (r & 3) + 8 * (r >> 2) + 4 * hi; }
typedef __bf16 bf16x2_t __attribute__((ext_vector_type(2)));
__device__ __forceinline__ unsigned cvtpk(float lo, float hi) { const float __attribute__((ext_vector_type(2))) v = {lo, hi}; const bf16x2_t b = __builtin_convertvector(v, bf16x2_t); return __builtin_bit_cast(unsigned, b); }
__device__ __forceinline__ bf16x8 load8(const bf16* p) { return *reinterpret_cast<const bf16x8*>(p); }
__device__ __forceinline__ void partialSM(f32x16& p0, f32x16& p1, float& m_reg, float& mn, float& alpha) {
    float pmax = p0[0]; for (int r = 1; r < 16; ++r) pmax = fmaxf(pmax, p0[r]); for (int r = 0; r < 16; ++r) pmax = fmaxf(pmax, p1[r]);
    { auto rr = __builtin_amdgcn_permlane32_swap(__float_as_uint(pmax), __float_as_uint(pmax), false, false);
      pmax = fmaxf(__uint_as_float(rr[0]), __uint_as_float(rr[1])); }
    if (__builtin_expect(__all((pmax - m_reg) * SCALE <= THR), 1)) { mn = m_reg; alpha = 1.f; }
    else { mn = fmaxf(m_reg, pmax); alpha = __builtin_amdgcn_exp2f((m_reg - mn) * C2); m_reg = mn; }
    const float mnL = -mn * C2;
    for (int r = 0; r < 16; ++r) p0[r] = fmaf(p0[r], C2, mnL); for (int r = 0; r < 16; ++r) p1[r] = fmaf(p1[r], C2, mnL);
    for (int r = 0; r < 16; ++r) p0[r] = __builtin_amdgcn_exp2f(p0[r]);
}
__device__ __forceinline__ void finishSM(f32x16& p0, f32x16& p1, float alpha, float& l_reg, bf16x8& pa0, bf16x8& pa1, bf16x8& pa2, bf16x8& pa3) {
    for (int r = 0; r < 16; ++r) p1[r] = __builtin_amdgcn_exp2f(p1[r]);
    float ps = 0; for (int r = 0; r < 16; ++r) ps += p0[r]; for (int r = 0; r < 16; ++r) ps += p1[r];
    { auto rr = __builtin_amdgcn_permlane32_swap(__float_as_uint(ps), __float_as_uint(ps), false, false);
      ps = __uint_as_float(rr[0]) + __uint_as_float(rr[1]); }
    l_reg = l_reg * alpha + ps;
#define PK4(P, B_, OUT) do { unsigned a0 = cvtpk(P[B_+0], P[B_+1]), a1 = cvtpk(P[B_+2], P[B_+3]);                          \
        unsigned b0 = cvtpk(P[B_+4], P[B_+5]), b1 = cvtpk(P[B_+6], P[B_+7]);                                             \
        auto r0 = __builtin_amdgcn_permlane32_swap(a0, b0, false, false); auto r1 = __builtin_amdgcn_permlane32_swap(a1, b1, false, false); \
        u32x4 w = {r0[0], r1[0], r0[1], r1[1]}; OUT = *reinterpret_cast<bf16x8*>(&w); } while (0)
    PK4(p0, 0, pa0); PK4(p0, 8, pa1); PK4(p1, 0, pa2); PK4(p1, 8, pa3);
#undef PK4
}
template <int KB>
__device__ __forceinline__ void qkt(f32x16& p0, f32x16& p1, const char* K_lds, int r32, int hi, const bf16x8* qr, u32x4 wa, u32x4 wb) {
#pragma unroll
    for (int w4 = 0; w4 < 4; ++w4) {
        const f32x2 a0 = __builtin_amdgcn_cvt_pk_f32_bf8((int)wa[w4], false), a1 = __builtin_amdgcn_cvt_pk_f32_bf8((int)wa[w4], true);
        const f32x2 b0 = __builtin_amdgcn_cvt_pk_f32_bf8((int)wb[w4], false), b1 = __builtin_amdgcn_cvt_pk_f32_bf8((int)wb[w4], true);
        p0[4 * w4] = a0.x; p0[4 * w4 + 1] = a0.y; p0[4 * w4 + 2] = a1.x; p0[4 * w4 + 3] = a1.y;
        p1[4 * w4] = b0.x; p1[4 * w4 + 1] = b0.y; p1[4 * w4 + 2] = b1.x; p1[4 * w4 + 3] = b1.y;
    }
    const char* kb[4];
#pragma unroll
    for (int dd = 0; dd < 4; ++dd) kb[dd] = K_lds + KB * SHM_K + KSWZ(r32, (dd * 16 + hi * 8) * 2);
#pragma unroll
    for (int d0 = 0; d0 < 8; ++d0) { const char* a = kb[d0 & 3] + (d0 >> 2) * 128;
        bf16x8 b0 = *reinterpret_cast<const bf16x8*>(a);
        bf16x8 b1 = *reinterpret_cast<const bf16x8*>(a + 32 * 256);
        p0 = __builtin_amdgcn_mfma_f32_32x32x16_bf16(b0, qr[d0], p0, 0, 0, 0);
        p1 = __builtin_amdgcn_mfma_f32_32x32x16_bf16(b1, qr[d0], p1, 0, 0, 0); }
}
template <int VB>
__device__ __forceinline__ void pv_tile(f32x16* o, int vb0, bf16x8 pa0, bf16x8 pa1, bf16x8 pa2, bf16x8 pa3) {
#define TRRD(dst, off) asm volatile("ds_read_b64_tr_b16 %0, %1 offset:%2" : "=&v"(dst) : "v"(vb0), "i"(off) : "memory")
#define PV_D0(d0) do { s16x4 l0, l1, l2, l3, h0, h1, h2, h3; constexpr int b_ = VB * SHM_V + v_rd_off(d0, 0, 0); \
        TRRD(l0, b_); TRRD(h0, b_ + 2048); TRRD(l1, b_ + 4096); TRRD(h1, b_ + 6144); TRRD(l2, b_ + 8192); TRRD(h2, b_ + 10240); TRRD(l3, b_ + 12288); TRRD(h3, b_ + 14336); \
        asm volatile("s_waitcnt lgkmcnt(0)" ::: "memory"); SBAR();   \
        o[d0] = __builtin_amdgcn_mfma_f32_32x32x16_bf16(pa0, (bf16x8){l0[0], l0[1], l0[2], l0[3], h0[0], h0[1], h0[2], h0[3]}, o[d0], 0, 0, 0);   \
        o[d0] = __builtin_amdgcn_mfma_f32_32x32x16_bf16(pa1, (bf16x8){l1[0], l1[1], l1[2], l1[3], h1[0], h1[1], h1[2], h1[3]}, o[d0], 0, 0, 0);   \
        o[d0] = __builtin_amdgcn_mfma_f32_32x32x16_bf16(pa2, (bf16x8){l2[0], l2[1], l2[2], l2[3], h2[0], h2[1], h2[2], h2[3]}, o[d0], 0, 0, 0);   \
        o[d0] = __builtin_amdgcn_mfma_f32_32x32x16_bf16(pa3, (bf16x8){l3[0], l3[1], l3[2], l3[3], h3[0], h3[1], h3[2], h3[3]}, o[d0], 0, 0, 0); } while (0)
    PV_D0(0); PV_D0(1); PV_D0(2); PV_D0(3);
#undef PV_D0
#undef TRRD
}
struct BlockRef { int P0, j_lo, j_hi; int uid, pid; unsigned* cnt; };
struct Bufs { bf16* YBh; const char* Qh; const char* Kh; const char* Vh; const char* Mh0; const char* Mh1; };
__device__ __forceinline__ bf16x8 bload8(__amdgpu_buffer_rsrc_t r, unsigned voff, unsigned soff) { return __builtin_bit_cast(bf16x8, __builtin_amdgcn_raw_buffer_load_b128(r, voff, soff, 0)); }
typedef unsigned u32x2 __attribute__((ext_vector_type(2)));
__device__ __forceinline__ u64 bload_u64(__amdgpu_buffer_rsrc_t r, unsigned voff, unsigned soff) { const u32x2 w = __builtin_amdgcn_raw_buffer_load_b64(r, voff, soff, 0); return (u64)w.x | ((u64)w.y << 32); }
struct Seam { bf16x8 qr[8]; bf16x8 st_v0, st_v1, st_k0, st_k1; };
#define VMW() asm volatile("s_waitcnt vmcnt(0)" ::: "memory")
#define VMWN(n) asm volatile("s_waitcnt vmcnt(%0)" :: "i"(n) : "memory")
#define GLD8(base_, voff_) (*(const bf16x8*)((const char*)(base_) + (size_t)(unsigned)(voff_)))
#define SLOAD_H(k0) do { const char* kb_ = B.Kh + (size_t)(k0) * (PITCH * 2); const char* vb_ = B.Vh + (size_t)(k0) * (PITCH * 2);                    \
                         S.st_v0 = GLD8(vb_, voff); S.st_v1 = GLD8(vb_ + 32 * PITCH * 2, voff); S.st_k0 = GLD8(kb_, voff); S.st_k1 = GLD8(kb_ + 32 * PITCH * 2, voff); } while (0)
#define QLOAD(R_) do { const char* qb_ = B.Qh + (size_t)((R_).P0) * (PITCH * 2); _Pragma("unroll") for (int d0 = 0; d0 < 8; ++d0) S.qr[d0] = GLD8(qb_ + d0 * 32, voffq); } while (0)
#define SWRITE_HK(bf) do { *(bf16x8*)(K_lds + (bf) * SHM_K + kws) = S.st_k0; *(bf16x8*)(K_lds + (bf) * SHM_K + kws + 32 * 256) = S.st_k1; } while (0)
#define SWRITE_HV(bf) do { *(bf16x8*)(V_lds + (bf) * SHM_V + vst0) = S.st_v0; *(bf16x8*)(V_lds + (bf) * SHM_V + vst1) = S.st_v1; } while (0)
#define SWRITE_H(bf) do { SWRITE_HV(bf); SWRITE_HK(bf); } while (0)
__device__ __forceinline__ void prime(const BlockRef& cur, const Bufs& B, char* lds, Seam& S) {
    const int tid = threadIdx.x, wid = __builtin_amdgcn_readfirstlane(tid >> 6), lane = tid & 63, r32 = lane & 31, hi = lane >> 5;
    const int sr = tid >> 4, sc = (tid & 15) * 8, kws = KSWZ(sr, sc * 2); char* K_lds = lds + 2 * SHM_V;
    const unsigned voff = (unsigned)(sr * PITCH + sc) * 2u, voffq = (unsigned)((wid * QBLK + r32) * PITCH + hi * 8) * 2u;
    const int kb0 = cur.j_lo * KVBLK;
    QLOAD(cur);
    SLOAD_H(kb0); VMW(); SWRITE_HK(0);
    __syncthreads();
}
__device__ __forceinline__ void block(const BlockRef& cur, const BlockRef& nxt, const Bufs& B, float* PART, f32x2* ML, char* lds, Seam& S) {
    const int tid = threadIdx.x, wid = __builtin_amdgcn_readfirstlane(tid >> 6), lane = tid & 63, r32 = lane & 31, hi = lane >> 5;
    const int j_lo = cur.j_lo, NT = cur.j_hi - cur.j_lo;
    const int kbn = nxt.j_lo * KVBLK;
    char* V_lds = lds; char* K_lds = lds + 2 * SHM_V;
    float* ws = (float*)(lds + 2 * SHM_V + 2 * SHM_K) + wid * 64; float* li_l = ws, * al_l = ws + 32;
    float m_reg = -1e30f, l_reg = 0; f32x16 o[4] = {};
    const int sr = tid >> 4, sc = (tid & 15) * 8, vst0 = v_st(sr, sc), vst1 = v_st(32 + sr, sc), kws = KSWZ(sr, sc * 2);
    const int vb0 = (int)(uintptr_t)V_lds + v_rd_base(lane);
    const unsigned voff = (unsigned)(sr * PITCH + sc) * 2u, voffq = (unsigned)((wid * QBLK + r32) * PITCH + hi * 8) * 2u;
    const unsigned voffm = (unsigned)((wid * QBLK + r32) * 64 + hi * 32);
#define MBASE(t) (((j_lo + (t)) < 64 ? B.Mh0 : B.Mh1) + (size_t)(j_lo + (t)) * 524288u + (size_t)cur.P0 * 64u)
#define MLOAD(WA, WB, t) do { const char* mb_ = MBASE(t); WA = *(const u32x4*)(mb_ + (size_t)voffm); WB = *(const u32x4*)(mb_ + 16 + (size_t)voffm); } while (0)
#define RESC(a) do { if (__any((a) < 1.f)) { if (hi == 0) al_l[r32] = (a); asm volatile("s_waitcnt lgkmcnt(0)" ::: "memory");              \
                     for (int d_ = 0; d_ < 4; ++d_) for (int r = 0; r < 16; ++r) o[d_][r] *= al_l[crow(r, hi)]; } } while (0)
#define KBASE(t) ((j_lo + (t)) * KVBLK)
    constexpr int NQL = 8;
#define SEAM_K0() do { VMWN(NQL); SWRITE_HK(0); SBAR(); } while (0)
    f32x16 pA0, pA1, pB0, pB1; float mnA, mnB, alA, alB; bf16x8 pa0, pa1, pa2, pa3;
    u32x4 wcA, wcB, wnA = {0u, 0u, 0u, 0u}, wnB = {0u, 0u, 0u, 0u}; MLOAD(wcA, wcB, 0);
    SWRITE_HV(0); SBAR();
    if (NT > 1) { SLOAD_H(KBASE(1)); MLOAD(wnA, wnB, 1); }
    SBAR(); qkt<0>(pA0, pA1, K_lds, r32, hi, S.qr, wcA, wcB);
    partialSM(pA0, pA1, m_reg, mnA, alA);
    if (NT > 1) { VMW(); SWRITE_H(1); }
    __syncthreads();
#define HALF_STEP(PX0, PX1, mnX, alX, PY0, PY1, alY, t, KB, VB, SB) do {                                                      \
        wcA = wnA; wcB = wnB;                                                                                                 \
        SBAR(); qkt<KB>(PX0, PX1, K_lds, r32, hi, S.qr, wcA, wcB);                                                           \
        finishSM(PY0, PY1, alY, l_reg, pa0, pa1, pa2, pa3); SBAR();                                                           \
        if ((t) + 1 < NT) { SLOAD_H(KBASE((t) + 1)); MLOAD(wnA, wnB, (t) + 1); SBAR(); }               \
        pv_tile<VB>(o, vb0, pa0, pa1, pa2, pa3); partialSM(PX0, PX1, m_reg, mnX, alX);                                        \
        __syncthreads();                                                                                                      \
        if ((t) + 1 < NT) { VMW(); SWRITE_H(SB); }                                                                            \
        RESC(alX); __syncthreads(); } while (0)
    for (int t = 1; t + 1 < NT; t += 2) {
        HALF_STEP(pB0, pB1, mnB, alB, pA0, pA1, alA, t, 1, 0, 0);
        HALF_STEP(pA0, pA1, mnA, alA, pB0, pB1, alB, t + 1, 0, 1, 1);
    }
    const bool even = (NT & 1) == 0;
    if (even) { wcA = wnA; wcB = wnB; SBAR(); qkt<1>(pB0, pB1, K_lds, r32, hi, S.qr, wcA, wcB); SBAR(); }
    SLOAD_H(kbn); SBAR();
    QLOAD(nxt);
    SBAR();
    finishSM(pA0, pA1, alA, l_reg, pa0, pa1, pa2, pa3); SBAR();
    pv_tile<0>(o, vb0, pa0, pa1, pa2, pa3);
    if (even) { partialSM(pB0, pB1, m_reg, mnB, alB); __syncthreads(); RESC(alB);
        finishSM(pB0, pB1, alB, l_reg, pa0, pa1, pa2, pa3); SBAR(); pv_tile<1>(o, vb0, pa0, pa1, pa2, pa3); }
    SBAR(); SEAM_K0();
    {
        float* po = PART + ((size_t)cur.uid * NW + wid) * 4096 + lane;
#pragma unroll
        for (int r = 0; r < 16; ++r)
#pragma unroll
            for (int d0 = 0; d0 < 4; ++d0) po[(r * 4 + d0) * 64] = o[d0][r];
        ML[((size_t)cur.uid * NW + wid) * 64 + lane] = (f32x2){m_reg, l_reg};
    }
    VMW();
    __syncthreads();
    unsigned* flag = (unsigned*)(lds + 2 * SHM_V + 2 * SHM_K + NW * 64 * 4);
    if (tid == 0) {
        __builtin_amdgcn_fence(__ATOMIC_RELEASE, "agent");
        asm volatile("s_waitcnt vmcnt(0)" ::: "memory");
        const unsigned old = __hip_atomic_fetch_add(cur.cnt, 1u, __ATOMIC_RELAXED, __HIP_MEMORY_SCOPE_AGENT);
        if (old == 1u) { __builtin_amdgcn_fence(__ATOMIC_ACQUIRE, "agent"); asm volatile("s_waitcnt vmcnt(0)" ::: "memory"); }
        *flag = old;
    }
    asm volatile("s_waitcnt lgkmcnt(0)" ::: "memory");
    __syncthreads();
    const bool last = (*(volatile unsigned*)flag) == 1u;
    if (last) {
        const f32x2 ml2 = ML[((size_t)cur.pid * NW + wid) * 64 + lane];
        const float m2 = ml2.x, l2 = ml2.y, mm = fmaxf(m_reg, m2);
        const float a1 = __builtin_amdgcn_exp2f((m_reg - mm) * C2), a2 = __builtin_amdgcn_exp2f((m2 - mm) * C2);
        const float linv = __builtin_amdgcn_rcpf(__fadd_rn(__fmul_rn(l_reg, a1), __fmul_rn(l2, a2)));
        if (hi == 0) { li_l[r32] = a1 * linv; al_l[r32] = a2 * linv; }
        asm volatile("s_waitcnt lgkmcnt(0)" ::: "memory");
        float o2[64];
        { const float* pp = PART + ((size_t)cur.pid * NW + wid) * 4096 + lane;
#pragma unroll
        for (int i = 0; i < 64; ++i) o2[i] = pp[i * 64]; }
#pragma unroll
        for (int r = 0; r < 16; ++r) { const int orow = crow(r, hi); const float f1 = li_l[orow], f2 = al_l[orow];
#pragma unroll
            for (int d0 = 0; d0 < 4; ++d0) o2[r * 4 + d0] = __fadd_rn(__fmul_rn(o[d0][r], f1), __fmul_rn(o2[r * 4 + d0], f2)); }
        const unsigned vo = (unsigned)(hi * 4 * PITCH + r32) * 2u, so = (unsigned)(cur.P0 + wid * QBLK) * (PITCH * 2);
#pragma unroll
        for (int r = 0; r < 16; ++r)
#pragma unroll
            for (int d0 = 0; d0 < 4; ++d0) { const float v = o2[r * 4 + d0]; const float vn = __shfl_xor(v, 1);
                if ((r32 & 1) == 0) *(unsigned*)((char*)B.YBh + (size_t)(so + ((r & 3) + 8 * (r >> 2)) * (PITCH * 2) + d0 * 64) + vo) = cvtpk(v, vn); }
    }
    __syncthreads();
#undef RESC
#undef KBASE
#undef SEAM_K0
#undef HALF_STEP
#undef MLOAD
#undef MBASE
}
#undef QLOAD
#undef GLD8
#undef VMW
#undef VMWN
#undef SLOAD_H
#undef SWRITE_HK
#undef SWRITE_HV
#undef SWRITE_H
#undef KSWZ
#undef SBAR
}
struct Args { const float* in[24]; float* out; unsigned char* ws; int ph_lo, ph_hi, li, pad; };
__global__ void __launch_bounds__(NWAVES * 64, 2) skel_fwd(Args args) {
    extern __shared__ __attribute__((aligned(16))) unsigned char lds[];
    Frame F;
    F.lds = (LAS unsigned char*)lds;
    F.MISC = (volatile LAS unsigned*)(F.lds + MISC_OFF);
    F.tid = threadIdx.x; F.lane = F.tid & 63; F.wave = __builtin_amdgcn_readfirstlane(F.tid >> 6);
    F.G = gridDim.x; { const int bx = blockIdx.x; F.vcu = (F.G % 8 == 0) ? (bx % 8) * (F.G / 8) + bx / 8 : bx; }
#pragma unroll
    for (int i = 0; i < 24; ++i) F.in[i] = args.in[i];
    F.out = args.out; F.ws = args.ws;
    F.ctl = (gu32*)(args.ws + WS_CTL);
    for (int u = F.tid; u < (LDS_BYTES - LDSCTL_OFF) / 4; u += NWAVES * 64) ((LAS unsigned*)(F.lds + LDSCTL_OFF))[u] = 0u;
    __syncthreads();
    XcdBarrier bar; bar.bar = (unsigned*)(F.ctl + CW_BAR); bar.x = 0; bar.st = nullptr;
    if (N_LAUNCHES == 1) bar = xcd_barrier_post((unsigned*)(F.ctl + CW_BAR), F.MISC + 8);
#define GRID_BAR() do { if (N_LAUNCHES == 1) xcd_barrier(bar); } while (0)
    const int lo = args.ph_lo, hi = args.ph_hi;
#define IN(k) (lo <= (k) && (k) < hi)
#define BOTH(k) (IN(k) && IN((k) + 1))
    unsigned char* ws = args.ws;
    const float* cosA = (const float*)(ws + WS_COSA); const float* sinA = (const float*)(ws + WS_SINA); const float* cosI = (const float*)(ws + WS_COSI); const float* sinI = (const float*)(ws + WS_SINI);

    if (IN(0)) { p0_prologue(F); if (BOTH(0)) GRID_BAR(); }
    if (IN(1)) { p1_prenorm(F); if (BOTH(1)) GRID_BAR(); }
    if (IN(2)) {
        pg8::Gemm g{(const pg8::bf16_t*)(ws + WS_H), (const pg8::bf16_t*)(ws + WS_WIN), S, NPROJ, D}; pg8::StaticOrder So; So.init(S, NPROJ, F.G, (int)blockIdx.x);
        pg8::EpiProj E{(pg8::bf16_t*)(ws + WS_U), (pg8::bf16_t*)(ws + WS_VG), (pg8::bf16_t*)(ws + WS_QLAT), (pg8::bf16_t*)(ws + WS_K), (pg8::bf16_t*)(ws + WS_V), (pg8::bf16_t*)(ws + WS_GATE), (pg8::bf16_t*)(ws + WS_SMALL),
                       (float*)(ws + WS_STATS), (float*)(ws + WS_STATS2), cosA, sinA};
        pg8::gemm_phase<pg8::EpiProj, pg8::StaticOrder, true, true>(F.lds + RING_OFF, g, So, E);
        { const int nun = (S / 256) * (NPROJ / 256), rem = nun % F.G;
          if (rem != 0 && (int)blockIdx.x >= rem) p_late_convert(F, 0, (int)blockIdx.x - rem, F.G - rem); else if (rem == 0) p_late_convert(F, 0, (int)blockIdx.x, F.G); }
        if (BOTH(2)) GRID_BAR();
    }
    if (IN(3)) {
        pg8::Gemm g{(const pg8::bf16_t*)(ws + WS_QLAT), (const pg8::bf16_t*)(ws + WS_WQQ), S, 2048, QL}; pg8::StaticOrder So; So.init(S, 2048, F.G, (int)blockIdx.x);
        LAS float* rt = (LAS float*)(F.lds + AUX_OFF);
        { pg8::Unit u0; if (So.next(0, u0)) p3_rt(F, u0.pm, rt); }
        LDS_WAIT(); __syncthreads();
        pg8::EpiQ E{(pg8::bf16_t*)(ws + WS_Q), (pg8::bf16_t*)(ws + WS_QIDX), (const PG8_LAS float*)rt, cosA, sinA, cosI, sinI, 1.0f};
        pg8::gemm_phase<pg8::EpiQ, pg8::StaticOrder, true, true>(F.lds + RING_OFF, g, So, E);
        __syncthreads();
        for (int it = F.vcu; it < 512; it += F.G) p3_spatial_item(F, it >> 3, it & 7);
        p3_kidx(F);
        if (BOTH(3)) GRID_BAR();
    }
    if (IN(4)) {
        const float kmax = idx_kmax(F);
        {
            X8Regs R;
#define P4_ITEM(rr_) ((rr_) * F.G + (((rr_) & 1) ? (F.G - 1 - F.vcu) : F.vcu))
            if (P4_ITEM(0) < S / 8) { x8_prefetch(F, 8 * P4_ITEM(0), R); x8_stage_wq(F, 8 * P4_ITEM(0)); }
            x8_zero_hist(F); LDS_WAIT(); __syncthreads();
            for (int rr = 0; rr * F.G < S / 8; ++rr) { const int it = P4_ITEM(rr), itn = P4_ITEM(rr + 1); if (it < S / 8) x8_item(F, 8 * it, (itn < S / 8) ? 8 * itn : 8 * it, kmax, R); }
#undef P4_ITEM
        }
        if (BOTH(4)) GRID_BAR();
    }
    if (IN(5)) {
        const int v = F.vcu & 255, h = v >> 5, i = v & 31, a = i & 15, zz = i >> 4;
        const att::bf16* Qb = (const att::bf16*)(ws + WS_Q); const att::bf16* Kb = (const att::bf16*)(ws + WS_K); const att::bf16* Vb = (const att::bf16*)(ws + WS_V); att::bf16* YB = (att::bf16*)(ws + WS_YB);
        att::BlockRef u0, u1;
#define MKREF(R, x_) do { const int x = (x_); R.P0 = 256 * x; const int half = 2 * (x + 1); R.j_lo = zz * half; R.j_hi = R.j_lo + half; R.uid = (h * 32 + x) * 2 + zz; R.pid = R.uid ^ 1; \
        R.cnt = (unsigned*)(F.ctl + CW_ATT) + (h * 32 + x) * 64; } while (0)
        MKREF(u0, a); MKREF(u1, 31 - a);
#undef MKREF
        att::Bufs B;
        B.YBh = YB + h * 128;
        B.Qh = (const char*)(Qb + h * 128); B.Kh = (const char*)(Kb + h * 128); B.Vh = (const char*)(Vb + h * 128); B.Mh0 = (const char*)(ws + WS_MASKB0); B.Mh1 = (const char*)(ws + WS_MASKB1) - (size_t)64 * 524288;
        att::Seam Sm;
        float* PART = F.out; att::f32x2* ML = (att::f32x2*)(ws + WS_WIN);
        { att::prime(u0, B, (char*)lds + RING_OFF, Sm);
        att::block(u0, u1, B, PART, ML, (char*)lds + RING_OFF, Sm);
        att::block(u1, u1, B, PART, ML, (char*)lds + RING_OFF, Sm); }
        if (BOTH(5)) GRID_BAR();
    }
    if (IN(6)) {
        pg8::Gemm g{(const pg8::bf16_t*)(ws + WS_U), (const pg8::bf16_t*)(ws + WS_WPA), S, D, GW, (const pg8::bf16_t*)(ws + WS_YB), (const pg8::bf16_t*)(ws + WS_WPB)};
        pg8::PairOrder So; So.init(S, D, F.G, (int)blockIdx.x);
        pg8::EpiGate2 E{(const pg8::bf16_t*)(ws + WS_GATE), (pg8::bf16_t*)(ws + WS_H)};
        pg8::gemm_phase<pg8::EpiGate2, pg8::PairOrder, true, true>(F.lds + RING_OFF, g, So, E);
    }
    if (IN(7)) { if (BOTH(7)) GRID_BAR(); }
    if (IN(8)) {
        pg8::Gemm g{(const pg8::bf16_t*)(ws + WS_H), (const pg8::bf16_t*)(ws + WS_WOUT), S, D, D}; pg8::StaticOrder So; So.init(S, D, F.G, (int)blockIdx.x);
        pg8::EpiOutBf16 E{(pg8::bf16_t*)(ws + WS_F)};
        pg8::gemm_phase<pg8::EpiOutBf16, pg8::StaticOrder, true, true>(F.lds + RING_OFF, g, So, E);
        if (BOTH(8)) GRID_BAR();
    }
    if (IN(9)) { p_rows<true>(F); if (BOTH(9)) GRID_BAR(); }
    if (IN(10)) {
        pg8::Gemm g{(const pg8::bf16_t*)(ws + WS_H), (const pg8::bf16_t*)(ws + WS_WGU), S, 2 * FF, D}; pg8::StaticOrder So; So.init(S, 2 * FF, F.G, (int)blockIdx.x);
        pg8::EpiSwiGLU E{(pg8::bf16_t*)(ws + WS_ACT), FF};
        pg8::gemm_phase<pg8::EpiSwiGLU, pg8::StaticOrder, true, true>(F.lds + RING_OFF, g, So, E);
        { const int nun = (S / 256) * (2 * FF / 256), rem = nun % F.G;
          if (rem != 0 && (int)blockIdx.x >= rem) p_late_convert(F, 1, (int)blockIdx.x - rem, F.G - rem); else if (rem == 0) p_late_convert(F, 1, (int)blockIdx.x, F.G); }
        if (BOTH(10)) GRID_BAR();
    }
    if (IN(11)) {
        pg8::Gemm g{(const pg8::bf16_t*)(ws + WS_ACT), (const pg8::bf16_t*)(ws + WS_WDOWN), S, D, FF}; pg8::StaticOrder So; So.init(S, D, F.G, (int)blockIdx.x);
        pg8::EpiOutBf16 E{(pg8::bf16_t*)(ws + WS_F2)};
        pg8::gemm_phase<pg8::EpiOutBf16, pg8::StaticOrder, true, true>(F.lds + RING_OFF, g, So, E);
        if (BOTH(11)) GRID_BAR();
    }
    if (IN(12)) { p_rows<false>(F); }
#undef IN
#undef BOTH
#undef GRID_BAR
}

extern "C" void kernel_launch(void* const* d_in, const int* in_sizes, int n_in, void* d_out, int out_size, void* d_ws, size_t ws_size, hipStream_t stream) {
    static int grid = 0;
    if (grid == 0) {
        if (n_in != 24 || out_size != S * D || ws_size < WS_END) { fprintf(stderr, "kernel_launch: unexpected problem (n_in %d, out %d, ws %zu)\n", n_in, out_size, ws_size); grid = -1; return; }
        if (hipFuncSetAttribute((const void*)skel_fwd, hipFuncAttributeMaxDynamicSharedMemorySize, LDS_BYTES) != hipSuccess) { fprintf(stderr, "kernel_launch: hipFuncSetAttribute failed\n"); grid = -1; return; }
        int dev = 0, cus = 0;
        if (hipGetDevice(&dev) != hipSuccess || hipDeviceGetAttribute(&cus, hipDeviceAttributeMultiprocessorCount, dev) != hipSuccess) { grid = -1; return; }
        (void)hipGetLastError();
        grid = 256;
        if (cus != 256) fprintf(stderr, "kernel_launch: device reports %d CUs; this kernel is built for 256\n", cus);
    }
    if (grid < 0) return;
    if (hipMemsetAsync((char*)d_ws + WS_CTL, 0, CTL_ZERO_BYTES, stream) != hipSuccess) return;
    Args a{};
    for (int i = 0; i < 24; ++i) a.in[i] = (const float*)d_in[i];
    a.out = (float*)d_out; a.ws = (unsigned char*)d_ws;
    if (N_LAUNCHES == 1) {
        a.ph_lo = 0; a.ph_hi = N_PHASES; a.li = 0;
        hipLaunchKernelGGL(skel_fwd, dim3(grid), dim3(NWAVES * 64), LDS_BYTES, stream, a);
    } else {
        for (int p = 0; p < N_PHASES; ++p) { a.ph_lo = p; a.ph_hi = p + 1; a.li = p; hipLaunchKernelGGL(skel_fwd, dim3(grid), dim3(NWAVES * 64), LDS_BYTES, stream, a); }
    }
}
```

```cpp
#include <hip/hip_runtime.h>
#include <cstdio>
#include <cstdint>
#include <cmath>
#define MK_N_LAUNCHES 1
namespace pg8 {
#define PG8_LAS __attribute__((address_space(3)))
typedef unsigned short bf16_t;
typedef short bf16x8 __attribute__((ext_vector_type(8)));
typedef float f32x4 __attribute__((ext_vector_type(4)));
typedef unsigned u32x4 __attribute__((ext_vector_type(4)));
constexpr int BM = 256, BK = 64, HALF = 128, HTB = HALF * BK * 2  , STAGE_BYTES = 8 * HTB, NXCD = 8, WGM = 8;

__host__ __device__ __forceinline__ int lds_byte(int r, int c) { const int st = (r >> 4) * 2 + (c >> 5), rr = r & 15, cc = c & 31, ob = rr * 64 + cc * 2; return st * 1024 + (ob ^ (((ob >> 9) & 1) << 5)); }
__host__ __device__ __forceinline__ void stage_rc(int b, int& R, int& C) { const int st = b / 1024, sb = b % 1024, swz = sb ^ (((sb >> 9) & 1) << 5); R = (st >> 1) * 16 + swz / 64; C = (st & 1) * 32 + (swz % 64) / 2; }
__host__ __device__ __forceinline__ int perm32(int rho) { const int n = rho >> 4, i = rho & 15; return 8 * (i >> 2) + 4 * n + (i & 3); }

struct Unit { int pm, pn, seg; };
struct Gemm { const bf16_t* A; const bf16_t* Bt; int M, N, K; const bf16_t* A2 = nullptr; const bf16_t* Bt2 = nullptr; };

struct StaticOrder {
    int nM, nN, nwg, G, c;
    __host__ __device__ __forceinline__ void init(int M, int N, int G_, int c_) { nM = M / BM; nN = N / BM; nwg = nM * nN; G = G_; c = c_; }
    __host__ __device__ __forceinline__ bool next(int i, Unit& u) const {
        const long L = (long)i * G + c; if (L >= nwg) return false;
        int wgid = (int)L; { const int q = nwg / NXCD, r = nwg % NXCD, xcd = wgid % NXCD, off = wgid / NXCD; wgid = (xcd < r ? xcd * (q + 1) : r * (q + 1) + (xcd - r) * q) + off; }
        const int nig = WGM * nN, gid = wgid / nig, fm = gid * WGM, gsz = (nM - fm) < WGM ? (nM - fm) : WGM;
        u.pm = fm + ((wgid % nig) % gsz); u.pn = (wgid % nig) / gsz; u.seg = 0; return true;
    }
    __device__ __forceinline__ void a_ready(const Unit&) const {}
    __device__ __forceinline__ void done(const Unit&) const {}
};
struct PairOrder {
    StaticOrder base;
    __host__ __device__ __forceinline__ void init(int M, int N, int G_, int c_) { base.init(M, N, G_, c_); }
    __host__ __device__ __forceinline__ bool next(int i, Unit& u) const { if (!base.next(i >> 1, u)) return false; u.seg = i & 1; return true; }
    __device__ __forceinline__ void a_ready(const Unit&) const {}
    __device__ __forceinline__ void done(const Unit&) const {}
};
typedef float f32x2 __attribute__((ext_vector_type(2)));
typedef __bf16 bf16x2_t __attribute__((ext_vector_type(2)));
__device__ __forceinline__ unsigned cvt_pk_bf16(float lo, float hi) { const f32x2 v = {lo, hi}; const bf16x2_t b = __builtin_convertvector(v, bf16x2_t); return __builtin_bit_cast(unsigned, b); }
__device__ __forceinline__ float fast_sigmoid(float x) { return __builtin_amdgcn_rcpf(1.0f + __builtin_amdgcn_exp2f(-1.4426950408889634f * x)); }
__device__ __forceinline__ float fast_gelu_tanh(float x) { const float u2 = 1.5957691216057308f * (x + 0.044715f * x * x * x); return x * fast_sigmoid(u2); }
__device__ __forceinline__ void store8_bf16(bf16_t* p, const f32x4& v0, const f32x4& v1) {
    u32x4 w; w.x = cvt_pk_bf16(v0[0], v0[1]); w.y = cvt_pk_bf16(v0[2], v0[3]); w.z = cvt_pk_bf16(v1[0], v1[1]); w.w = cvt_pk_bf16(v1[2], v1[3]); *(u32x4*)p = w;
}
__device__ __forceinline__ float bf_lo(unsigned w) { return __builtin_bit_cast(float, w << 16); }
__device__ __forceinline__ float bf_hi(unsigned w) { return __builtin_bit_cast(float, w & 0xffff0000u); }
__device__ __forceinline__ void rope4(f32x4& v0, f32x4& v1, const f32x4 c, const f32x4 s) {
    const float a0 = v0[0], b0 = v0[1], a1 = v0[2], b1 = v0[3], a2 = v1[0], b2 = v1[1], a3 = v1[2], b3 = v1[3];
    v0[0] = a0 * c[0] - b0 * s[0]; v0[1] = b0 * c[0] + a0 * s[0]; v0[2] = a1 * c[1] - b1 * s[1]; v0[3] = b1 * c[1] + a1 * s[1];
    v1[0] = a2 * c[2] - b2 * s[2]; v1[1] = b2 * c[2] + a2 * s[2]; v1[2] = a3 * c[3] - b3 * s[3]; v1[3] = b3 * c[3] + a3 * s[3];
}
struct EpiProj {
    static constexpr bool PERM = true, AFTER_DRAIN = false;
    bf16_t *U, *Vg, *QLAT, *Kb, *Vb, *GATE, *SMALL; float* stats; float* stats2; const float* cosA; const float* sinA;
    __device__ __forceinline__ void operator()(const f32x4 (&acc)[2][2][4][2], const Unit& u, int wr, int wc, int fr, int fq) const {
        const int pn = u.pn; int mode, ld, c0; bf16_t* dst;
        if (pn < 4) { mode = 1; dst = U; ld = 1024; c0 = pn * 256; }
        else if (pn < 8) { mode = 2; dst = Vg; ld = 1024; c0 = (pn - 4) * 256; }
        else if (pn < 10) { mode = 5; dst = QLAT; ld = 512; c0 = (pn - 8) * 256; }
        else if (pn < 14) { mode = 3; dst = Kb; ld = 1024; c0 = (pn - 10) * 256; }
        else if (pn < 18) { mode = 0; dst = Vb; ld = 1024; c0 = (pn - 14) * 256; }
        else if (pn < 34) { mode = 4; dst = GATE; ld = 4096; c0 = (pn - 18) * 256; }
        else { mode = 0; dst = SMALL; ld = 256; c0 = 0; }
        const int row0 = u.pm * BM + wr * 64 + fr, cl = wc * 32 + 8 * fq;
#pragma unroll
        for (int ai = 0; ai < 2; ++ai)
#pragma unroll
            for (int m = 0; m < 4; ++m) {
                const int row = row0 + ai * HALF + m * 16;
                f32x4 v[2][2];
#pragma unroll
                for (int bj = 0; bj < 2; ++bj) { v[bj][0] = acc[ai][bj][m][0]; v[bj][1] = acc[ai][bj][m][1]; }
                if (mode == 1 || mode == 2) {
#pragma unroll
                    for (int bj = 0; bj < 2; ++bj)
#pragma unroll
                        for (int n = 0; n < 2; ++n)
#pragma unroll
                            for (int e = 0; e < 4; ++e) v[bj][n][e] = fast_gelu_tanh(v[bj][n][e]);
                    if (mode == 2) {
                        float s = 0.f, q = 0.f;
#pragma unroll
                        for (int bj = 0; bj < 2; ++bj)
#pragma unroll
                            for (int n = 0; n < 2; ++n)
#pragma unroll
                                for (int e = 0; e < 4; ++e) { s += v[bj][n][e]; q += v[bj][n][e] * v[bj][n][e]; }
                        s += __shfl_xor(s, 16); s += __shfl_xor(s, 32); q += __shfl_xor(q, 16); q += __shfl_xor(q, 32);
                        if (fq == 0) { f32x2 o; o.x = s; o.y = q; *(f32x2*)(stats + ((size_t)row * 16 + (pn - 4) * 4 + wc) * 2) = o; }
                    }
                } else if (mode == 5) {
                    float q = 0.f;
#pragma unroll
                    for (int bj = 0; bj < 2; ++bj)
#pragma unroll
                        for (int n = 0; n < 2; ++n)
#pragma unroll
                            for (int e = 0; e < 4; ++e) q += v[bj][n][e] * v[bj][n][e];
                    q += __shfl_xor(q, 16); q += __shfl_xor(q, 32);
                    if (fq == 0) stats2[(size_t)row * 8 + (pn - 8) * 4 + wc] = q;
                } else if (mode == 3) {
                    const f32x4 c = *(const f32x4*)(cosA + (size_t)row * 64 + 16 * wc + 4 * fq), s = *(const f32x4*)(sinA + (size_t)row * 64 + 16 * wc + 4 * fq);
                    rope4(v[0][0], v[0][1], c, s); rope4(v[1][0], v[1][1], c, s);
                } else if (mode == 4) {
#pragma unroll
                    for (int bj = 0; bj < 2; ++bj)
#pragma unroll
                        for (int n = 0; n < 2; ++n)
#pragma unroll
                            for (int e = 0; e < 4; ++e) v[bj][n][e] = fast_sigmoid(v[bj][n][e]);
                }
                bf16_t* rowp = dst + (size_t)row * ld + c0 + cl;
                store8_bf16(rowp, v[0][0], v[0][1]); store8_bf16(rowp + HALF, v[1][0], v[1][1]);
            }
    }
};
struct EpiQ {
    static constexpr bool PERM = true, AFTER_DRAIN = false;
    bf16_t *Q, *QIDX; const PG8_LAS float* rt; const float *cosA, *sinA, *cosI, *sinI; float qscale;
    __device__ __forceinline__ void operator()(const f32x4 (&acc)[2][2][4][2], const Unit& u, int wr, int wc, int fr, int fq) const {
        const int pn = u.pn; const bool isq = pn < 4;
        bf16_t* dst = isq ? Q : QIDX; const int c0 = (isq ? pn : pn - 4) * 256 + wc * 32 + 8 * fq;
#pragma unroll
        for (int ai = 0; ai < 2; ++ai)
#pragma unroll
            for (int m = 0; m < 4; ++m) {
                const int lrow = ai * HALF + wr * 64 + m * 16 + fr, row = u.pm * BM + lrow;
                const float sc = rt[lrow] * (isq ? qscale : 1.0f);
                f32x4 v[2][2];
#pragma unroll
                for (int bj = 0; bj < 2; ++bj) { v[bj][0] = acc[ai][bj][m][0] * sc; v[bj][1] = acc[ai][bj][m][1] * sc; }
                if (isq) {
                    const f32x4 c = *(const f32x4*)(cosA + (size_t)row * 64 + 16 * wc + 4 * fq), s = *(const f32x4*)(sinA + (size_t)row * 64 + 16 * wc + 4 * fq);
                    rope4(v[0][0], v[0][1], c, s); rope4(v[1][0], v[1][1], c, s);
                } else if ((wc & 1) == 0) {
                    const f32x4 c = *(const f32x4*)(cosI + (size_t)row * 16 + 4 * fq), s = *(const f32x4*)(sinI + (size_t)row * 16 + 4 * fq);
                    rope4(v[0][0], v[0][1], c, s); rope4(v[1][0], v[1][1], c, s);
                }
                bf16_t* rowp = dst + (size_t)row * 1024 + c0;
                store8_bf16(rowp, v[0][0], v[0][1]); store8_bf16(rowp + HALF, v[1][0], v[1][1]);
            }
    }
};
struct EpiGate2 {
    static constexpr bool PERM = true, AFTER_DRAIN = false;
    const bf16_t* GATE; bf16_t* MERGED;
    __device__ __forceinline__ void operator()(f32x4 (&acc)[2][2][4][2], const Unit& u, int wr, int wc, int fr, int fq) const {
        const int row0 = u.pm * BM + wr * 64 + fr, col0 = u.pn * BM + wc * 32 + 8 * fq;
#pragma unroll
        for (int ai = 0; ai < 2; ++ai)
#pragma unroll
            for (int m = 0; m < 4; ++m) {
                const int row = row0 + ai * HALF + m * 16;
#pragma unroll
                for (int bj = 0; bj < 2; ++bj) {
                    const int col = col0 + bj * HALF;
                    const u32x4 gb = *(const u32x4*)(GATE + (size_t)row * 4096 + 2048 + col);
                    f32x4 b0 = {bf_lo(gb.x), bf_hi(gb.x), bf_lo(gb.y), bf_hi(gb.y)}, b1 = {bf_lo(gb.z), bf_hi(gb.z), bf_lo(gb.w), bf_hi(gb.w)};
                    if (u.seg == 0) {
                        const u32x4 ga = *(const u32x4*)(GATE + (size_t)row * 4096 + col);
                        const f32x4 a0 = {bf_lo(ga.x), bf_hi(ga.x), bf_lo(ga.y), bf_hi(ga.y)}, a1 = {bf_lo(ga.z), bf_hi(ga.z), bf_lo(ga.w), bf_hi(ga.w)};
#pragma unroll
                        for (int e = 0; e < 4; ++e) { acc[ai][bj][m][0][e] *= a0[e] * __builtin_amdgcn_rcpf(b0[e]); acc[ai][bj][m][1][e] *= a1[e] * __builtin_amdgcn_rcpf(b1[e]); }
                    } else {
                        store8_bf16(MERGED + (size_t)row * 2048 + col, acc[ai][bj][m][0] * b0, acc[ai][bj][m][1] * b1);
                    }
                }
            }
    }
};
struct EpiOutBf16 {
    static constexpr bool PERM = true, AFTER_DRAIN = false;
    bf16_t* O;
    __device__ __forceinline__ void operator()(const f32x4 (&acc)[2][2][4][2], const Unit& u, int wr, int wc, int fr, int fq) const {
        const int row0 = u.pm * BM + wr * 64 + fr, col0 = u.pn * BM + wc * 32 + 8 * fq;
#pragma unroll
        for (int ai = 0; ai < 2; ++ai)
#pragma unroll
            for (int m = 0; m < 4; ++m)
#pragma unroll
                for (int bj = 0; bj < 2; ++bj) store8_bf16(O + (size_t)(row0 + ai * HALF + m * 16) * 2048 + col0 + bj * HALF, acc[ai][bj][m][0], acc[ai][bj][m][1]);
    }
};
struct EpiSwiGLU {
    static constexpr bool PERM = true, AFTER_DRAIN = false;
    bf16_t* ACT; int ld;
    __device__ __forceinline__ void operator()(const f32x4 (&acc)[2][2][4][2], const Unit& u, int wr, int wc, int fr, int fq) const {
        const int row0 = u.pm * BM + wr * 64 + fr, col0 = u.pn * HALF + wc * 32 + 8 * fq;
#pragma unroll
        for (int ai = 0; ai < 2; ++ai)
#pragma unroll
            for (int m = 0; m < 4; ++m) {
                f32x4 o[2];
#pragma unroll
                for (int n = 0; n < 2; ++n)
#pragma unroll
                    for (int e = 0; e < 4; ++e) { const float g = acc[ai][0][m][n][e]; o[n][e] = g * fast_sigmoid(g) * acc[ai][1][m][n][e]; }
                store8_bf16(ACT + (size_t)(row0 + ai * HALF + m * 16) * ld + col0, o[0], o[1]);
            }
    }
};
template <class Epi, class Sched, bool ALIGN_EPI = false, bool SP2 = false>
__device__ __forceinline__ void gemm_phase(PG8_LAS unsigned char* lds, const Gemm g, const Sched& S, const Epi& E) {
    const int tid = threadIdx.x, wid = __builtin_amdgcn_readfirstlane(tid >> 6), lane = tid & 63, wr = wid >> 2, wc = wid & 3, fr = lane & 15, fq = lane >> 4;
    const int K = g.K, nt = K / BK;
    unsigned voffA[2], voffB[2];
#pragma unroll
    for (int i = 0; i < 2; ++i) { int R, C; stage_rc(tid * 16 + i * 8192, R, C); const int Rb = Epi::PERM ? ((R & ~31) + perm32(R & 31)) : R;
        voffA[i] = (unsigned)(R * K + C) * 2u; voffB[i] = (unsigned)(Rb * K + C) * 2u; }
    const size_t kstep = (size_t)(BK * 2);
    const size_t hstep = (size_t)HALF * K * 2;
    const size_t tstep = 2 * hstep;
    const unsigned ldsw = (unsigned)wid * 1024u;
    const int aoff = lds_byte(wr * 64 + fr, fq * 8), boff = lds_byte(wc * 32 + fr, fq * 8);
#define PG8_SA(b, h) (((b) * 2 + (h)) * HTB)
#define PG8_SB(b, h) ((4 + (b) * 2 + (h)) * HTB)
#define PG8_STAGE(bufoff, gbase, voff) do { _Pragma("unroll") for (int _i = 0; _i < 2; ++_i) \
        __builtin_amdgcn_global_load_lds((const unsigned*)((const char*)(gbase) + (voff)[_i]), (PG8_LAS unsigned*)(lds + (bufoff) + ldsw + _i * 8192), 16, 0, 0); } while (0)
#define PG8_LDA(dst, b, h) do { _Pragma("unroll") for (int m = 0; m < 4; ++m) _Pragma("unroll") for (int k = 0; k < 2; ++k) dst[m][k] = *(const PG8_LAS bf16x8*)(lds + PG8_SA(b, h) + aoff + m * 2048 + k * 1024); } while (0)
#define PG8_LDB(dst, b, h) do { _Pragma("unroll") for (int n = 0; n < 2; ++n) _Pragma("unroll") for (int k = 0; k < 2; ++k) dst[n][k] = *(const PG8_LAS bf16x8*)(lds + PG8_SB(b, h) + boff + n * 2048 + k * 1024); } while (0)
#define PG8_MMA(ai, bj, At, Bt) do { __builtin_amdgcn_s_setprio(1); _Pragma("unroll") for (int m = 0; m < 4; ++m) _Pragma("unroll") for (int n = 0; n < 2; ++n) _Pragma("unroll") for (int k = 0; k < 2; ++k) \
        acc[ai][bj][m][n] = __builtin_amdgcn_mfma_f32_16x16x32_bf16(Bt[n][k], At[m][k], acc[ai][bj][m][n], 0, 0, 0); __builtin_amdgcn_s_setprio(0); } while (0)
#define PG8_WAIT_V(n) asm volatile("s_waitcnt vmcnt(" #n ")" ::: "memory")
#define PG8_WAIT_L(n) asm volatile("s_waitcnt lgkmcnt(" #n ")" ::: "memory")
#define PG8_BAR __builtin_amdgcn_s_barrier()
#define PG8_SCHED __builtin_amdgcn_sched_barrier(0)
    Unit cur, nxt; int ui = 0;
    if (!S.next(0, cur)) return;
    f32x4 acc[2][2][4][2];
#pragma unroll
    for (int a = 0; a < 2; ++a)
#pragma unroll
        for (int b = 0; b < 2; ++b)
#pragma unroll
            for (int m = 0; m < 4; ++m)
#pragma unroll
                for (int n = 0; n < 2; ++n) acc[a][b][m][n] = (f32x4){0.f, 0.f, 0.f, 0.f};
    bf16x8 At[4][2], B0[2][2], B1[2][2];
    const char* cA = (const char*)(cur.seg ? g.A2 : g.A) + (size_t)cur.pm * tstep; const char* cB = (const char*)(cur.seg ? g.Bt2 : g.Bt) + (size_t)cur.pn * tstep;
    S.a_ready(cur);
    if constexpr (SP2) {
        PG8_STAGE(PG8_SB(0, 0), cB, voffB); PG8_STAGE(PG8_SB(0, 1), cB + hstep, voffB); PG8_STAGE(PG8_SA(0, 0), cA, voffA); PG8_STAGE(PG8_SA(0, 1), cA + hstep, voffA);
        if (wr == 1) PG8_BAR;
        PG8_WAIT_V(2); PG8_BAR;
        PG8_STAGE(PG8_SB(1, 0), cB + kstep, voffB); PG8_STAGE(PG8_SA(1, 0), cA + kstep, voffA); PG8_STAGE(PG8_SB(1, 1), cB + hstep + kstep, voffB);
        PG8_WAIT_V(6); PG8_BAR;
    } else {
        PG8_STAGE(PG8_SB(0, 0), cB, voffB); PG8_STAGE(PG8_SA(0, 0), cA, voffA); PG8_STAGE(PG8_SB(0, 1), cB + hstep, voffB); PG8_STAGE(PG8_SA(0, 1), cA + hstep, voffA);
        if (wr == 1) PG8_BAR;
        PG8_WAIT_V(4); PG8_BAR;
        PG8_STAGE(PG8_SB(1, 0), cB + kstep, voffB); PG8_STAGE(PG8_SA(1, 0), cA + kstep, voffA); PG8_STAGE(PG8_SB(1, 1), cB + hstep + kstep, voffB);
        PG8_WAIT_V(6); PG8_BAR;
    }
    for (;;) {
        const bool has_next = S.next(ui + 1, nxt);
        const char* nA = has_next ? (const char*)(nxt.seg ? g.A2 : g.A) + (size_t)nxt.pm * tstep : cA; const char* nB = has_next ? (const char*)(nxt.seg ? g.Bt2 : g.Bt) + (size_t)nxt.pn * tstep : cB;
        for (int t = 0; t < nt; t += 2) {
            const bool last = (t == nt - 2);
            const char* a1 = cA + (size_t)(t + 1) * kstep;
            const char* a2 = last ? nA : cA + (size_t)(t + 2) * kstep; const char* b2 = last ? nB : cB + (size_t)(t + 2) * kstep;
            const char* a3 = a2 + kstep; const char* b3 = b2 + kstep;
            if (last && has_next) S.a_ready(nxt);
            if constexpr (SP2) {
            PG8_LDB(B0, 0, 0); PG8_LDB(B1, 0, 1); PG8_SCHED; PG8_LDA(At, 0, 0); PG8_STAGE(PG8_SA(1, 1), a1 + hstep, voffA);
            PG8_WAIT_V(8); PG8_WAIT_L(0); PG8_BAR; PG8_MMA(0, 0, At, B0); PG8_MMA(0, 1, At, B1); PG8_BAR; PG8_SCHED;
            PG8_LDA(At, 0, 1); PG8_STAGE(PG8_SB(0, 0), b2, voffB); PG8_STAGE(PG8_SB(0, 1), b2 + hstep, voffB); PG8_STAGE(PG8_SA(0, 0), a2, voffA);
            PG8_WAIT_V(8); PG8_WAIT_L(0); PG8_BAR; PG8_MMA(1, 0, At, B0); PG8_MMA(1, 1, At, B1); PG8_BAR; PG8_SCHED;
            PG8_LDB(B0, 1, 0); PG8_LDB(B1, 1, 1); PG8_SCHED; PG8_LDA(At, 1, 0); PG8_STAGE(PG8_SA(0, 1), a2 + hstep, voffA);
            PG8_WAIT_V(8); PG8_WAIT_L(0); PG8_BAR; PG8_MMA(0, 0, At, B0); PG8_MMA(0, 1, At, B1); PG8_BAR; PG8_SCHED;
            PG8_LDA(At, 1, 1); PG8_STAGE(PG8_SB(1, 0), b3, voffB); PG8_STAGE(PG8_SB(1, 1), b3 + hstep, voffB); PG8_STAGE(PG8_SA(1, 0), a3, voffA);
            PG8_WAIT_V(8); PG8_WAIT_L(0); PG8_BAR; PG8_MMA(1, 0, At, B0); PG8_MMA(1, 1, At, B1); PG8_BAR; PG8_SCHED;
            } else {
            PG8_LDB(B0, 0, 0); PG8_SCHED; PG8_LDA(At, 0, 0); PG8_STAGE(PG8_SA(1, 1), a1 + hstep, voffA);
            PG8_WAIT_L(8); PG8_BAR; PG8_WAIT_L(0); PG8_MMA(0, 0, At, B0); PG8_BAR; PG8_SCHED;
            PG8_LDB(B1, 0, 1); PG8_STAGE(PG8_SB(0, 0), b2, voffB);
            PG8_BAR; PG8_WAIT_L(0); PG8_MMA(0, 1, At, B1); PG8_BAR;
            PG8_LDA(At, 0, 1); PG8_STAGE(PG8_SA(0, 0), a2, voffA);
            PG8_BAR; PG8_WAIT_L(0); PG8_MMA(1, 0, At, B0); PG8_BAR; PG8_SCHED;
            PG8_STAGE(PG8_SB(0, 1), b2 + hstep, voffB);
            PG8_WAIT_V(6); PG8_BAR; PG8_MMA(1, 1, At, B1); PG8_BAR;
            PG8_LDB(B0, 1, 0); PG8_SCHED; PG8_LDA(At, 1, 0); PG8_STAGE(PG8_SA(0, 1), a2 + hstep, voffA);
            PG8_WAIT_L(8); PG8_BAR; PG8_WAIT_L(0); PG8_MMA(0, 0, At, B0); PG8_BAR; PG8_SCHED;
            PG8_LDB(B1, 1, 1); PG8_STAGE(PG8_SB(1, 0), b3, voffB);
            PG8_BAR; PG8_WAIT_L(0); PG8_MMA(0, 1, At, B1); PG8_BAR;
            PG8_LDA(At, 1, 1); PG8_STAGE(PG8_SA(1, 0), a3, voffA);
            PG8_BAR; PG8_WAIT_L(0); PG8_MMA(1, 0, At, B0); PG8_BAR; PG8_SCHED;
            PG8_STAGE(PG8_SB(1, 1), b3 + hstep, voffB);
            PG8_WAIT_V(6); PG8_BAR; PG8_MMA(1, 1, At, B1); PG8_BAR;
            }
        }
        if constexpr (ALIGN_EPI) { if (wr == 0) PG8_BAR; }
        if constexpr (!Epi::AFTER_DRAIN) { E(acc, cur, wr, wc, fr, fq); S.done(cur); }
        if (!has_next) break;
        if (nxt.seg == 0)
#pragma unroll
        for (int a = 0; a < 2; ++a)
#pragma unroll
            for (int b = 0; b < 2; ++b)
#pragma unroll
                for (int m = 0; m < 4; ++m)
#pragma unroll
                    for (int n = 0; n < 2; ++n) acc[a][b][m][n] = (f32x4){0.f, 0.f, 0.f, 0.f};
        cur = nxt; cA = nA; cB = nB; ++ui;
        if constexpr (ALIGN_EPI) { if (wr == 1) PG8_BAR; }
    }
    PG8_WAIT_V(0);
    if constexpr (!ALIGN_EPI) { if (wr == 0) PG8_BAR; }
    PG8_BAR;
    if constexpr (Epi::AFTER_DRAIN) { E.fused(acc, cur, wr, wc, fr, fq, lds, wid, lane); S.done(cur); }
#undef PG8_SA
#undef PG8_SB
#undef PG8_STAGE
#undef PG8_LDA
#undef PG8_LDB
#undef PG8_MMA
#undef PG8_WAIT_V
#undef PG8_WAIT_L
#undef PG8_BAR
#undef PG8_SCHED
}
}
#define GAS __attribute__((address_space(1)))
#define LAS __attribute__((address_space(3)))
typedef unsigned short bf16;
typedef unsigned v4u __attribute__((ext_vector_type(4)));
typedef float f32x4 __attribute__((ext_vector_type(4)));
typedef short bf16x8 __attribute__((ext_vector_type(8)));
typedef GAS unsigned gu32;
typedef GAS unsigned long long gu64;
#define RLX_AGENT __ATOMIC_RELAXED, __HIP_MEMORY_SCOPE_AGENT
#define LDS_WAIT() asm volatile("s_waitcnt lgkmcnt(0)" ::: "memory")
#define VM_WAIT() asm volatile("s_waitcnt vmcnt(0)" ::: "memory")
__device__ __forceinline__ unsigned long long rt() { return __builtin_amdgcn_s_memrealtime(); }
__device__ __forceinline__ unsigned f2bf(float f) { unsigned u = __builtin_bit_cast(unsigned, f); return (u + 0x7fffu + ((u >> 16) & 1u)) >> 16; }
__device__ __forceinline__ unsigned pk2(float lo, float hi) { return f2bf(lo) | (f2bf(hi) << 16); }
#define XB_TMO      128
#define XB_XCNT(j)  (256  + 64 * (j))
#define XB_XSUB(j)  (1280 + 64 * (j))
#define XB_XGEN(j)  (2304 + 64 * (j))
#define XB_TOP      3328
#define XB_TOPGEN   3392
#define XCD_BAR_WORDS 3456
#define XB_SPIN_CAP (1u << 18)

__device__ __forceinline__ unsigned xb_ld(unsigned* p)              { return __hip_atomic_load(p, __ATOMIC_RELAXED, __HIP_MEMORY_SCOPE_AGENT); }
__device__ __forceinline__ unsigned xb_add(unsigned* p, unsigned v) { return __hip_atomic_fetch_add(p, v, __ATOMIC_RELAXED, __HIP_MEMORY_SCOPE_AGENT); }
__device__ __forceinline__ unsigned xb_xcc_id() { return (unsigned)__builtin_amdgcn_s_getreg((3 << 11) | 20) & 0xFu; }
#define XB_SPIN(cond, bar) do { unsigned _sp = 0; while (cond) { __builtin_amdgcn_s_sleep(1); \
    if ((++_sp & 255u) == 0u) { if (xb_ld(&(bar)[XB_TMO])) break; if (_sp > XB_SPIN_CAP) { atomicAdd(&(bar)[XB_TMO], 1u); break; } } } } while (0)

struct XcdBarrier {
    unsigned* bar; unsigned x;
    volatile LAS unsigned* st;
};

__device__ __forceinline__ XcdBarrier xcd_barrier_post(unsigned* bar, volatile LAS unsigned* st) {
    XcdBarrier b; b.bar = bar; b.x = xb_xcc_id(); b.st = st;
    if (threadIdx.x == 0) (void)xb_add(&bar[XB_XCNT(b.x)], 1u);
    return b;
}
__device__ __forceinline__ void xcd_barrier_complete(unsigned* bar, unsigned x, unsigned& nloc, unsigned& nx) {
    const unsigned G = gridDim.x * gridDim.y * gridDim.z;
    unsigned sum, cnt, mine, sp = 0u;
    for (;;) {
        sum = 0u; cnt = 0u; mine = 0u;
#pragma unroll
        for (unsigned j = 0; j < 16; ++j) { const unsigned c = xb_ld(&bar[XB_XCNT(j)]); sum += c; cnt += (c > 0u) ? 1u : 0u; mine = (j == x) ? c : mine; }
        if (sum == G) break;
        __builtin_amdgcn_s_sleep(1);
        if ((++sp & 255u) == 0u) { if (xb_ld(&bar[XB_TMO])) break; if (sp > XB_SPIN_CAP) { atomicAdd(&bar[XB_TMO], 1u); break; } }
    }
    nloc = mine > 0u ? mine : 1u; nx = cnt > 0u ? cnt : 1u;
}

__device__ __forceinline__ void xcd_barrier(const XcdBarrier& b) {
    asm volatile("s_waitcnt vmcnt(0)" ::: "memory");
    __syncthreads();
    if (threadIdx.x == 0) {
        unsigned* bar = b.bar;
        __builtin_amdgcn_s_waitcnt(0);
        unsigned nloc = b.st[0], nx = b.st[1];
        if (nloc == 0u) { xcd_barrier_complete(bar, b.x, nloc, nx); b.st[0] = nloc; b.st[1] = nx; }
        const unsigned old = xb_add(&bar[XB_XSUB(b.x)], 1u);
        const unsigned gen = old / nloc;
        if (old + 1u == (gen + 1u) * nloc) {
            __builtin_amdgcn_fence(__ATOMIC_RELEASE, "agent");
            asm volatile("s_waitcnt vmcnt(0)" ::: "memory");
            const unsigned og = xb_add(&bar[XB_TOP], 1u);
            const unsigned tg = og / nx;
            if (og + 1u == (tg + 1u) * nx) xb_add(&bar[XB_TOPGEN], 1u);
            else XB_SPIN(xb_ld(&bar[XB_TOPGEN]) == tg, bar);
            __builtin_amdgcn_fence(__ATOMIC_ACQUIRE, "agent");
            xb_add(&bar[XB_XGEN(b.x)], 1u);
            asm volatile("s_waitcnt vmcnt(0)" ::: "memory");
        } else {
            XB_SPIN(xb_ld(&bar[XB_XGEN(b.x)]) == gen, bar);
            __builtin_amdgcn_fence(__ATOMIC_ACQUIRE, "agent");
            asm volatile("s_waitcnt vmcnt(0)" ::: "memory");
        }
    }
    __syncthreads();
}
constexpr int NWAVES = 8;
#ifndef MK_N_LAUNCHES
#define MK_N_LAUNCHES 1
#endif
constexpr int N_PHASES = 13;
constexpr int N_LAUNCHES = MK_N_LAUNCHES;

constexpr int S = 8192, D = 2048, GW = 1024, QL = 512, AW = 1024, FF = 5632;
constexpr int NPROJ = 8960;
constexpr int SRC_INC = 8784;
constexpr float NORM_EPS = 1e-6f;
constexpr float QSCALE = 0.08838834764831845f * 1.4426950408889634f;

constexpr size_t MiB = 1u << 20;
constexpr size_t WS_CTL = 0, CTL_ZERO_BYTES = 128 * 1024;
constexpr size_t WS_MOD = 1 * MiB, WS_COSA = 2 * MiB, WS_SINA = 4 * MiB, WS_COSI = 6 * MiB, WS_SINI = 6 * MiB + 512 * 1024, WS_STATS = 7 * MiB, WS_IDXW = 8 * MiB, WS_KIDX = 8 * MiB + 512 * 1024, WS_WM = 9 * MiB + 512 * 1024, WS_STATS2 = 9 * MiB + 768 * 1024;
constexpr size_t WS_WIN = 10 * MiB, WS_WQQ = 45 * MiB, WS_WPA = 47 * MiB, WS_WPB = 51 * MiB, WS_WOUT = 55 * MiB, WS_WGU = 63 * MiB, WS_WDOWN = 107 * MiB;
constexpr size_t WS_H = 129 * MiB;
constexpr size_t WS_U = 161 * MiB, WS_VG = 177 * MiB, WS_QLAT = 193 * MiB, WS_K = 201 * MiB, WS_V = 217 * MiB, WS_GATE = 233 * MiB, WS_SMALL = 297 * MiB;
constexpr size_t WS_ACT = 161 * MiB;
constexpr size_t WS_Q = 301 * MiB, WS_QIDX = 317 * MiB, WS_YB = 341 * MiB;
constexpr size_t WS_MASKB0 = WS_H, WS_MASKB1 = WS_WIN + 2 * MiB;
constexpr size_t WS_X1 = 249 * MiB;
constexpr size_t WS_F2 = 333 * MiB;
constexpr size_t WS_F = 301 * MiB;
constexpr size_t WS_END = 365 * MiB;
static_assert(WS_WIN + (size_t)NPROJ * D * 2 <= WS_WQQ && WS_WGU + (size_t)2 * FF * D * 2 <= WS_WDOWN && WS_WDOWN + (size_t)D * FF * 2 <= WS_H && WS_ACT + (size_t)S * FF * 2 <= WS_Q, "d_ws map");
constexpr int CW_TMO = 0, CW_CODE = 1, CW_BAR = 4096, CW_ATT = 16384;
static_assert((size_t)(CW_ATT + 256 * 64) * 4 <= CTL_ZERO_BYTES, "every polled word inside the memset region");

constexpr int RING_OFF = 0, RING_BYTES = 131072;
constexpr int LDSCTL_OFF = RING_BYTES, MISC_OFF = LDSCTL_OFF + 320;
constexpr int AUX_OFF = RING_BYTES + 1024;
constexpr int LDS_BYTES = 163840;
struct Frame {
    LAS unsigned char* lds;
    volatile LAS unsigned* MISC;
    gu32* ctl;
    int tid, lane, wave;
    int vcu, G;
    const float* in[24];
    float* out; unsigned char* ws;
};
__device__ __forceinline__ float wave_sum(float v) {
#pragma unroll
    for (int o = 1; o < 64; o <<= 1) v += __shfl_xor(v, o);
    return v;
}
__device__ __forceinline__ float wave_max(float v) {
#pragma unroll
    for (int o = 1; o < 64; o <<= 1) v = fmaxf(v, __shfl_xor(v, o));
    return v;
}
__device__ __forceinline__ float bf2f(bf16 b) { return __builtin_bit_cast(float, (unsigned)b << 16); }
__device__ __forceinline__ float bflo(unsigned w) { return __builtin_bit_cast(float, w << 16); }
__device__ __forceinline__ float bfhi(unsigned w) { return __builtin_bit_cast(float, w & 0xffff0000u); }

enum { MAT_WIN = 0, MAT_WQ, MAT_WQI, MAT_WPA, MAT_WPB, MAT_WOUT, MAT_WGATE, MAT_WUP, MAT_WDOWN };
__device__ __forceinline__ int dst_of(int mat, int c) {
    switch (mat) {
    case MAT_WIN:
        if (c < 2560) return c;
        if (c < 3584) { const int h = (c - 2560) >> 7, d = (c - 2560) & 127; return 2560 + h * 128 + (d < 64 ? 2 * d : 2 * (d - 64) + 1); }
        if (c < 4608) return c;
        if (c < 4688) return 8704 + (c - 4608);
        return c - 4688 + 4608;
    case MAT_WQ: { const int h = c >> 7, d = c & 127; return h * 128 + (d < 64 ? 2 * d : 2 * (d - 64) + 1); }
    case MAT_WQI: { const int h = c >> 6, d = c & 63; return 1024 + h * 64 + (d < 32 ? (d < 16 ? 2 * d : 2 * (d - 16) + 1) : d); }
    case MAT_WGATE: return (c >> 7) * 256 + (c & 127);
    case MAT_WUP: return (c >> 7) * 256 + 128 + (c & 127);
    default: return c;
    }
}
__device__ __forceinline__ void p0_transpose_item(int mat, const float* __restrict__ W, int K, int N, bf16* WT, const float* ksc, LAS unsigned char* scr, int item, int lane) {
    const int nblk = (N + 63) / 64, kb = item / nblk, nb = item % nblk, k0 = 64 * kb, c0 = 64 * nb;
    const int kq = lane >> 4, nq = lane & 15;
    const bool colok = (c0 + 4 * nq) < N;
    f32x4 v[16];
#pragma unroll
    for (int i = 0; i < 16; ++i) { const int k = k0 + 16 * (i >> 2) + 4 * kq + (i & 3); v[i] = colok ? *(const f32x4*)(W + (size_t)k * N + c0 + 4 * nq) : (f32x4){0.f, 0.f, 0.f, 0.f}; }
    if (ksc) {
#pragma unroll
        for (int i = 0; i < 16; ++i) v[i] = v[i] * ksc[k0 + 16 * (i >> 2) + 4 * kq + (i & 3)];
    }
#pragma unroll
    for (int j = 0; j < 4; ++j)
#pragma unroll
        for (int e = 0; e < 4; ++e) {
            const unsigned lo = pk2(v[4 * j][e], v[4 * j + 1][e]), hi = pk2(v[4 * j + 2][e], v[4 * j + 3][e]);
            *(LAS unsigned long long*)(scr + (4 * nq + e) * 144 + (16 * j + 4 * kq) * 2) = (unsigned long long)lo | ((unsigned long long)hi << 32);
        }
    LDS_WAIT(); asm volatile("" ::: "memory");
#pragma unroll
    for (int j = 0; j < 8; ++j) {
        const int ch = lane + 64 * j, cl = ch >> 3, k8 = ch & 7;
        const v4u o = *(const LAS v4u*)(scr + cl * 144 + k8 * 16);
        if (c0 + cl < N) *(GAS v4u*)(WT + (size_t)dst_of(mat, c0 + cl) * K + k0 + 8 * k8) = o;
    }
    LDS_WAIT(); asm volatile("" ::: "memory");
}
__device__ __forceinline__ void p0_prologue(const Frame& F) {
    unsigned char* ws = F.ws;
    LAS unsigned char* scr = F.lds + RING_OFF + F.wave * 16384;
    const int gw = F.vcu * NWAVES + F.wave, NGW = F.G * NWAVES;
    constexpr int I_WIN = (D / 64) * ((SRC_INC + 63) / 64), I_WQ = (QL / 64) * (1024 / 64);
    constexpr int NITEMS = I_WIN + 2 * I_WQ;
    for (int it = gw; it < NITEMS; it += NGW) {
        int r = it;
        if (r < I_WIN) { p0_transpose_item(MAT_WIN, F.in[6], D, SRC_INC, (bf16*)(ws + WS_WIN), nullptr, scr, r, F.lane); continue; } r -= I_WIN;
        if (r < I_WQ) { p0_transpose_item(MAT_WQ, F.in[12], QL, 1024, (bf16*)(ws + WS_WQQ), F.in[11], scr, r, F.lane); continue; } r -= I_WQ;
        p0_transpose_item(MAT_WQI, F.in[13], QL, 1024, (bf16*)(ws + WS_WQQ), F.in[11], scr, r, F.lane);
    }
    {
        v4u* z = (v4u*)(ws + WS_WIN + (size_t)8784 * D * 2);
        for (int i = F.vcu * 512 + F.tid; i < (NPROJ - 8784) * D * 2 / 16; i += F.G * 512) z[i] = (v4u){0u, 0u, 0u, 0u};
    }
    {
        const float* wsrc = F.in[9]; bf16* wm = (bf16*)(ws + WS_WM);
        for (int i = (F.vcu * 512 + F.tid); i < 8 * 128 * 128; i += F.G * 512) { const int t = (i >> 7) & 127, s = i & 127; wm[i] = (bf16)f2bf(s <= t ? wsrc[i] : 0.f); }
    }
    {
        float* cosA = (float*)(ws + WS_COSA); float* sinA = (float*)(ws + WS_SINA); float* cosI = (float*)(ws + WS_COSI); float* sinI = (float*)(ws + WS_SINI);
        for (int i = F.vcu * 512 + F.tid; i < S * 64; i += F.G * 512) {
            const int t = i >> 6, k = i & 63;
            const float inv = 1.0f / powf(10000.0f, (float)(2 * k) / 128.0f); const float ang = (float)t * inv;
            { const double a = (double)ang, rr = a - 6.283185307179586476925 * rint(a * 0.15915494309189533577); float sn, cs; sincosf((float)rr, &sn, &cs); cosA[i] = cs; sinA[i] = sn; }
            if (k < 16) { const float inv2 = 1.0f / powf(10000.0f, (float)(2 * k) / 32.0f); const float ang2 = (float)t * inv2;
                const double a = (double)ang2, rr = a - 6.283185307179586476925 * rint(a * 0.15915494309189533577); float sn, cs; sincosf((float)rr, &sn, &cs); cosI[t * 16 + k] = cs; sinI[t * 16 + k] = sn; }
        }
    }
    {
        __syncthreads();
        LAS f32x4* red = (LAS f32x4*)(F.lds + RING_OFF);
        const float* cv = F.in[1]; const float* wmod = F.in[2]; const float* bmod = F.in[3]; float* mod = (float*)(ws + WS_MOD);
        for (int cb = F.vcu; cb < 256; cb += F.G) {
            const int kg = F.tid / 12, c4 = F.tid % 12;
            if (kg < 42) {
                f32x4 acc = {0.f, 0.f, 0.f, 0.f};
#pragma unroll 8
                for (int k = kg; k < D; k += 42) acc += *(const f32x4*)(wmod + (size_t)k * (6 * D) + cb * 48 + 4 * c4) * cv[k];
                red[kg * 12 + c4] = acc;
            }
            __syncthreads();
            if (F.tid < 48) { float a = bmod[cb * 48 + F.tid]; const LAS float* rf = (const LAS float*)red; for (int g = 0; g < 42; ++g) a += rf[g * 48 + F.tid]; mod[cb * 48 + F.tid] = a; }
            __syncthreads();
        }
    }
}
__device__ __forceinline__ void p_late_convert(const Frame& F, int part, int widx, int nwg) {
    unsigned char* ws = F.ws;
    LAS unsigned char* scr = F.lds + RING_OFF + F.wave * 16384;
    constexpr int I_WPA = (GW / 64) * (D / 64), I_WOUT = (D / 64) * (D / 64), I_WG = (D / 64) * (FF / 64), I_WDOWN = (FF / 64) * (D / 64);
    const int n = part == 0 ? 2 * I_WPA + I_WOUT + 2 * I_WG : I_WDOWN;
    for (int it = widx * NWAVES + F.wave; it < n; it += nwg * NWAVES) {
        if (part == 1) { p0_transpose_item(MAT_WDOWN, F.in[23], FF, D, (bf16*)(ws + WS_WDOWN), nullptr, scr, it, F.lane); continue; }
        int r = it;
        if (r < I_WPA) { p0_transpose_item(MAT_WPA, F.in[16], GW, D, (bf16*)(ws + WS_WPA), nullptr, scr, r, F.lane); continue; } r -= I_WPA;
        if (r < I_WPA) { p0_transpose_item(MAT_WPB, F.in[17], AW, D, (bf16*)(ws + WS_WPB), nullptr, scr, r, F.lane); continue; } r -= I_WPA;
        if (r < I_WOUT) { p0_transpose_item(MAT_WOUT, F.in[18], D, D, (bf16*)(ws + WS_WOUT), nullptr, scr, r, F.lane); continue; } r -= I_WOUT;
        if (r < I_WG) { p0_transpose_item(MAT_WGATE, F.in[21], D, FF, (bf16*)(ws + WS_WGU), nullptr, scr, r, F.lane); continue; } r -= I_WG;
        p0_transpose_item(MAT_WUP, F.in[22], D, FF, (bf16*)(ws + WS_WGU), nullptr, scr, r, F.lane);
    }
}
__device__ __forceinline__ void p1_prenorm(const Frame& F) {
    const int gw = F.vcu * NWAVES + F.wave, NGW = F.G * NWAVES;
    const float* x = F.in[0]; const float* g = F.in[4]; const float* mod = (const float*)(F.ws + WS_MOD); bf16* H = (bf16*)(F.ws + WS_H);
    for (int m = gw; m < S; m += NGW) {
        const f32x4* xr = (const f32x4*)(x + (size_t)m * D) + F.lane;
        f32x4 v[8]; float ss = 0.f;
#pragma unroll
        for (int j = 0; j < 8; ++j) { v[j] = xr[64 * j]; ss += (v[j].x * v[j].x + v[j].y * v[j].y) + (v[j].z * v[j].z + v[j].w * v[j].w); }
        const float r = rsqrtf(wave_sum(ss) * (1.f / D) + NORM_EPS);
        unsigned long long* o8 = (unsigned long long*)(H + (size_t)m * D) + F.lane;
#pragma unroll
        for (int j = 0; j < 8; ++j) {
            const int n = 4 * F.lane + 256 * j;
            const f32x4 gg = *(const f32x4*)(g + n), sh = *(const f32x4*)(mod + n), sc = *(const f32x4*)(mod + D + n);
            const f32x4 o = v[j] * r * gg * (sc + 1.0f) + sh;
            o8[64 * j] = (unsigned long long)pk2(o.x, o.y) | ((unsigned long long)pk2(o.z, o.w) << 32);
        }
    }
}
__device__ __forceinline__ void p3_spatial_item(const Frame& F, int c, int g) {
    constexpr int VP = 136;
    LAS bf16* VT = (LAS bf16*)(F.lds + RING_OFF);
    const bf16* Vg = (const bf16*)(F.ws + WS_VG); bf16* U = (bf16*)(F.ws + WS_U); const bf16* WM = (const bf16*)(F.ws + WS_WM) + (size_t)g * 128 * 128;
    const float* stats = (const float*)(F.ws + WS_STATS); const float* gam = F.in[7] + g * 128; const float* bet = F.in[8] + g * 128; const float* bs = F.in[10] + g * 128;
    const int w = F.wave, fr = F.lane & 15, fq = F.lane >> 4;
    bf16x8 bw[8][4];
#pragma unroll
    for (int ks = 0; ks < 4; ++ks)
#pragma unroll
        for (int nt = 0; nt < 8; ++nt) if (nt >= 2 * ks) bw[nt][ks] = *(const bf16x8*)(WM + (size_t)(16 * nt + fr) * 128 + 32 * ks + 8 * fq);
    {
        const int s = F.tid >> 2, dq = F.tid & 3, row = c * 128 + s;
        float sm = 0.f, sq = 0.f;
#pragma unroll
        for (int k = 0; k < 16; ++k) { const float2 p = *(const float2*)(stats + ((size_t)row * 16 + k) * 2); sm += p.x; sq += p.y; }
        const float mu = sm * (1.f / GW), var = sq * (1.f / GW) - mu * mu, r = rsqrtf(fmaxf(var, 0.f) + NORM_EPS);
        const v4u* vp = (const v4u*)(Vg + (size_t)row * GW + g * 128 + dq * 32);
#pragma unroll
        for (int i = 0; i < 4; ++i) {
            const v4u w = vp[i];
            const unsigned ww[4] = {w.x, w.y, w.z, w.w};
#pragma unroll
            for (int e = 0; e < 4; ++e) {
                const int d = dq * 32 + i * 8 + e * 2;
                const float a = (bflo(ww[e]) - mu) * r * gam[d] + bet[d], b = (bfhi(ww[e]) - mu) * r * gam[d + 1] + bet[d + 1];
                VT[d * VP + s] = (bf16)f2bf(a); VT[(d + 1) * VP + s] = (bf16)f2bf(b);
            }
        }
    }
    __syncthreads();
    {
        f32x4 acc[8];
#pragma unroll
        for (int nt = 0; nt < 8; ++nt) acc[nt] = (f32x4){0.f, 0.f, 0.f, 0.f};
#pragma unroll
        for (int ks = 0; ks < 4; ++ks) {
            const bf16x8 a = *(const LAS bf16x8*)(VT + (16 * w + fr) * VP + 32 * ks + 8 * fq);
#pragma unroll
            for (int nt = 0; nt < 8; ++nt) if (nt >= 2 * ks) acc[nt] = __builtin_amdgcn_mfma_f32_16x16x32_bf16(a, bw[nt][ks], acc[nt], 0, 0, 0);
        }
#pragma unroll
        for (int nt = 0; nt < 8; ++nt) {
            const int t = 16 * nt + fr; const float bb = bs[t];
            unsigned long long* up = (unsigned long long*)(U + (size_t)(c * 128 + t) * GW + g * 128 + 16 * w + 4 * fq);
            const unsigned long long uu = *up; const unsigned lo = (unsigned)uu, hi = (unsigned)(uu >> 32);
            const float o0 = bflo(lo) * (acc[nt][0] + bb), o1 = bfhi(lo) * (acc[nt][1] + bb), o2 = bflo(hi) * (acc[nt][2] + bb), o3 = bfhi(hi) * (acc[nt][3] + bb);
            *up = (unsigned long long)pk2(o0, o1) | ((unsigned long long)pk2(o2, o3) << 32);
        }
    }
    __syncthreads();
}
__device__ __forceinline__ void p3_kidx(const Frame& F) {
    const int gw = F.vcu * NWAVES + F.wave, NGW = F.G * NWAVES, l = F.lane;
    const bf16* SM = (const bf16*)(F.ws + WS_SMALL); bf16* KIDX = (bf16*)(F.ws + WS_KIDX); float* IDXW = (float*)(F.ws + WS_IDXW);
    const float* kg = F.in[14]; const float* kb = F.in[15]; const float* cosI = (const float*)(F.ws + WS_COSI); const float* sinI = (const float*)(F.ws + WS_SINI);
    for (int t0 = gw; t0 < S; t0 += 4 * NGW) {
        float z[4], cs[4], sn[4], wv[4];
#pragma unroll
        for (int u = 0; u < 4; ++u) { const int t = (t0 + u * NGW < S) ? t0 + u * NGW : t0; z[u] = bf2f(SM[(size_t)t * 256 + l]); cs[u] = cosI[t * 16 + (l & 15)]; sn[u] = sinI[t * 16 + (l & 15)]; wv[u] = bf2f(SM[(size_t)t * 256 + 64 + (l & 15)]); }
        const float gl = kg[l], bl = kb[l];
#pragma unroll
        for (int u = 0; u < 4; ++u) {
            const int t = t0 + u * NGW;
            const float mu = wave_sum(z[u]) * (1.f / 64.f); const float dd = z[u] - mu;
            const float r = rsqrtf(wave_sum(dd * dd) * (1.f / 64.f) + NORM_EPS);
            const float y = dd * r * gl + bl;
            const float yp = __shfl(y, (l < 16) ? l + 16 : ((l < 32) ? l - 16 : l));
            float o; int pos;
            if (l < 16) { o = y * cs[u] - yp * sn[u]; pos = 2 * l; } else if (l < 32) { o = y * cs[u] + yp * sn[u]; pos = 2 * (l - 16) + 1; } else { o = y; pos = l; }
            if (t < S) {
                KIDX[(size_t)(t >> 5) * 2048 + (pos >> 4) * 512 + (((pos >> 3) & 1) * 32 + (t & 31)) * 8 + (pos & 7)] = (bf16)f2bf(o);
                if (l < 16) IDXW[t * 16 + l] = wv[u] * 0.03125f;
            }
        }
    }
}
__device__ __forceinline__ void p3_rt(const Frame& F, int pm, LAS float* rt) {
    const float* st2 = (const float*)(F.ws + WS_STATS2);
    if (F.tid < 256) {
        const f32x4 a = *(const f32x4*)(st2 + (size_t)(pm * 256 + F.tid) * 8), b = *(const f32x4*)(st2 + (size_t)(pm * 256 + F.tid) * 8 + 4);
        const float ss = ((a.x + a.y) + (a.z + a.w)) + ((b.x + b.y) + (b.z + b.w));
        rt[F.tid] = rsqrtf(ss * (1.f / QL) + NORM_EPS);
    }
}
typedef float f32x16 __attribute__((ext_vector_type(16)));
__device__ __forceinline__ float key2f(unsigned k) { return __uint_as_float((k & 0x80000000u) ? (k ^ 0x80000000u) : ~k); }
__device__ __forceinline__ unsigned f2key(float f) { const unsigned b = __float_as_uint(f); return b ^ ((b >> 31) ? 0xFFFFFFFFu : 0x80000000u); }
__device__ __forceinline__ int wave_isum(int v) {
#pragma unroll
    for (int o = 1; o < 64; o <<= 1) v += __shfl_xor(v, o);
    return v;
}
__device__ __forceinline__ int idx_count_ge(const LAS f32x4* row4, int n256, float p, int lane) {
    int c = 0;
    for (int it = 0; it < n256; ++it) { const f32x4 v = row4[it * 64 + lane]; c += (v.x >= p ? 1 : 0) + (v.y >= p ? 1 : 0) + (v.z >= p ? 1 : 0) + (v.w >= p ? 1 : 0); }
    return wave_isum(c);
}
constexpr int IDX_NBIN = 1024;
constexpr float IDX_ZOOM = 6.0f;
__device__ __forceinline__ float relu_asm(float x) { const int b = __float_as_int(x); return __int_as_float(b > 0 ? b : 0); }
__device__ __forceinline__ float idx_kmax(const Frame& F) {
    const float g = fabsf(F.in[14][F.lane]), b = F.in[15][F.lane];
    return wave_max(g) * 8.0f + sqrtf(wave_sum(b * b));
}
template <bool FIRST>
__device__ __forceinline__ void p_rows(const Frame& F) {
    const int gw = F.vcu * NWAVES + F.wave, NGW = F.G * NWAVES;
    const float* mod = (const float*)(F.ws + WS_MOD);
    const float* gpost = F.in[5]; const float* gate = mod + 2 * D;
    const bf16* ysrc = (const bf16*)(F.ws + WS_F); const float* xsrc = F.in[0];
    bf16* H2 = (bf16*)(F.ws + WS_H);
    for (int m = gw; m < S; m += NGW) {
        const unsigned long long* yr = (const unsigned long long*)(ysrc + (size_t)m * D) + F.lane; const f32x4* xr = (const f32x4*)(xsrc + (size_t)m * D) + F.lane;
        f32x4 v[8]; float ss = 0.f;
#pragma unroll
        for (int j = 0; j < 8; ++j) { const unsigned long long yw = yr[64 * j]; const unsigned ylo = (unsigned)yw, yhi = (unsigned)(yw >> 32);
            v[j] = (f32x4){bflo(ylo), bfhi(ylo), bflo(yhi), bfhi(yhi)}; ss += (v[j].x * v[j].x + v[j].y * v[j].y) + (v[j].z * v[j].z + v[j].w * v[j].w); }
        f32x4 f[8]; float sf = 0.f;
        if (!FIRST) {
            const unsigned long long* fr = (const unsigned long long*)((const bf16*)(F.ws + WS_F2) + (size_t)m * D) + F.lane;
#pragma unroll
            for (int j = 0; j < 8; ++j) { const unsigned long long yw = fr[64 * j]; const unsigned ylo = (unsigned)yw, yhi = (unsigned)(yw >> 32);
                f[j] = (f32x4){bflo(ylo), bfhi(ylo), bflo(yhi), bfhi(yhi)}; sf += (f[j].x * f[j].x + f[j].y * f[j].y) + (f[j].z * f[j].z + f[j].w * f[j].w); }
        }
        const float r = rsqrtf(wave_sum(ss) * (1.f / D) + NORM_EPS);
        float s2 = 0.f;
#pragma unroll
        for (int j = 0; j < 8; ++j) {
            const int n = 4 * F.lane + 256 * j;
            const f32x4 gg = *(const f32x4*)(gpost + n), gt = *(const f32x4*)(gate + n);
            v[j] = xr[64 * j] + gt * (v[j] * r * gg);
            s2 += (v[j].x * v[j].x + v[j].y * v[j].y) + (v[j].z * v[j].z + v[j].w * v[j].w);
        }
        if (FIRST) {
            const float r2 = rsqrtf(wave_sum(s2) * (1.f / D) + NORM_EPS);
            const float* g2 = F.in[19];
            unsigned long long* o8 = (unsigned long long*)(H2 + (size_t)m * D) + F.lane;
#pragma unroll
            for (int j = 0; j < 8; ++j) {
                const int n = 4 * F.lane + 256 * j;
                const f32x4 gg = *(const f32x4*)(g2 + n), sh = *(const f32x4*)(mod + 3 * D + n), sc = *(const f32x4*)(mod + 4 * D + n);
                const f32x4 o = v[j] * r2 * gg * (sc + 1.0f) + sh;
                o8[64 * j] = (unsigned long long)pk2(o.x, o.y) | ((unsigned long long)pk2(o.z, o.w) << 32);
            }
        } else {
            const float rf = rsqrtf(wave_sum(sf) * (1.f / D) + NORM_EPS);
            const float* gpf = F.in[20]; const float* gatef = mod + 5 * D;
            f32x4* orow = (f32x4*)(F.out + (size_t)m * D) + F.lane;
#pragma unroll
            for (int j = 0; j < 8; ++j) {
                const int n = 4 * F.lane + 256 * j;
                const f32x4 gg = *(const f32x4*)(gpf + n), gt = *(const f32x4*)(gatef + n);
                orow[64 * j] = v[j] + gt * (f[j] * rf * gg);
            }
        }
    }
}
constexpr int X8_CAP = 128;
constexpr int X8_HIST_OFF = AUX_OFF, X8_MASKW_OFF = X8_HIST_OFF + 8 * (IDX_NBIN / 2) * 4, X8_CI_OFF = X8_MASKW_OFF + 8 * 128 * 8, X8_CX_OFF = X8_CI_OFF + 8 * X8_CAP * 2, X8_END = X8_CX_OFF + 8 * X8_CAP * 4;
constexpr int X8_SCALE_OFF = LDSCTL_OFF + 512, X8_CNT_OFF = X8_SCALE_OFF + 32, X8_FB_OFF = X8_CNT_OFF + 32;
constexpr int X8_WQ_OFF = X8_END;
static_assert(X8_WQ_OFF + 512 <= LDS_BYTES && X8_END <= LDS_BYTES && 8 * 8192 * 2 <= RING_BYTES && X8_FB_OFF + 32 <= LDSCTL_OFF + 640, "8-query indexer LDS map");
struct X8Regs { bf16x8 a[4][4]; f32x4 wq[4][4]; bf16x8 bA[4], bB[4], bC[4]; };
#define X8_ZERO16 ((f32x16){0.f, 0.f, 0.f, 0.f, 0.f, 0.f, 0.f, 0.f, 0.f, 0.f, 0.f, 0.f, 0.f, 0.f, 0.f, 0.f})
#define X8_HEADSUM(S_, WQ_, DD_) do { S_ = 0.f; _Pragma("unroll") for (int i_ = 0; i_ < 16; ++i_) S_ = __builtin_fmaf((WQ_)[i_ >> 2][i_ & 3], relu_asm((DD_)[i_]), S_); S_ += 0.0f; } while (0)
__device__ __forceinline__ unsigned x8_y16(float s, float scale64) { const unsigned u = (unsigned)fmaxf(fmaf(s, scale64, 64.0f * (float)(IDX_NBIN / 2)), 0.0f); return u < 65535u ? u : 65535u; }
__device__ __forceinline__ void x8_prefetch(const Frame& F, int t0, X8Regs& R) {
    const bf16* QIDX = (const bf16*)(F.ws + WS_QIDX); const bf16* KIDX = (const bf16*)(F.ws + WS_KIDX);
    const int lane = F.lane, r = lane & 31, hh = lane >> 5, w = F.wave, NT = t0 / 32 + 1;
#define X8_LOAD0(B_, kt_) do { const int ktc_ = (kt_) < NT ? (kt_) : NT - 1; \
        _Pragma("unroll") for (int ks = 0; ks < 4; ++ks) B_[ks] = *(const bf16x8*)(KIDX + (size_t)ktc_ * 2048 + ks * 512 + lane * 8); } while (0)
    X8_LOAD0(R.bA, w); X8_LOAD0(R.bB, w + 8); X8_LOAD0(R.bC, w + 16);
#undef X8_LOAD0
#pragma unroll
    for (int m = 0; m < 4; ++m) {
        const int tq = t0 + 2 * m + ((r >> 2) & 1), head = (r & 3) + 4 * (r >> 3);
#pragma unroll
        for (int ks = 0; ks < 4; ++ks) R.a[m][ks] = *(const bf16x8*)(QIDX + (size_t)tq * 1024 + head * 64 + 16 * ks + 8 * hh);
    }
}
__device__ __forceinline__ void x8_stage_wq(const Frame& F, int t0) { if (F.tid < 128) ((LAS float*)(F.lds + X8_WQ_OFF))[F.tid] = ((const float*)(F.ws + WS_IDXW))[t0 * 16 + F.tid]; }
__device__ __forceinline__ void x8_fetch_wq(const Frame& F, X8Regs& R) {
    const LAS f32x4* wl = (const LAS f32x4*)(F.lds + X8_WQ_OFF) + (F.lane >> 5) * 4;
#pragma unroll
    for (int m = 0; m < 4; ++m)
#pragma unroll
        for (int i4 = 0; i4 < 4; ++i4) R.wq[m][i4] = wl[m * 8 + i4];
}
__device__ __forceinline__ float x8_score_q(const X8Regs& R, int qi, const bf16x8 (&Bg)[4]) {
    float s = 0.f;
#define X8_CASE(M_) { asm volatile("; x8 row tile %0" :: "n"(M_));     \
        f32x16 d_ = X8_ZERO16; _Pragma("unroll") for (int ks = 0; ks < 4; ++ks) d_ = __builtin_amdgcn_mfma_f32_32x32x16_bf16(R.a[M_][ks], Bg[ks], d_, 0, 0, 0); X8_HEADSUM(s, R.wq[M_], d_); asm volatile("; x8 row tile %0 done" :: "n"(M_), "v"(s)); }
    const int m = qi >> 1;
    if (m == 0) X8_CASE(0) else if (m == 1) X8_CASE(1) else if (m == 2) X8_CASE(2) else X8_CASE(3)
#undef X8_CASE
    return s;
}
template <int G>
__device__ __forceinline__ void x8_pass_group(const LAS unsigned short* rp, unsigned thrLo, unsigned thrHi, unsigned& hlo, unsigned& hhi, unsigned& clo, unsigned& chi) {
    unsigned xv[8];
#pragma unroll
    for (int u = 0; u < 8; ++u) xv[u] = rp[512 * G + 64 * u];
    __builtin_amdgcn_sched_barrier(0);
#define X8_W(u_) { const unsigned long long hiw = __ballot(xv[u_] >= thrHi), cw = __ballot(xv[u_] >= thrLo) & ~hiw; \
        asm("s_nop 0\n\tv_writelane_b32 %0, %4, %8\n\tv_writelane_b32 %1, %5, %8\n\tv_writelane_b32 %2, %6, %8\n\tv_writelane_b32 %3, %7, %8" \
            : "+v"(hlo), "+v"(hhi), "+v"(clo), "+v"(chi) : "s"((unsigned)hiw), "s"((unsigned)(hiw >> 32)), "s"((unsigned)cw), "s"((unsigned)(cw >> 32)), "n"((8 * G + u_) & 63)); }
    X8_W(0) X8_W(1) X8_W(2) X8_W(3) X8_W(4) X8_W(5) X8_W(6) X8_W(7)
#undef X8_W
}
__device__ __forceinline__ void x8_zero_hist(const Frame& F) { LAS unsigned* hist = (LAS unsigned*)(F.lds + X8_HIST_OFF); for (int i = F.tid; i < 8 * (IDX_NBIN / 2); i += 512) hist[i] = 0u; }
__device__ __forceinline__ void x8_item(const Frame& F, int t0, int t0n, float kmax, X8Regs& R) {
    LAS unsigned short* sc = (LAS unsigned short*)(F.lds + RING_OFF);
    LAS unsigned* hist = (LAS unsigned*)(F.lds + X8_HIST_OFF);
    LAS unsigned* ccount = (LAS unsigned*)(F.lds + X8_CNT_OFF);
    LAS unsigned* fbflag = (LAS unsigned*)(F.lds + X8_FB_OFF);
    const bf16* KIDX = (const bf16*)(F.ws + WS_KIDX);
    const int w = F.wave;
    const int NT = t0 / 32 + 1;
    {
        const int lane = F.lane, r = lane & 31, hh = lane >> 5;
        float bs[4];
        x8_fetch_wq(F, R);
        bf16x8 (&a)[4][4] = R.a; f32x4 (&wq)[4][4] = R.wq;
#pragma unroll
        for (int m = 0; m < 4; ++m) {
            const int tq = t0 + 2 * m + ((r >> 2) & 1), head = (r & 3) + 4 * (r >> 3);
            float ss = 0.f;
#pragma unroll
            for (int ks = 0; ks < 4; ++ks) { const v4u x = __builtin_bit_cast(v4u, a[m][ks]); const unsigned ww[4] = {x.x, x.y, x.z, x.w};
#pragma unroll
                for (int e = 0; e < 4; ++e) ss += bflo(ww[e]) * bflo(ww[e]) + bfhi(ww[e]) * bfhi(ww[e]); }
            ss += __shfl_xor(ss, 32);
            float term = sqrtf(ss) * fabsf(((const LAS float*)(F.lds + X8_WQ_OFF))[(tq - t0) * 16 + head]);
            term += __shfl_xor(term, 1); term += __shfl_xor(term, 2); term += __shfl_xor(term, 8); term += __shfl_xor(term, 16);
            const float scl = (float)(IDX_NBIN / 2 - 1) / (term * kmax * (1.03f / IDX_ZOOM) + 1e-30f);
            const float other = __shfl_xor(scl, 4);
            const float s_even = ((r >> 2) & 1) ? other : scl, s_odd = ((r >> 2) & 1) ? scl : other;
            bs[m] = 64.0f * (hh ? s_odd : s_even);
        }
#define X8_LOAD(B_, kt_) do { const int ktc_ = (kt_) < NT ? (kt_) : NT - 1;     \
        _Pragma("unroll") for (int ks = 0; ks < 4; ++ks) B_[ks] = *(const bf16x8*)(KIDX + (size_t)ktc_ * 2048 + ks * 512 + lane * 8); } while (0)
#define X8_COMP_(B_, kt_, MASKED_) do { \
            _Pragma("unroll") for (int m = 0; m < 4; ++m) { \
                f32x16 dd = X8_ZERO16;     \
                _Pragma("unroll") for (int ks = 0; ks < 4; ++ks) dd = __builtin_amdgcn_mfma_f32_32x32x16_bf16(a[m][ks], B_[ks], dd, 0, 0, 0); \
                float s; X8_HEADSUM(s, wq[m], dd); \
                const int key = 32 * (kt_) + r, q = 2 * m + hh; const bool ok = !(MASKED_) || key <= t0 + q; \
                const unsigned u = x8_y16(s, bs[m]); \
                sc[q * 8192 + key] = (unsigned short)(ok ? u : 0u); \
                if (ok) __hip_atomic_fetch_add(hist + q * (IDX_NBIN / 2) + (u >> 7), 1u + 0xFFFFu * ((u >> 6) & 1u), __ATOMIC_RELAXED, __HIP_MEMORY_SCOPE_WORKGROUP); \
                __builtin_amdgcn_sched_barrier(0); } } while (0)
#define X8_COMP(B_, kt_) do { if ((kt_) < NT - 1) X8_COMP_(B_, kt_, 0); else if ((kt_) < NT) X8_COMP_(B_, kt_, 1); } while (0)
#define X8_PIN() __builtin_amdgcn_sched_barrier(0)
        bf16x8 (&bA)[4] = R.bA, (&bB)[4] = R.bB, (&bC)[4] = R.bC;
        X8_PIN();
        for (int kt = w; kt < NT; kt += 24) {
            X8_COMP(bA, kt); X8_PIN(); X8_LOAD(bA, kt + 24); X8_PIN();
            X8_COMP(bB, kt + 8); X8_PIN(); X8_LOAD(bB, kt + 32); X8_PIN();
            X8_COMP(bC, kt + 16); X8_PIN(); X8_LOAD(bC, kt + 40); X8_PIN();
        }
        X8_PIN();
#undef X8_PIN
#undef X8_LOAD
#undef X8_COMP
#undef X8_COMP_
    }
    int lane_o = F.lane; asm volatile("" : "+v"(lane_o));
    const int lane = lane_o, r = lane & 31, hh = lane >> 5;
    if (F.tid < 8) { ccount[F.tid] = 0u; fbflag[F.tid] = 0u; }
    if ((NT & 1) && F.tid < 256) sc[(F.tid >> 5) * 8192 + 32 * NT + (F.tid & 31)] = 0;
    LDS_WAIT(); __syncthreads();
    const int q = w, t = t0 + q, n = t + 1, nw = (n + 63) >> 6;
    LAS unsigned long long* mw = (LAS unsigned long long*)(F.lds + X8_MASKW_OFF) + q * 128;
    LAS unsigned short* ci = (LAS unsigned short*)(F.lds + X8_CI_OFF) + q * X8_CAP;
    LAS float* cx = (LAS float*)(F.lds + X8_CX_OFF) + q * X8_CAP;
    {
        LAS unsigned* hq = hist + q * (IDX_NBIN / 2);
        int Bbin = 0, inB = 0, need = 0; bool usehist = false;
        constexpr int BPL = IDX_NBIN / 64;
        static_assert(BPL == 16, "16 bins = 8 packed words per lane");
        {
            LAS v4u* h4 = (LAS v4u*)hq + 2 * lane;
            int hv[BPL];
#pragma unroll
            for (int q4 = 0; q4 < 2; ++q4) { const v4u hh4 = h4[q4]; const unsigned pw[4] = {hh4.x, hh4.y, hh4.z, hh4.w};
#pragma unroll
                for (int e = 0; e < 4; ++e) { hv[8 * q4 + 2 * e] = (int)(pw[e] & 0xffffu); hv[8 * q4 + 2 * e + 1] = (int)(pw[e] >> 16); } }
            h4[0] = (v4u){0u, 0u, 0u, 0u}; h4[1] = (v4u){0u, 0u, 0u, 0u};
            if (t >= 256) {
                int mine = 0;
#pragma unroll
                for (int e = 0; e < BPL; ++e) mine += hv[e];
                int suf = mine;
#pragma unroll
                for (int o = 1; o < 64; o <<= 1) { const int v = __shfl_down(suf, o); if (lane + o < 64) suf += v; }
                const unsigned long long ge = __ballot(suf >= 256);
                const int L = 63 - __builtin_clzll(ge);
                int acc = suf - mine, bsel = 0, csel = 0, asel = 0; bool found = false;
#pragma unroll
                for (int e = BPL - 1; e >= 0; --e) { const bool hit = !found && (acc + hv[e] >= 256); bsel = hit ? e : bsel; csel = hit ? hv[e] : csel; asel = hit ? acc : asel; found = found || hit; acc += hv[e]; }
                Bbin = BPL * L + __builtin_amdgcn_readlane(bsel, L); inB = __builtin_amdgcn_readlane(csel, L);
                need = 256 - __builtin_amdgcn_readlane(asel, L);
                usehist = inB <= X8_CAP && Bbin >= 1;
            }
        }
        if (usehist) {
            const unsigned thrLo = (unsigned)Bbin << 6, thrHi = ((unsigned)Bbin + 1u) << 6;
            unsigned h0l = 0u, h0h = 0u, c0l = 0u, c0h = 0u, h1l = 0u, h1h = 0u, c1l = 0u, c1h = 0u;
            const LAS unsigned short* rp = sc + q * 8192 + lane;
#define X8_G0(G_) if (nw > 8 * (G_)) x8_pass_group<G_>(rp, thrLo, thrHi, h0l, h0h, c0l, c0h);
#define X8_G1(G_) if (nw > 8 * (G_)) x8_pass_group<G_>(rp, thrLo, thrHi, h1l, h1h, c1l, c1h);
            X8_G0(0) X8_G0(1) X8_G0(2) X8_G0(3) X8_G0(4) X8_G0(5) X8_G0(6) X8_G0(7) X8_G1(8) X8_G1(9) X8_G1(10) X8_G1(11) X8_G1(12) X8_G1(13) X8_G1(14) X8_G1(15)
#undef X8_G0
#undef X8_G1
            const bool v0 = lane < nw, v1 = 64 + lane < nw;
            mw[lane] = v0 ? (((unsigned long long)h0h << 32) | h0l) : 0ull; mw[64 + lane] = v1 ? (((unsigned long long)h1h << 32) | h1l) : 0ull;
            unsigned long long cw0 = v0 ? (((unsigned long long)c0h << 32) | c0l) : 0ull, cw1 = v1 ? (((unsigned long long)c1h << 32) | c1l) : 0ull;
            const int nc = __builtin_popcountll(cw0) + __builtin_popcountll(cw1);
            if (nc) {
                int off = (int)__hip_atomic_fetch_add(ccount + q, (unsigned)nc, __ATOMIC_RELAXED, __HIP_MEMORY_SCOPE_WORKGROUP);
                while (cw0) { ci[off++] = (unsigned short)(64 * lane + __builtin_ctzll(cw0)); cw0 &= cw0 - 1ull; }
                while (cw1) { ci[off++] = (unsigned short)(64 * (64 + lane) + __builtin_ctzll(cw1)); cw1 &= cw1 - 1ull; }
            }
            LDS_WAIT();
            const int cnt = (int)*(volatile LAS unsigned*)(ccount + q);
            for (int c0 = 0; c0 < cnt; c0 += 32) {
                const int idx = c0 + r; const int key = idx < cnt ? (int)ci[idx] : 0;
                const bf16* kp = KIDX + (size_t)(key >> 5) * 2048 + (hh * 32 + (key & 31)) * 8;
                bf16x8 Bg[4];
#pragma unroll
                for (int ks = 0; ks < 4; ++ks) Bg[ks] = *(const bf16x8*)(kp + ks * 512);
                const float s = x8_score_q(R, q, Bg);
                if (hh == (q & 1) && idx < cnt) cx[idx] = s;
            }
            LDS_WAIT();
            for (int i0 = 0; i0 < cnt; i0 += 64) {
                const int i = i0 + lane; const bool act = i < cnt;
                const int ii = act ? (int)ci[i] : 0; const float xi = act ? cx[i] : 0.f;
                int rank = 0;
                for (int cb = 0; cb < cnt; cb += 64) {
                    const int jl = cb + lane; const bool jact = jl < cnt; const int ijv = jact ? (int)ci[jl] : 0; const float xjv = jact ? cx[jl] : 0.f;
                    const int cn = (cnt - cb < 64) ? cnt - cb : 64;
                    for (int l = 0; l < cn; ++l) {
                        const float xj = __builtin_bit_cast(float, __builtin_amdgcn_readlane(__builtin_bit_cast(int, xjv), l)); const int ij = __builtin_amdgcn_readlane(ijv, l);
                        rank += (xj > xi || (xj == xi && ij < ii)) ? 1 : 0;
                    }
                }
                if (act && rank < need) __hip_atomic_fetch_or(mw + (ii >> 6), 1ull << (ii & 63), __ATOMIC_RELAXED, __HIP_MEMORY_SCOPE_WORKGROUP);
            }
        } else if (t < 256) {
#pragma unroll
            for (int hf = 0; hf < 2; ++hf) { const int j = 64 * hf + lane; unsigned long long wv = 0ull;
                if (64 * j <= t) wv = (t - 64 * j >= 63) ? ~0ull : ((1ull << (t - 64 * j + 1)) - 1ull);
                mw[j] = wv; }
        } else if (lane == 0) fbflag[q] = 1u;
    }
    LDS_WAIT(); __syncthreads();
    {
        unsigned anyfb = 0u;
#pragma unroll
        for (int qf = 0; qf < 8; ++qf) anyfb |= fbflag[qf];
        if (anyfb) {
            LAS float* row = (LAS float*)(F.lds + RING_OFF);
            for (int qf = 0; qf < 8; ++qf) {
                if (fbflag[qf] == 0u) continue;
                const int tf = t0 + qf, nf = tf + 1, nwf = (nf + 63) >> 6, n256 = (nf + 255) >> 8;
                for (int kt = w; kt < NT; kt += 8) {
                    bf16x8 Bg[4];
#pragma unroll
                    for (int ks = 0; ks < 4; ++ks) Bg[ks] = *(const bf16x8*)(KIDX + (size_t)kt * 2048 + ks * 512 + lane * 8);
                    const float s = x8_score_q(R, qf, Bg);
                    const int key = 32 * kt + r;
                    if (hh == (qf & 1)) row[key] = (key <= tf) ? s : -INFINITY;
                }
                for (int idx = 32 * NT + F.tid; idx < 256 * n256; idx += 512) row[idx] = -INFINITY;
                LDS_WAIT(); __syncthreads();
                if (w == 0) {
                    LAS unsigned long long* mwf = (LAS unsigned long long*)(F.lds + X8_MASKW_OFF) + qf * 128;
                    unsigned long long w0 = 0ull, w1 = 0ull;
                    const LAS f32x4* row4 = (const LAS f32x4*)row;
                    unsigned T = 0u; bool exact = false; float pf = 0.f;
                    for (int bit = 31; bit >= 0; --bit) {
                        const unsigned cand = T | (1u << bit);
                        const float p = key2f(cand);
                        const int c = idx_count_ge(row4, n256, p, lane);
                        if (c >= 256) { T = cand; pf = p; if (c == 256) { exact = true; break; } }
                    }
                    int need2 = 0;
                    if (!exact) {
                        int cg = 0;
                        for (int it = 0; it < n256; ++it) { const f32x4 v = row4[it * 64 + lane]; cg += (v.x > pf ? 1 : 0) + (v.y > pf ? 1 : 0) + (v.z > pf ? 1 : 0) + (v.w > pf ? 1 : 0); }
                        need2 = 256 - wave_isum(cg);
                    }
                    for (int j = 0; j < nwf; ++j) {
                        const float x = row[64 * j + lane];
                        unsigned long long b;
                        if (exact) b = __ballot(x >= pf);
                        else {
                            b = __ballot(x > pf);
                            unsigned long long eq = __ballot(x == pf);
                            while (need2 > 0 && eq) { const unsigned long long low = eq & (~eq + 1ull); b |= low; eq ^= low; --need2; }
                        }
                        if (lane == (j & 63)) { if (j < 64) w0 = b; else w1 = b; }
                    }
                    mwf[lane] = w0; mwf[64 + lane] = w1;
                }
                LDS_WAIT(); __syncthreads();
            }
        }
    }
    x8_prefetch(F, t0n, R);
    x8_stage_wq(F, t0n);
    {
        const LAS unsigned long long* mwa = (const LAS unsigned long long*)(F.lds + X8_MASKW_OFF);
        const int ntw = 4 * (t0 >> 8) + 4;
        for (int g = F.tid; g < ntw * 32; g += 512) {
            const int j = g >> 5, qq = (g >> 2) & 7, hs = g & 3;
            const unsigned nib = (unsigned)(mwa[qq * 128 + j] >> (32 * (hs & 1) + 4 * (hs >> 1)));
            v4u o;
#pragma unroll
            for (int k = 0; k < 4; ++k) { const unsigned b = (((nib >> (8 * k)) & 15u) * 0x00204081u) & 0x01010101u; o[k] = (b ^ 0x01010101u) * 0xFCu; }
            unsigned char* mb = F.ws + (j < 64 ? WS_MASKB0 : WS_MASKB1 - (size_t)64 * 524288) + (size_t)j * 524288 + (size_t)t0 * 64;
            *(v4u*)(mb + (g & 31) * 16) = o;
        }
    }
    __syncthreads();
}
namespace att {
constexpr int D = 128, PITCH = 1024, NW = 8, QBLK = 32, KVBLK = 64, QB = NW * QBLK;
constexpr int SHM_V = KVBLK * D * 2, SHM_K = KVBLK * D * 2;
constexpr int LDS_BYTES = 2 * SHM_V + 2 * SHM_K + NW * 64 * 4;
constexpr float SCALE = 0.08838834764831845f, THR = 8.f;
constexpr float C2 = 1.4426950408889634f * SCALE;
typedef unsigned short bf16;
typedef short bf16x8 __attribute__((ext_vector_type(8)));
typedef short s16x4 __attribute__((ext_vector_type(4)));
typedef float f32x16 __attribute__((ext_vector_type(16)));
typedef float f32x4 __attribute__((ext_vector_type(4)));
typedef float f32x2 __attribute__((ext_vector_type(2)));
typedef unsigned u32x4 __attribute__((ext_vector_type(4)));
typedef unsigned long long u64;
#define KSWZ(row, colB) ((row) * 256 + ((colB) ^ (((row) & 7) << 4)))
#define SBAR() __builtin_amdgcn_sched_barrier(0)
__device__ __forceinline__ int v_st(int k, int c) { const int kk = (k & ~0xC) | ((k & 4) << 1) | ((k & 8) >> 1); return ((kk >> 3) * 4 + (c >> 5)) * 512 + ((kk & 7) * 32 + (c & 31)) * 2; }
__device__ __forceinline__ int v_rd_base(int lane) { return ((lane & 3) << 3) | (((lane >> 2) & 3) << 6) | (((lane >> 4) & 1) << 5) | (((lane >> 5) & 1) << 8); }
constexpr int v_rd_off(int d0, int ks, int half) { return d0 * 512 + ks * 4096 + half * 2048; }
__device__ __forceinline__ int crow(int r, int hi) { return (r & 3) + 8 * (r >> 2) + 4 * hi; }
typedef __bf16 bf16x2_t __attribute__((ext_vector_type(2)));
__device__ __forceinline__ unsigned cvtpk(float lo, float hi) { const float __attribute__((ext_vector_type(2))) v = {lo, hi}; const bf16x2_t b = __builtin_convertvector(v, bf16x2_t); return __builtin_bit_cast(unsigned, b); }
__device__ __forceinline__ bf16x8 load8(const bf16* p) { return *reinterpret_cast<const bf16x8*>(p); }
__device__ __forceinline__ void partialSM(f32x16& p0, f32x16& p1, float& m_reg, float& mn, float& alpha) {
    float pmax = p0[0]; for (int r = 1; r < 16; ++r) pmax = fmaxf(pmax, p0[r]); for (int r = 0; r < 16; ++r) pmax = fmaxf(pmax, p1[r]);
    { auto rr = __builtin_amdgcn_permlane32_swap(__float_as_uint(pmax), __float_as_uint(pmax), false, false);
      pmax = fmaxf(__uint_as_float(rr[0]), __uint_as_float(rr[1])); }
    if (__builtin_expect(__all((pmax - m_reg) * SCALE <= THR), 1)) { mn = m_reg; alpha = 1.f; }
    else { mn = fmaxf(m_reg, pmax); alpha = __builtin_amdgcn_exp2f((m_reg - mn) * C2); m_reg = mn; }
    const float mnL = -mn * C2;
    for (int r = 0; r < 16; ++r) p0[r] = fmaf(p0[r], C2, mnL); for (int r = 0; r < 16; ++r) p1[r] = fmaf(p1[r], C2, mnL);
    for (int r = 0; r < 16; ++r) p0[r] = __builtin_amdgcn_exp2f(p0[r]);
}
__device__ __forceinline__ void finishSM(f32x16& p0, f32x16& p1, float alpha, float& l_reg, bf16x8& pa0, bf16x8& pa1, bf16x8& pa2, bf16x8& pa3) {
    for (int r = 0; r < 16; ++r) p1[r] = __builtin_amdgcn_exp2f(p1[r]);
    float ps = 0; for (int r = 0; r < 16; ++r) ps += p0[r]; for (int r = 0; r < 16; ++r) ps += p1[r];
    { auto rr = __builtin_amdgcn_permlane32_swap(__float_as_uint(ps), __float_as_uint(ps), false, false);
      ps = __uint_as_float(rr[0]) + __uint_as_float(rr[1]); }
    l_reg = l_reg * alpha + ps;
#define PK4(P, B_, OUT) do { unsigned a0 = cvtpk(P[B_+0], P[B_+1]), a1 = cvtpk(P[B_+2], P[B_+3]);                          \
        unsigned b0 = cvtpk(P[B_+4], P[B_+5]), b1 = cvtpk(P[B_+6], P[B_+7]);                                             \
        auto r0 = __builtin_amdgcn_permlane32_swap(a0, b0, false, false); auto r1 = __builtin_amdgcn_permlane32_swap(a1, b1, false, false); \
        u32x4 w = {r0[0], r1[0], r0[1], r1[1]}; OUT = *reinterpret_cast<bf16x8*>(&w); } while (0)
    PK4(p0, 0, pa0); PK4(p0, 8, pa1); PK4(p1, 0, pa2); PK4(p1, 8, pa3);
#undef PK4
}
template <int KB>
__device__ __forceinline__ void qkt(f32x16& p0, f32x16& p1, const char* K_lds, int r32, int hi, const bf16x8* qr, u32x4 wa, u32x4 wb) {
#pragma unroll
    for (int w4 = 0; w4 < 4; ++w4) {
        const f32x2 a0 = __builtin_amdgcn_cvt_pk_f32_bf8((int)wa[w4], false), a1 = __builtin_amdgcn_cvt_pk_f32_bf8((int)wa[w4], true);
        const f32x2 b0 = __builtin_amdgcn_cvt_pk_f32_bf8((int)wb[w4], false), b1 = __builtin_amdgcn_cvt_pk_f32_bf8((int)wb[w4], true);
        p0[4 * w4] = a0.x; p0[4 * w4 + 1] = a0.y; p0[4 * w4 + 2] = a1.x; p0[4 * w4 + 3] = a1.y;
        p1[4 * w4] = b0.x; p1[4 * w4 + 1] = b0.y; p1[4 * w4 + 2] = b1.x; p1[4 * w4 + 3] = b1.y;
    }
    const char* kb[4];
#pragma unroll
    for (int dd = 0; dd < 4; ++dd) kb[dd] = K_lds + KB * SHM_K + KSWZ(r32, (dd * 16 + hi * 8) * 2);
#pragma unroll
    for (int d0 = 0; d0 < 8; ++d0) { const char* a = kb[d0 & 3] + (d0 >> 2) * 128;
        bf16x8 b0 = *reinterpret_cast<const bf16x8*>(a);
        bf16x8 b1 = *reinterpret_cast<const bf16x8*>(a + 32 * 256);
        p0 = __builtin_amdgcn_mfma_f32_32x32x16_bf16(b0, qr[d0], p0, 0, 0, 0);
        p1 = __builtin_amdgcn_mfma_f32_32x32x16_bf16(b1, qr[d0], p1, 0, 0, 0); }
}
template <int VB>
__device__ __forceinline__ void pv_tile(f32x16* o, int vb0, bf16x8 pa0, bf16x8 pa1, bf16x8 pa2, bf16x8 pa3) {
#define TRRD(dst, off) asm volatile("ds_read_b64_tr_b16 %0, %1 offset:%2" : "=&v"(dst) : "v"(vb0), "i"(off) : "memory")
#define PV_D0(d0) do { s16x4 l0, l1, l2, l3, h0, h1, h2, h3; constexpr int b_ = VB * SHM_V + v_rd_off(d0, 0, 0); \
        TRRD(l0, b_); TRRD(h0, b_ + 2048); TRRD(l1, b_ + 4096); TRRD(h1, b_ + 6144); TRRD(l2, b_ + 8192); TRRD(h2, b_ + 10240); TRRD(l3, b_ + 12288); TRRD(h3, b_ + 14336); \
        asm volatile("s_waitcnt lgkmcnt(0)" ::: "memory"); SBAR();   \
        o[d0] = __builtin_amdgcn_mfma_f32_32x32x16_bf16(pa0, (bf16x8){l0[0], l0[1], l0[2], l0[3], h0[0], h0[1], h0[2], h0[3]}, o[d0], 0, 0, 0);   \
        o[d0] = __builtin_amdgcn_mfma_f32_32x32x16_bf16(pa1, (bf16x8){l1[0], l1[1], l1[2], l1[3], h1[0], h1[1], h1[2], h1[3]}, o[d0], 0, 0, 0);   \
        o[d0] = __builtin_amdgcn_mfma_f32_32x32x16_bf16(pa2, (bf16x8){l2[0], l2[1], l2[2], l2[3], h2[0], h2[1], h2[2], h2[3]}, o[d0], 0, 0, 0);   \
        o[d0] = __builtin_amdgcn_mfma_f32_32x32x16_bf16(pa3, (bf16x8){l3[0], l3[1], l3[2], l3[3], h3[0], h3[1], h3[2], h3[3]}, o[d0], 0, 0, 0); } while (0)
    PV_D0(0); PV_D0(1); PV_D0(2); PV_D0(3);
#undef PV_D0
#undef TRRD
}
struct BlockRef { int P0, j_lo, j_hi; int uid, pid; unsigned* cnt; };
struct Bufs { bf16* YBh; const char* Qh; const char* Kh; const char* Vh; const char* Mh0; const char* Mh1; };
__device__ __forceinline__ bf16x8 bload8(__amdgpu_buffer_rsrc_t r, unsigned voff, unsigned soff) { return __builtin_bit_cast(bf16x8, __builtin_amdgcn_raw_buffer_load_b128(r, voff, soff, 0)); }
typedef unsigned u32x2 __attribute__((ext_vector_type(2)));
__device__ __forceinline__ u64 bload_u64(__amdgpu_buffer_rsrc_t r, unsigned voff, unsigned soff) { const u32x2 w = __builtin_amdgcn_raw_buffer_load_b64(r, voff, soff, 0); return (u64)w.x | ((u64)w.y << 32); }
struct Seam { bf16x8 qr[8]; bf16x8 st_v0, st_v1, st_k0, st_k1; };
#define VMW() asm volatile("s_waitcnt vmcnt(0)" ::: "memory")
#define VMWN(n) asm volatile("s_waitcnt vmcnt(%0)" :: "i"(n) : "memory")
#define GLD8(base_, voff_) (*(const bf16x8*)((const char*)(base_) + (size_t)(unsigned)(voff_)))
#define SLOAD_H(k0) do { const char* kb_ = B.Kh + (size_t)(k0) * (PITCH * 2); const char* vb_ = B.Vh + (size_t)(k0) * (PITCH * 2);                    \
                         S.st_v0 = GLD8(vb_, voff); S.st_v1 = GLD8(vb_ + 32 * PITCH * 2, voff); S.st_k0 = GLD8(kb_, voff); S.st_k1 = GLD8(kb_ + 32 * PITCH * 2, voff); } while (0)
#define QLOAD(R_) do { const char* qb_ = B.Qh + (size_t)((R_).P0) * (PITCH * 2); _Pragma("unroll") for (int d0 = 0; d0 < 8; ++d0) S.qr[d0] = GLD8(qb_ + d0 * 32, voffq); } while (0)
#define SWRITE_HK(bf) do { *(bf16x8*)(K_lds + (bf) * SHM_K + kws) = S.st_k0; *(bf16x8*)(K_lds + (bf) * SHM_K + kws + 32 * 256) = S.st_k1; } while (0)
#define SWRITE_HV(bf) do { *(bf16x8*)(V_lds + (bf) * SHM_V + vst0) = S.st_v0; *(bf16x8*)(V_lds + (bf) * SHM_V + vst1) = S.st_v1; } while (0)
#define SWRITE_H(bf) do { SWRITE_HV(bf); SWRITE_HK(bf); } while (0)
__device__ __forceinline__ void prime(const BlockRef& cur, const Bufs& B, char* lds, Seam& S) {
    const int tid = threadIdx.x, wid = __builtin_amdgcn_readfirstlane(tid >> 6), lane = tid & 63, r32 = lane & 31, hi = lane >> 5;
    const int sr = tid >> 4, sc = (tid & 15) * 8, kws = KSWZ(sr, sc * 2); char* K_lds = lds + 2 * SHM_V;
    const unsigned voff = (unsigned)(sr * PITCH + sc) * 2u, voffq = (unsigned)((wid * QBLK + r32) * PITCH + hi * 8) * 2u;
    const int kb0 = cur.j_lo * KVBLK;
    QLOAD(cur);
    SLOAD_H(kb0); VMW(); SWRITE_HK(0);
    __syncthreads();
}
__device__ __forceinline__ void block(const BlockRef& cur, const BlockRef& nxt, const Bufs& B, float* PART, f32x2* ML, char* lds, Seam& S) {
    const int tid = threadIdx.x, wid = __builtin_amdgcn_readfirstlane(tid >> 6), lane = tid & 63, r32 = lane & 31, hi = lane >> 5;
    const int j_lo = cur.j_lo, NT = cur.j_hi - cur.j_lo;
    const int kbn = nxt.j_lo * KVBLK;
    char* V_lds = lds; char* K_lds = lds + 2 * SHM_V;
    float* ws = (float*)(lds + 2 * SHM_V + 2 * SHM_K) + wid * 64; float* li_l = ws, * al_l = ws + 32;
    float m_reg = -1e30f, l_reg = 0; f32x16 o[4] = {};
    const int sr = tid >> 4, sc = (tid & 15) * 8, vst0 = v_st(sr, sc), vst1 = v_st(32 + sr, sc), kws = KSWZ(sr, sc * 2);
    const int vb0 = (int)(uintptr_t)V_lds + v_rd_base(lane);
    const unsigned voff = (unsigned)(sr * PITCH + sc) * 2u, voffq = (unsigned)((wid * QBLK + r32) * PITCH + hi * 8) * 2u;
    const unsigned voffm = (unsigned)((wid * QBLK + r32) * 64 + hi * 32);
#define MBASE(t) (((j_lo + (t)) < 64 ? B.Mh0 : B.Mh1) + (size_t)(j_lo + (t)) * 524288u + (size_t)cur.P0 * 64u)
#define MLOAD(WA, WB, t) do { const char* mb_ = MBASE(t); WA = *(const u32x4*)(mb_ + (size_t)voffm); WB = *(const u32x4*)(mb_ + 16 + (size_t)voffm); } while (0)
#define RESC(a) do { if (__any((a) < 1.f)) { if (hi == 0) al_l[r32] = (a); asm volatile("s_waitcnt lgkmcnt(0)" ::: "memory");              \
                     for (int d_ = 0; d_ < 4; ++d_) for (int r = 0; r < 16; ++r) o[d_][r] *= al_l[crow(r, hi)]; } } while (0)
#define KBASE(t) ((j_lo + (t)) * KVBLK)
    constexpr int NQL = 8;
#define SEAM_K0() do { VMWN(NQL); SWRITE_HK(0); SBAR(); } while (0)
    f32x16 pA0, pA1, pB0, pB1; float mnA, mnB, alA, alB; bf16x8 pa0, pa1, pa2, pa3;
    u32x4 wcA, wcB, wnA = {0u, 0u, 0u, 0u}, wnB = {0u, 0u, 0u, 0u}; MLOAD(wcA, wcB, 0);
    SWRITE_HV(0); SBAR();
    if (NT > 1) { SLOAD_H(KBASE(1)); MLOAD(wnA, wnB, 1); }
    SBAR(); qkt<0>(pA0, pA1, K_lds, r32, hi, S.qr, wcA, wcB);
    partialSM(pA0, pA1, m_reg, mnA, alA);
    if (NT > 1) { VMW(); SWRITE_H(1); }
    __syncthreads();
#define HALF_STEP(PX0, PX1, mnX, alX, PY0, PY1, alY, t, KB, VB, SB) do {                                                      \
        wcA = wnA; wcB = wnB;                                                                                                 \
        SBAR(); qkt<KB>(PX0, PX1, K_lds, r32, hi, S.qr, wcA, wcB);                                                           \
        finishSM(PY0, PY1, alY, l_reg, pa0, pa1, pa2, pa3); SBAR();                                                           \
        if ((t) + 1 < NT) { SLOAD_H(KBASE((t) + 1)); MLOAD(wnA, wnB, (t) + 1); SBAR(); }               \
        pv_tile<VB>(o, vb0, pa0, pa1, pa2, pa3); partialSM(PX0, PX1, m_reg, mnX, alX);                                        \
        __syncthreads();                                                                                                      \
        if ((t) + 1 < NT) { VMW(); SWRITE_H(SB); }                                                                            \
        RESC(alX); __syncthreads(); } while (0)
    for (int t = 1; t + 1 < NT; t += 2) {
        HALF_STEP(pB0, pB1, mnB, alB, pA0, pA1, alA, t, 1, 0, 0);
        HALF_STEP(pA0, pA1, mnA, alA, pB0, pB1, alB, t + 1, 0, 1, 1);
    }
    const bool even = (NT & 1) == 0;
    if (even) { wcA = wnA; wcB = wnB; SBAR(); qkt<1>(pB0, pB1, K_lds, r32, hi, S.qr, wcA, wcB); SBAR(); }
    SLOAD_H(kbn); SBAR();
    QLOAD(nxt);
    SBAR();
    finishSM(pA0, pA1, alA, l_reg, pa0, pa1, pa2, pa3); SBAR();
    pv_tile<0>(o, vb0, pa0, pa1, pa2, pa3);
    if (even) { partialSM(pB0, pB1, m_reg, mnB, alB); __syncthreads(); RESC(alB);
        finishSM(pB0, pB1, alB, l_reg, pa0, pa1, pa2, pa3); SBAR(); pv_tile<1>(o, vb0, pa0, pa1, pa2, pa3); }
    SBAR(); SEAM_K0();
    {
        float* po = PART + ((size_t)cur.uid * NW + wid) * 4096 + lane;
#pragma unroll
        for (int r = 0; r < 16; ++r)
#pragma unroll
            for (int d0 = 0; d0 < 4; ++d0) po[(r * 4 + d0) * 64] = o[d0][r];
        ML[((size_t)cur.uid * NW + wid) * 64 + lane] = (f32x2){m_reg, l_reg};
    }
    VMW();
    __syncthreads();
    unsigned* flag = (unsigned*)(lds + 2 * SHM_V + 2 * SHM_K + NW * 64 * 4);
    if (tid == 0) {
        __builtin_amdgcn_fence(__ATOMIC_RELEASE, "agent");
        asm volatile("s_waitcnt vmcnt(0)" ::: "memory");
        const unsigned old = __hip_atomic_fetch_add(cur.cnt, 1u, __ATOMIC_RELAXED, __HIP_MEMORY_SCOPE_AGENT);
        if (old == 1u) { __builtin_amdgcn_fence(__ATOMIC_ACQUIRE, "agent"); asm volatile("s_waitcnt vmcnt(0)" ::: "memory"); }
        *flag = old;
    }
    asm volatile("s_waitcnt lgkmcnt(0)" ::: "memory");
    __syncthreads();
    const bool last = (*(volatile unsigned*)flag) == 1u;
    if (last) {
        const f32x2 ml2 = ML[((size_t)cur.pid * NW + wid) * 64 + lane];
        const float m2 = ml2.x, l2 = ml2.y, mm = fmaxf(m_reg, m2);
        const float a1 = __builtin_amdgcn_exp2f((m_reg - mm) * C2), a2 = __builtin_amdgcn_exp2f((m2 - mm) * C2);
        const float linv = __builtin_amdgcn_rcpf(__fadd_rn(__fmul_rn(l_reg, a1), __fmul_rn(l2, a2)));
        if (hi == 0) { li_l[r32] = a1 * linv; al_l[r32] = a2 * linv; }
        asm volatile("s_waitcnt lgkmcnt(0)" ::: "memory");
        float o2[64];
        { const float* pp = PART + ((size_t)cur.pid * NW + wid) * 4096 + lane;
#pragma unroll
        for (int i = 0; i < 64; ++i) o2[i] = pp[i * 64]; }
#pragma unroll
        for (int r = 0; r < 16; ++r) { const int orow = crow(r, hi); const float f1 = li_l[orow], f2 = al_l[orow];
#pragma unroll
            for (int d0 = 0; d0 < 4; ++d0) o2[r * 4 + d0] = __fadd_rn(__fmul_rn(o[d0][r], f1), __fmul_rn(o2[r * 4 + d0], f2)); }
        const unsigned vo = (unsigned)(hi * 4 * PITCH + r32) * 2u, so = (unsigned)(cur.P0 + wid * QBLK) * (PITCH * 2);
#pragma unroll
        for (int r = 0; r < 16; ++r)
#pragma unroll
            for (int d0 = 0; d0 < 4; ++d0) { const float v = o2[r * 4 + d0]; const float vn = __shfl_xor(v, 1);
                if ((r32 & 1) == 0) *(unsigned*)((char*)B.YBh + (size_t)(so + ((r & 3) + 8 * (r >> 2)) * (PITCH * 2) + d0 * 64) + vo) = cvtpk(v, vn); }
    }
    __syncthreads();
#undef RESC
#undef KBASE
#undef SEAM_K0
#undef HALF_STEP
#undef MLOAD
#undef MBASE
}
#undef QLOAD
#undef GLD8
#undef VMW
#undef VMWN
#undef SLOAD_H
#undef SWRITE_HK
#undef SWRITE_HV
#undef SWRITE_H
#undef KSWZ
#undef SBAR
}
struct Args { const float* in[24]; float* out; unsigned char* ws; int ph_lo, ph_hi, li, pad; };
__global__ void __launch_bounds__(NWAVES * 64, 2) skel_fwd(Args args) {
    extern __shared__ __attribute__((aligned(16))) unsigned char lds[];
    Frame F;
    F.lds = (LAS unsigned char*)lds;
    F.MISC = (volatile LAS unsigned*)(F.lds + MISC_OFF);
    F.tid = threadIdx.x; F.lane = F.tid & 63; F.wave = __builtin_amdgcn_readfirstlane(F.tid >> 6);
    F.G = gridDim.x; { const int bx = blockIdx.x; F.vcu = (F.G % 8 == 0) ? (bx % 8) * (F.G / 8) + bx / 8 : bx; }
#pragma unroll
    for (int i = 0; i < 24; ++i) F.in[i] = args.in[i];
    F.out = args.out; F.ws = args.ws;
    F.ctl = (gu32*)(args.ws + WS_CTL);
    for (int u = F.tid; u < (LDS_BYTES - LDSCTL_OFF) / 4; u += NWAVES * 64) ((LAS unsigned*)(F.lds + LDSCTL_OFF))[u] = 0u;
    __syncthreads();
    XcdBarrier bar; bar.bar = (unsigned*)(F.ctl + CW_BAR); bar.x = 0; bar.st = nullptr;
    if (N_LAUNCHES == 1) bar = xcd_barrier_post((unsigned*)(F.ctl + CW_BAR), F.MISC + 8);
#define GRID_BAR() do { if (N_LAUNCHES == 1) xcd_barrier(bar); } while (0)
    const int lo = args.ph_lo, hi = args.ph_hi;
#define IN(k) (lo <= (k) && (k) < hi)
#define BOTH(k) (IN(k) && IN((k) + 1))
    unsigned char* ws = args.ws;
    const float* cosA = (const float*)(ws + WS_COSA); const float* sinA = (const float*)(ws + WS_SINA); const float* cosI = (const float*)(ws + WS_COSI); const float* sinI = (const float*)(ws + WS_SINI);

    if (IN(0)) { p0_prologue(F); if (BOTH(0)) GRID_BAR(); }
    if (IN(1)) { p1_prenorm(F); if (BOTH(1)) GRID_BAR(); }
    if (IN(2)) {
        pg8::Gemm g{(const pg8::bf16_t*)(ws + WS_H), (const pg8::bf16_t*)(ws + WS_WIN), S, NPROJ, D}; pg8::StaticOrder So; So.init(S, NPROJ, F.G, (int)blockIdx.x);
        pg8::EpiProj E{(pg8::bf16_t*)(ws + WS_U), (pg8::bf16_t*)(ws + WS_VG), (pg8::bf16_t*)(ws + WS_QLAT), (pg8::bf16_t*)(ws + WS_K), (pg8::bf16_t*)(ws + WS_V), (pg8::bf16_t*)(ws + WS_GATE), (pg8::bf16_t*)(ws + WS_SMALL),
                       (float*)(ws + WS_STATS), (float*)(ws + WS_STATS2), cosA, sinA};
        pg8::gemm_phase<pg8::EpiProj, pg8::StaticOrder, true, true>(F.lds + RING_OFF, g, So, E);
        { const int nun = (S / 256) * (NPROJ / 256), rem = nun % F.G;
          if (rem != 0 && (int)blockIdx.x >= rem) p_late_convert(F, 0, (int)blockIdx.x - rem, F.G - rem); else if (rem == 0) p_late_convert(F, 0, (int)blockIdx.x, F.G); }
        if (BOTH(2)) GRID_BAR();
    }
    if (IN(3)) {
        pg8::Gemm g{(const pg8::bf16_t*)(ws + WS_QLAT), (const pg8::bf16_t*)(ws + WS_WQQ), S, 2048, QL}; pg8::StaticOrder So; So.init(S, 2048, F.G, (int)blockIdx.x);
        LAS float* rt = (LAS float*)(F.lds + AUX_OFF);
        { pg8::Unit u0; if (So.next(0, u0)) p3_rt(F, u0.pm, rt); }
        LDS_WAIT(); __syncthreads();
        pg8::EpiQ E{(pg8::bf16_t*)(ws + WS_Q), (pg8::bf16_t*)(ws + WS_QIDX), (const PG8_LAS float*)rt, cosA, sinA, cosI, sinI, 1.0f};
        pg8::gemm_phase<pg8::EpiQ, pg8::StaticOrder, true, true>(F.lds + RING_OFF, g, So, E);
        __syncthreads();
        for (int it = F.vcu; it < 512; it += F.G) p3_spatial_item(F, it >> 3, it & 7);
        p3_kidx(F);
        if (BOTH(3)) GRID_BAR();
    }
    if (IN(4)) {
        const float kmax = idx_kmax(F);
        {
            X8Regs R;
#define P4_ITEM(rr_) ((rr_) * F.G + (((rr_) & 1) ? (F.G - 1 - F.vcu) : F.vcu))
            if (P4_ITEM(0) < S / 8) { x8_prefetch(F, 8 * P4_ITEM(0), R); x8_stage_wq(F, 8 * P4_ITEM(0)); }
            x8_zero_hist(F); LDS_WAIT(); __syncthreads();
            for (int rr = 0; rr * F.G < S / 8; ++rr) { const int it = P4_ITEM(rr), itn = P4_ITEM(rr + 1); if (it < S / 8) x8_item(F, 8 * it, (itn < S / 8) ? 8 * itn : 8 * it, kmax, R); }
#undef P4_ITEM
        }
        if (BOTH(4)) GRID_BAR();
    }
    if (IN(5)) {
        const int v = F.vcu & 255, h = v >> 5, i = v & 31, a = i & 15, zz = i >> 4;
        const att::bf16* Qb = (const att::bf16*)(ws + WS_Q); const att::bf16* Kb = (const att::bf16*)(ws + WS_K); const att::bf16* Vb = (const att::bf16*)(ws + WS_V); att::bf16* YB = (att::bf16*)(ws + WS_YB);
        att::BlockRef u0, u1;
#define MKREF(R, x_) do { const int x = (x_); R.P0 = 256 * x; const int half = 2 * (x + 1); R.j_lo = zz * half; R.j_hi = R.j_lo + half; R.uid = (h * 32 + x) * 2 + zz; R.pid = R.uid ^ 1; \
        R.cnt = (unsigned*)(F.ctl + CW_ATT) + (h * 32 + x) * 64; } while (0)
        MKREF(u0, a); MKREF(u1, 31 - a);
#undef MKREF
        att::Bufs B;
        B.YBh = YB + h * 128;
        B.Qh = (const char*)(Qb + h * 128); B.Kh = (const char*)(Kb + h * 128); B.Vh = (const char*)(Vb + h * 128); B.Mh0 = (const char*)(ws + WS_MASKB0); B.Mh1 = (const char*)(ws + WS_MASKB1) - (size_t)64 * 524288;
        att::Seam Sm;
        float* PART = F.out; att::f32x2* ML = (att::f32x2*)(ws + WS_WIN);
        { att::prime(u0, B, (char*)lds + RING_OFF, Sm);
        att::block(u0, u1, B, PART, ML, (char*)lds + RING_OFF, Sm);
        att::block(u1, u1, B, PART, ML, (char*)lds + RING_OFF, Sm); }
        if (BOTH(5)) GRID_BAR();
    }
    if (IN(6)) {
        pg8::Gemm g{(const pg8::bf16_t*)(ws + WS_U), (const pg8::bf16_t*)(ws + WS_WPA), S, D, GW, (const pg8::bf16_t*)(ws + WS_YB), (const pg8::bf16_t*)(ws + WS_WPB)};
        pg8::PairOrder So; So.init(S, D, F.G, (int)blockIdx.x);
        pg8::EpiGate2 E{(const pg8::bf16_t*)(ws + WS_GATE), (pg8::bf16_t*)(ws + WS_H)};
        pg8::gemm_phase<pg8::EpiGate2, pg8::PairOrder, true, true>(F.lds + RING_OFF, g, So, E);
    }
    if (IN(7)) { if (BOTH(7)) GRID_BAR(); }
    if (IN(8)) {
        pg8::Gemm g{(const pg8::bf16_t*)(ws + WS_H), (const pg8::bf16_t*)(ws + WS_WOUT), S, D, D}; pg8::StaticOrder So; So.init(S, D, F.G, (int)blockIdx.x);
        pg8::EpiOutBf16 E{(pg8::bf16_t*)(ws + WS_F)};
        pg8::gemm_phase<pg8::EpiOutBf16, pg8::StaticOrder, true, true>(F.lds + RING_OFF, g, So, E);
        if (BOTH(8)) GRID_BAR();
    }
    if (IN(9)) { p_rows<true>(F); if (BOTH(9)) GRID_BAR(); }
    if (IN(10)) {
        pg8::Gemm g{(const pg8::bf16_t*)(ws + WS_H), (const pg8::bf16_t*)(ws + WS_WGU), S, 2 * FF, D}; pg8::StaticOrder So; So.init(S, 2 * FF, F.G, (int)blockIdx.x);
        pg8::EpiSwiGLU E{(pg8::bf16_t*)(ws + WS_ACT), FF};
        pg8::gemm_phase<pg8::EpiSwiGLU, pg8::StaticOrder, true, true>(F.lds + RING_OFF, g, So, E);
        { const int nun = (S / 256) * (2 * FF / 256), rem = nun % F.G;
          if (rem != 0 && (int)blockIdx.x >= rem) p_late_convert(F, 1, (int)blockIdx.x - rem, F.G - rem); else if (rem == 0) p_late_convert(F, 1, (int)blockIdx.x, F.G); }
        if (BOTH(10)) GRID_BAR();
    }
    if (IN(11)) {
        pg8::Gemm g{(const pg8::bf16_t*)(ws + WS_ACT), (const pg8::bf16_t*)(ws + WS_WDOWN), S, D, FF}; pg8::StaticOrder So; So.init(S, D, F.G, (int)blockIdx.x);
        pg8::EpiOutBf16 E{(pg8::bf16_t*)(ws + WS_F2)};
        pg8::gemm_phase<pg8::EpiOutBf16, pg8::StaticOrder, true, true>(F.lds + RING_OFF, g, So, E);
        if (BOTH(11)) GRID_BAR();
    }
    if (IN(12)) { p_rows<false>(F); }
#undef IN
#undef BOTH
#undef GRID_BAR
}

extern "C" void kernel_launch(void* const* d_in, const int* in_sizes, int n_in, void* d_out, int out_size, void* d_ws, size_t ws_size, hipStream_t stream) {
    static int grid = 0;
    if (grid == 0) {
        if (n_in != 24 || out_size != S * D || ws_size < WS_END) { fprintf(stderr, "kernel_launch: unexpected problem (n_in %d, out %d, ws %zu)\n", n_in, out_size, ws_size); grid = -1; return; }
        if (hipFuncSetAttribute((const void*)skel_fwd, hipFuncAttributeMaxDynamicSharedMemorySize, LDS_BYTES) != hipSuccess) { fprintf(stderr, "kernel_launch: hipFuncSetAttribute failed\n"); grid = -1; return; }
        int dev = 0, cus = 0;
        if (hipGetDevice(&dev) != hipSuccess || hipDeviceGetAttribute(&cus, hipDeviceAttributeMultiprocessorCount, dev) != hipSuccess) { grid = -1; return; }
        (void)hipGetLastError();
        grid = 256;
        if (cus != 256) fprintf(stderr, "kernel_launch: device reports %d CUs; this kernel is built for 256\n", cus);
    }
    if (grid < 0) return;
    if (hipMemsetAsync((char*)d_ws + WS_CTL, 0, CTL_ZERO_BYTES, stream) != hipSuccess) return;
    Args a{};
    for (int i = 0; i < 24; ++i) a.in[i] = (const float*)d_in[i];
    a.out = (float*)d_out; a.ws = (unsigned char*)d_ws;
    if (N_LAUNCHES == 1) {
        a.ph_lo = 0; a.ph_hi = N_PHASES; a.li = 0;
        hipLaunchKernelGGL(skel_fwd, dim3(grid), dim3(NWAVES * 64), LDS_BYTES, stream, a);
    } else {
        for (int p = 0; p < N_PHASES; ++p) { a.ph_lo = p; a.ph_hi = p + 1; a.li = p; hipLaunchKernelGGL(skel_fwd, dim3(grid), dim3(NWAVES * 64), LDS_BYTES, stream, a); }
    }
}
```

```cpp
#include <hip/hip_runtime.h>
#include <cstdio>
#include <cstdint>
#include <cmath>
#define MK_N_LAUNCHES 1
namespace pg8 {
#define PG8_LAS __attribute__((address_space(3)))
typedef unsigned short bf16_t;
typedef short bf16x8 __attribute__((ext_vector_type(8)));
typedef float f32x4 __attribute__((ext_vector_type(4)));
typedef unsigned u32x4 __attribute__((ext_vector_type(4)));
constexpr int BM = 256, BK = 64, HALF = 128, HTB = HALF * BK * 2  , STAGE_BYTES = 8 * HTB, NXCD = 8, WGM = 8;

__host__ __device__ __forceinline__ int lds_byte(int r, int c) { const int st = (r >> 4) * 2 + (c >> 5), rr = r & 15, cc = c & 31, ob = rr * 64 + cc * 2; return st * 1024 + (ob ^ (((ob >> 9) & 1) << 5)); }
__host__ __device__ __forceinline__ void stage_rc(int b, int& R, int& C) { const int st = b / 1024, sb = b % 1024, swz = sb ^ (((sb >> 9) & 1) << 5); R = (st >> 1) * 16 + swz / 64; C = (st & 1) * 32 + (swz % 64) / 2; }
__host__ __device__ __forceinline__ int perm32(int rho) { const int n = rho >> 4, i = rho & 15; return 8 * (i >> 2) + 4 * n + (i & 3); }

struct Unit { int pm, pn, seg; };
struct Gemm { const bf16_t* A; const bf16_t* Bt; int M, N, K; const bf16_t* A2 = nullptr; const bf16_t* Bt2 = nullptr; };

struct StaticOrder {
    int nM, nN, nwg, G, c;
    __host__ __device__ __forceinline__ void init(int M, int N, int G_, int c_) { nM = M / BM; nN = N / BM; nwg = nM * nN; G = G_; c = c_; }
    __host__ __device__ __forceinline__ bool next(int i, Unit& u) const {
        const long L = (long)i * G + c; if (L >= nwg) return false;
        int wgid = (int)L; { const int q = nwg / NXCD, r = nwg % NXCD, xcd = wgid % NXCD, off = wgid / NXCD; wgid = (xcd < r ? xcd * (q + 1) : r * (q + 1) + (xcd - r) * q) + off; }
        const int nig = WGM * nN, gid = wgid / nig, fm = gid * WGM, gsz = (nM - fm) < WGM ? (nM - fm) : WGM;
        u.pm = fm + ((wgid % nig) % gsz); u.pn = (wgid % nig) / gsz; u.seg = 0; return true;
    }
    __device__ __forceinline__ void a_ready(const Unit&) const {}
    __device__ __forceinline__ void done(const Unit&) const {}
};
struct PairOrder {
    StaticOrder base;
    __host__ __device__ __forceinline__ void init(int M, int N, int G_, int c_) { base.init(M, N, G_, c_); }
    __host__ __device__ __forceinline__ bool next(int i, Unit& u) const { if (!base.next(i >> 1, u)) return false; u.seg = i & 1; return true; }
    __device__ __forceinline__ void a_ready(const Unit&) const {}
    __device__ __forceinline__ void done(const Unit&) const {}
};
typedef float f32x2 __attribute__((ext_vector_type(2)));
typedef __bf16 bf16x2_t __attribute__((ext_vector_type(2)));
__device__ __forceinline__ unsigned cvt_pk_bf16(float lo, float hi) { const f32x2 v = {lo, hi}; const bf16x2_t b = __builtin_convertvector(v, bf16x2_t); return __builtin_bit_cast(unsigned, b); }
__device__ __forceinline__ float fast_sigmoid(float x) { return __builtin_amdgcn_rcpf(1.0f + __builtin_amdgcn_exp2f(-1.4426950408889634f * x)); }
__device__ __forceinline__ float fast_gelu_tanh(float x) { const float u2 = 1.5957691216057308f * (x + 0.044715f * x * x * x); return x * fast_sigmoid(u2); }
__device__ __forceinline__ void store8_bf16(bf16_t* p, const f32x4& v0, const f32x4& v1) {
    u32x4 w; w.x = cvt_pk_bf16(v0[0], v0[1]); w.y = cvt_pk_bf16(v0[2], v0[3]); w.z = cvt_pk_bf16(v1[0], v1[1]); w.w = cvt_pk_bf16(v1[2], v1[3]); *(u32x4*)p = w;
}
__device__ __forceinline__ float bf_lo(unsigned w) { return __builtin_bit_cast(float, w << 16); }
__device__ __forceinline__ float bf_hi(unsigned w) { return __builtin_bit_cast(float, w & 0xffff0000u); }
__device__ __forceinline__ void rope4(f32x4& v0, f32x4& v1, const f32x4 c, const f32x4 s) {
    const float a0 = v0[0], b0 = v0[1], a1 = v0[2], b1 = v0[3], a2 = v1[0], b2 = v1[1], a3 = v1[2], b3 = v1[3];
    v0[0] = a0 * c[0] - b0 * s[0]; v0[1] = b0 * c[0] + a0 * s[0]; v0[2] = a1 * c[1] - b1 * s[1]; v0[3] = b1 * c[1] + a1 * s[1];
    v1[0] = a2 * c[2] - b2 * s[2]; v1[1] = b2 * c[2] + a2 * s[2]; v1[2] = a3 * c[3] - b3 * s[3]; v1[3] = b3 * c[3] + a3 * s[3];
}
struct EpiProj {
    static constexpr bool PERM = true, AFTER_DRAIN = false;
    bf16_t *U, *Vg, *QLAT, *Kb, *Vb, *GATE, *SMALL; float* stats; float* stats2; const float* cosA; const float* sinA;
    __device__ __forceinline__ void operator()(const f32x4 (&acc)[2][2][4][2], const Unit& u, int wr, int wc, int fr, int fq) const {
        const int pn = u.pn; int mode, ld, c0; bf16_t* dst;
        if (pn < 4) { mode = 1; dst = U; ld = 1024; c0 = pn * 256; }
        else if (pn < 8) { mode = 2; dst = Vg; ld = 1024; c0 = (pn - 4) * 256; }
        else if (pn < 10) { mode = 5; dst = QLAT; ld = 512; c0 = (pn - 8) * 256; }
        else if (pn < 14) { mode = 3; dst = Kb; ld = 1024; c0 = (pn - 10) * 256; }
        else if (pn < 18) { mode = 0; dst = Vb; ld = 1024; c0 = (pn - 14) * 256; }
        else if (pn < 34) { mode = 4; dst = GATE; ld = 4096; c0 = (pn - 18) * 256; }
        else { mode = 0; dst = SMALL; ld = 256; c0 = 0; }
        const int row0 = u.pm * BM + wr * 64 + fr, cl = wc * 32 + 8 * fq;
#pragma unroll
        for (int ai = 0; ai < 2; ++ai)
#pragma unroll
            for (int m = 0; m < 4; ++m) {
                const int row = row0 + ai * HALF + m * 16;
                f32x4 v[2][2];
#pragma unroll
                for (int bj = 0; bj < 2; ++bj) { v[bj][0] = acc[ai][bj][m][0]; v[bj][1] = acc[ai][bj][m][1]; }
                if (mode == 1 || mode == 2) {
#pragma unroll
                    for (int bj = 0; bj < 2; ++bj)
#pragma unroll
                        for (int n = 0; n < 2; ++n)
#pragma unroll
                            for (int e = 0; e < 4; ++e) v[bj][n][e] = fast_gelu_tanh(v[bj][n][e]);
                    if (mode == 2) {
                        float s = 0.f, q = 0.f;
#pragma unroll
                        for (int bj = 0; bj < 2; ++bj)
#pragma unroll
                            for (int n = 0; n < 2; ++n)
#pragma unroll
                                for (int e = 0; e < 4; ++e) { s += v[bj][n][e]; q += v[bj][n][e] * v[bj][n][e]; }
                        s += __shfl_xor(s, 16); s += __shfl_xor(s, 32); q += __shfl_xor(q, 16); q += __shfl_xor(q, 32);
                        if (fq == 0) { f32x2 o; o.x = s; o.y = q; *(f32x2*)(stats + ((size_t)row * 16 + (pn - 4) * 4 + wc) * 2) = o; }
                    }
                } else if (mode == 5) {
                    float q = 0.f;
#pragma unroll
                    for (int bj = 0; bj < 2; ++bj)
#pragma unroll
                        for (int n = 0; n < 2; ++n)
#pragma unroll
                            for (int e = 0; e < 4; ++e) q += v[bj][n][e] * v[bj][n][e];
                    q += __shfl_xor(q, 16); q += __shfl_xor(q, 32);
                    if (fq == 0) stats2[(size_t)row * 8 + (pn - 8) * 4 + wc] = q;
                } else if (mode == 3) {
                    const f32x4 c = *(const f32x4*)(cosA + (size_t)row * 64 + 16 * wc + 4 * fq), s = *(const f32x4*)(sinA + (size_t)row * 64 + 16 * wc + 4 * fq);
                    rope4(v[0][0], v[0][1], c, s); rope4(v[1][0], v[1][1], c, s);
                } else if (mode == 4) {
#pragma unroll
                    for (int bj = 0; bj < 2; ++bj)
#pragma unroll
                        for (int n = 0; n < 2; ++n)
#pragma unroll
                            for (int e = 0; e < 4; ++e) v[bj][n][e] = fast_sigmoid(v[bj][n][e]);
                }
                bf16_t* rowp = dst + (size_t)row * ld + c0 + cl;
                store8_bf16(rowp, v[0][0], v[0][1]); store8_bf16(rowp + HALF, v[1][0], v[1][1]);
            }
    }
};
struct EpiQ {
    static constexpr bool PERM = true, AFTER_DRAIN = false;
    bf16_t *Q, *QIDX; const PG8_LAS float* rt; const float *cosA, *sinA, *cosI, *sinI; float qscale;
    __device__ __forceinline__ void operator()(const f32x4 (&acc)[2][2][4][2], const Unit& u, int wr, int wc, int fr, int fq) const {
        const int pn = u.pn; const bool isq = pn < 4;
        bf16_t* dst = isq ? Q : QIDX; const int c0 = (isq ? pn : pn - 4) * 256 + wc * 32 + 8 * fq;
#pragma unroll
        for (int ai = 0; ai < 2; ++ai)
#pragma unroll
            for (int m = 0; m < 4; ++m) {
                const int lrow = ai * HALF + wr * 64 + m * 16 + fr, row = u.pm * BM + lrow;
                const float sc = rt[lrow] * (isq ? qscale : 1.0f);
                f32x4 v[2][2];
#pragma unroll
                for (int bj = 0; bj < 2; ++bj) { v[bj][0] = acc[ai][bj][m][0] * sc; v[bj][1] = acc[ai][bj][m][1] * sc; }
                if (isq) {
                    const f32x4 c = *(const f32x4*)(cosA + (size_t)row * 64 + 16 * wc + 4 * fq), s = *(const f32x4*)(sinA + (size_t)row * 64 + 16 * wc + 4 * fq);
                    rope4(v[0][0], v[0][1], c, s); rope4(v[1][0], v[1][1], c, s);
                } else if ((wc & 1) == 0) {
                    const f32x4 c = *(const f32x4*)(cosI + (size_t)row * 16 + 4 * fq), s = *(const f32x4*)(sinI + (size_t)row * 16 + 4 * fq);
                    rope4(v[0][0], v[0][1], c, s); rope4(v[1][0], v[1][1], c, s);
                }
                bf16_t* rowp = dst + (size_t)row * 1024 + c0;
                store8_bf16(rowp, v[0][0], v[0][1]); store8_bf16(rowp + HALF, v[1][0], v[1][1]);
            }
    }
};
struct EpiGate2 {
    static constexpr bool PERM = true, AFTER_DRAIN = false;
    const bf16_t* GATE; bf16_t* MERGED;
    __device__ __forceinline__ void operator()(f32x4 (&acc)[2][2][4][2], const Unit& u, int wr, int wc, int fr, int fq) const {
        const int row0 = u.pm * BM + wr * 64 + fr, col0 = u.pn * BM + wc * 32 + 8 * fq;
#pragma unroll
        for (int ai = 0; ai < 2; ++ai)
#pragma unroll
            for (int m = 0; m < 4; ++m) {
                const int row = row0 + ai * HALF + m * 16;
#pragma unroll
                for (int bj = 0; bj < 2; ++bj) {
                    const int col = col0 + bj * HALF;
                    const u32x4 gb = *(const u32x4*)(GATE + (size_t)row * 4096 + 2048 + col);
                    f32x4 b0 = {bf_lo(gb.x), bf_hi(gb.x), bf_lo(gb.y), bf_hi(gb.y)}, b1 = {bf_lo(gb.z), bf_hi(gb.z), bf_lo(gb.w), bf_hi(gb.w)};
                    if (u.seg == 0) {
                        const u32x4 ga = *(const u32x4*)(GATE + (size_t)row * 4096 + col);
                        const f32x4 a0 = {bf_lo(ga.x), bf_hi(ga.x), bf_lo(ga.y), bf_hi(ga.y)}, a1 = {bf_lo(ga.z), bf_hi(ga.z), bf_lo(ga.w), bf_hi(ga.w)};
#pragma unroll
                        for (int e = 0; e < 4; ++e) { acc[ai][bj][m][0][e] *= a0[e] * __builtin_amdgcn_rcpf(b0[e]); acc[ai][bj][m][1][e] *= a1[e] * __builtin_amdgcn_rcpf(b1[e]); }
                    } else {
                        store8_bf16(MERGED + (size_t)row * 2048 + col, acc[ai][bj][m][0] * b0, acc[ai][bj][m][1] * b1);
                    }
                }
            }
    }
};
struct EpiOutBf16 {
    static constexpr bool PERM = true, AFTER_DRAIN = false;
    bf16_t* O;
    __device__ __forceinline__ void operator()(const f32x4 (&acc)[2][2][4][2], const Unit& u, int wr, int wc, int fr, int fq) const {
        const int row0 = u.pm * BM + wr * 64 + fr, col0 = u.pn * BM + wc * 32 + 8 * fq;
#pragma unroll
        for (int ai = 0; ai < 2; ++ai)
#pragma unroll
            for (int m = 0; m < 4; ++m)
#pragma unroll
                for (int bj = 0; bj < 2; ++bj) store8_bf16(O + (size_t)(row0 + ai * HALF + m * 16) * 2048 + col0 + bj * HALF, acc[ai][bj][m][0], acc[ai][bj][m][1]);
    }
};
struct EpiSwiGLU {
    static constexpr bool PERM = true, AFTER_DRAIN = false;
    bf16_t* ACT; int ld;
    __device__ __forceinline__ void operator()(const f32x4 (&acc)[2][2][4][2], const Unit& u, int wr, int wc, int fr, int fq) const {
        const int row0 = u.pm * BM + wr * 64 + fr, col0 = u.pn * HALF + wc * 32 + 8 * fq;
#pragma unroll
        for (int ai = 0; ai < 2; ++ai)
#pragma unroll
            for (int m = 0; m < 4; ++m) {
                f32x4 o[2];
#pragma unroll
                for (int n = 0; n < 2; ++n)
#pragma unroll
                    for (int e = 0; e < 4; ++e) { const float g = acc[ai][0][m][n][e]; o[n][e] = g * fast_sigmoid(g) * acc[ai][1][m][n][e]; }
                store8_bf16(ACT + (size_t)(row0 + ai * HALF + m * 16) * ld + col0, o[0], o[1]);
            }
    }
};
template <class Epi, class Sched, bool ALIGN_EPI = false, bool SP2 = false>
__device__ __forceinline__ void gemm_phase(PG8_LAS unsigned char* lds, const Gemm g, const Sched& S, const Epi& E) {
    const int tid = threadIdx.x, wid = __builtin_amdgcn_readfirstlane(tid >> 6), lane = tid & 63, wr = wid >> 2, wc = wid & 3, fr = lane & 15, fq = lane >> 4;
    const int K = g.K, nt = K / BK;
    unsigned voffA[2], voffB[2];
#pragma unroll
    for (int i = 0; i < 2; ++i) { int R, C; stage_rc(tid * 16 + i * 8192, R, C); const int Rb = Epi::PERM ? ((R & ~31) + perm32(R & 31)) : R;
        voffA[i] = (unsigned)(R * K + C) * 2u; voffB[i] = (unsigned)(Rb * K + C) * 2u; }
    const size_t kstep = (size_t)(BK * 2);
    const size_t hstep = (size_t)HALF * K * 2;
    const size_t tstep = 2 * hstep;
    const unsigned ldsw = (unsigned)wid * 1024u;
    const int aoff = lds_byte(wr * 64 + fr, fq * 8), boff = lds_byte(wc * 32 + fr, fq * 8);
#define PG8_SA(b, h) (((b) * 2 + (h)) * HTB)
#define PG8_SB(b, h) ((4 + (b) * 2 + (h)) * HTB)
#define PG8_STAGE(bufoff, gbase, voff) do { _Pragma("unroll") for (int _i = 0; _i < 2; ++_i) \
        __builtin_amdgcn_global_load_lds((const unsigned*)((const char*)(gbase) + (voff)[_i]), (PG8_LAS unsigned*)(lds + (bufoff) + ldsw + _i * 8192), 16, 0, 0); } while (0)
#define PG8_LDA(dst, b, h) do { _Pragma("unroll") for (int m = 0; m < 4; ++m) _Pragma("unroll") for (int k = 0; k < 2; ++k) dst[m][k] = *(const PG8_LAS bf16x8*)(lds + PG8_SA(b, h) + aoff + m * 2048 + k * 1024); } while (0)
#define PG8_LDB(dst, b, h) do { _Pragma("unroll") for (int n = 0; n < 2; ++n) _Pragma("unroll") for (int k = 0; k < 2; ++k) dst[n][k] = *(const PG8_LAS bf16x8*)(lds + PG8_SB(b, h) + boff + n * 2048 + k * 1024); } while (0)
#define PG8_MMA(ai, bj, At, Bt) do { __builtin_amdgcn_s_setprio(1); _Pragma("unroll") for (int m = 0; m < 4; ++m) _Pragma("unroll") for (int n = 0; n < 2; ++n) _Pragma("unroll") for (int k = 0; k < 2; ++k) \
        acc[ai][bj][m][n] = __builtin_amdgcn_mfma_f32_16x16x32_bf16(Bt[n][k], At[m][k], acc[ai][bj][m][n], 0, 0, 0); __builtin_amdgcn_s_setprio(0); } while (0)
#define PG8_WAIT_V(n) asm volatile("s_waitcnt vmcnt(" #n ")" ::: "memory")
#define PG8_WAIT_L(n) asm volatile("s_waitcnt lgkmcnt(" #n ")" ::: "memory")
#define PG8_BAR __builtin_amdgcn_s_barrier()
#define PG8_SCHED __builtin_amdgcn_sched_barrier(0)
    Unit cur, nxt; int ui = 0;
    if (!S.next(0, cur)) return;
    f32x4 acc[2][2][4][2];
#pragma unroll
    for (int a = 0; a < 2; ++a)
#pragma unroll
        for (int b = 0; b < 2; ++b)
#pragma unroll
            for (int m = 0; m < 4; ++m)
#pragma unroll
                for (int n = 0; n < 2; ++n) acc[a][b][m][n] = (f32x4){0.f, 0.f, 0.f, 0.f};
    bf16x8 At[4][2], B0[2][2], B1[2][2];
    const char* cA = (const char*)(cur.seg ? g.A2 : g.A) + (size_t)cur.pm * tstep; const char* cB = (const char*)(cur.seg ? g.Bt2 : g.Bt) + (size_t)cur.pn * tstep;
    S.a_ready(cur);
    if constexpr (SP2) {
        PG8_STAGE(PG8_SB(0, 0), cB, voffB); PG8_STAGE(PG8_SB(0, 1), cB + hstep, voffB); PG8_STAGE(PG8_SA(0, 0), cA, voffA); PG8_STAGE(PG8_SA(0, 1), cA + hstep, voffA);
        if (wr == 1) PG8_BAR;
        PG8_WAIT_V(2); PG8_BAR;
        PG8_STAGE(PG8_SB(1, 0), cB + kstep, voffB); PG8_STAGE(PG8_SA(1, 0), cA + kstep, voffA); PG8_STAGE(PG8_SB(1, 1), cB + hstep + kstep, voffB);
        PG8_WAIT_V(6); PG8_BAR;
    } else {
        PG8_STAGE(PG8_SB(0, 0), cB, voffB); PG8_STAGE(PG8_SA(0, 0), cA, voffA); PG8_STAGE(PG8_SB(0, 1), cB + hstep, voffB); PG8_STAGE(PG8_SA(0, 1), cA + hstep, voffA);
        if (wr == 1) PG8_BAR;
        PG8_WAIT_V(4); PG8_BAR;
        PG8_STAGE(PG8_SB(1, 0), cB + kstep, voffB); PG8_STAGE(PG8_SA(1, 0), cA + kstep, voffA); PG8_STAGE(PG8_SB(1, 1), cB + hstep + kstep, voffB);
        PG8_WAIT_V(6); PG8_BAR;
    }
    for (;;) {
        const bool has_next = S.next(ui + 1, nxt);
        const char* nA = has_next ? (const char*)(nxt.seg ? g.A2 : g.A) + (size_t)nxt.pm * tstep : cA; const char* nB = has_next ? (const char*)(nxt.seg ? g.Bt2 : g.Bt) + (size_t)nxt.pn * tstep : cB;
        for (int t = 0; t < nt; t += 2) {
            const bool last = (t == nt - 2);
            const char* a1 = cA + (size_t)(t + 1) * kstep;
            const char* a2 = last ? nA : cA + (size_t)(t + 2) * kstep; const char* b2 = last ? nB : cB + (size_t)(t + 2) * kstep;
            const char* a3 = a2 + kstep; const char* b3 = b2 + kstep;
            if (last && has_next) S.a_ready(nxt);
            if constexpr (SP2) {
            PG8_LDB(B0, 0, 0); PG8_LDB(B1, 0, 1); PG8_SCHED; PG8_LDA(At, 0, 0); PG8_STAGE(PG8_SA(1, 1), a1 + hstep, voffA);
            PG8_WAIT_V(8); PG8_WAIT_L(0); PG8_BAR; PG8_MMA(0, 0, At, B0); PG8_MMA(0, 1, At, B1); PG8_BAR; PG8_SCHED;
            PG8_LDA(At, 0, 1); PG8_STAGE(PG8_SB(0, 0), b2, voffB); PG8_STAGE(PG8_SB(0, 1), b2 + hstep, voffB); PG8_STAGE(PG8_SA(0, 0), a2, voffA);
            PG8_WAIT_V(8); PG8_WAIT_L(0); PG8_BAR; PG8_MMA(1, 0, At, B0); PG8_MMA(1, 1, At, B1); PG8_BAR; PG8_SCHED;
            PG8_LDB(B0, 1, 0); PG8_LDB(B1, 1, 1); PG8_SCHED; PG8_LDA(At, 1, 0); PG8_STAGE(PG8_SA(0, 1), a2 + hstep, voffA);
            PG8_WAIT_V(8); PG8_WAIT_L(0); PG8_BAR; PG8_MMA(0, 0, At, B0); PG8_MMA(0, 1, At, B1); PG8_BAR; PG8_SCHED;
            PG8_LDA(At, 1, 1); PG8_STAGE(PG8_SB(1, 0), b3, voffB); PG8_STAGE(PG8_SB(1, 1), b3 + hstep, voffB); PG8_STAGE(PG8_SA(1, 0), a3, voffA);
            PG8_WAIT_V(8); PG8_WAIT_L(0); PG8_BAR; PG8_MMA(1, 0, At, B0); PG8_MMA(1, 1, At, B1); PG8_BAR; PG8_SCHED;
            } else {
            PG8_LDB(B0, 0, 0); PG8_SCHED; PG8_LDA(At, 0, 0); PG8_STAGE(PG8_SA(1, 1), a1 + hstep, voffA);
            PG8_WAIT_L(8); PG8_BAR; PG8_WAIT_L(0); PG8_MMA(0, 0, At, B0); PG8_BAR; PG8_SCHED;
            PG8_LDB(B1, 0, 1); PG8_STAGE(PG8_SB(0, 0), b2, voffB);
            PG8_BAR; PG8_WAIT_L(0); PG8_MMA(0, 1, At, B1); PG8_BAR;
            PG8_LDA(At, 0, 1); PG8_STAGE(PG8_SA(0, 0), a2, voffA);
            PG8_BAR; PG8_WAIT_L(0); PG8_MMA(1, 0, At, B0); PG8_BAR; PG8_SCHED;
            PG8_STAGE(PG8_SB(0, 1), b2 + hstep, voffB);
            PG8_WAIT_V(6); PG8_BAR; PG8_MMA(1, 1, At, B1); PG8_BAR;
            PG8_LDB(B0, 1, 0); PG8_SCHED; PG8_LDA(At, 1, 0); PG8_STAGE(PG8_SA(0, 1), a2 + hstep, voffA);
            PG8_WAIT_L(8); PG8_BAR; PG8_WAIT_L(0); PG8_MMA(0, 0, At, B0); PG8_BAR; PG8_SCHED;
            PG8_LDB(B1, 1, 1); PG8_STAGE(PG8_SB(1, 0), b3, voffB);
            PG8_BAR; PG8_WAIT_L(0); PG8_MMA(0, 1, At, B1); PG8_BAR;
            PG8_LDA(At, 1, 1); PG8_STAGE(PG8_SA(1, 0), a3, voffA);
            PG8_BAR; PG8_WAIT_L(0); PG8_MMA(1, 0, At, B0); PG8_BAR; PG8_SCHED;
            PG8_STAGE(PG8_SB(1, 1), b3 + hstep, voffB);
            PG8_WAIT_V(6); PG8_BAR; PG8_MMA(1, 1, At, B1); PG8_BAR;
            }
        }
        if constexpr (ALIGN_EPI) { if (wr == 0) PG8_BAR; }
        if constexpr (!Epi::AFTER_DRAIN) { E(acc, cur, wr, wc, fr, fq); S.done(cur); }
        if (!has_next) break;
        if (nxt.seg == 0)
#pragma unroll
        for (int a = 0; a < 2; ++a)
#pragma unroll
            for (int b = 0; b < 2; ++b)
#pragma unroll
                for (int m = 0; m < 4; ++m)
#pragma unroll
                    for (int n = 0; n < 2; ++n) acc[a][b][m][n] = (f32x4){0.f, 0.f, 0.f, 0.f};
        cur = nxt; cA = nA; cB = nB; ++ui;
        if constexpr (ALIGN_EPI) { if (wr == 1) PG8_BAR; }
    }
    PG8_WAIT_V(0);
    if constexpr (!ALIGN_EPI) { if (wr == 0) PG8_BAR; }
    PG8_BAR;
    if constexpr (Epi::AFTER_DRAIN) { E.fused(acc, cur, wr, wc, fr, fq, lds, wid, lane); S.done(cur); }
#undef PG8_SA
#undef PG8_SB
#undef PG8_STAGE
#undef PG8_LDA
#undef PG8_LDB
#undef PG8_MMA
#undef PG8_WAIT_V
#undef PG8_WAIT_L
#undef PG8_BAR
#undef PG8_SCHED
}
}
#define GAS __attribute__((address_space(1)))
#define LAS __attribute__((address_space(3)))
typedef unsigned short bf16;
typedef unsigned v4u __attribute__((ext_vector_type(4)));
typedef float f32x4 __attribute__((ext_vector_type(4)));
typedef short bf16x8 __attribute__((ext_vector_type(8)));
typedef GAS unsigned gu32;
typedef GAS unsigned long long gu64;
#define RLX_AGENT __ATOMIC_RELAXED, __HIP_MEMORY_SCOPE_AGENT
#define LDS_WAIT() asm volatile("s_waitcnt lgkmcnt(0)" ::: "memory")
#define VM_WAIT() asm volatile("s_waitcnt vmcnt(0)" ::: "memory")
__device__ __forceinline__ unsigned long long rt() { return __builtin_amdgcn_s_memrealtime(); }
__device__ __forceinline__ unsigned f2bf(float f) { unsigned u = __builtin_bit_cast(unsigned, f); return (u + 0x7fffu + ((u >> 16) & 1u)) >> 16; }
__device__ __forceinline__ unsigned pk2(float lo, float hi) { return f2bf(lo) | (f2bf(hi) << 16); }
#define XB_TMO      128
#define XB_XCNT(j)  (256  + 64 * (j))
#define XB_XSUB(j)  (1280 + 64 * (j))
#define XB_XGEN(j)  (2304 + 64 * (j))
#define XB_TOP      3328
#define XB_TOPGEN   3392
#define XCD_BAR_WORDS 3456
#define XB_SPIN_CAP (1u << 18)

__device__ __forceinline__ unsigned xb_ld(unsigned* p)              { return __hip_atomic_load(p, __ATOMIC_RELAXED, __HIP_MEMORY_SCOPE_AGENT); }
__device__ __forceinline__ unsigned xb_add(unsigned* p, unsigned v) { return __hip_atomic_fetch_add(p, v, __ATOMIC_RELAXED, __HIP_MEMORY_SCOPE_AGENT); }
__device__ __forceinline__ unsigned xb_xcc_id() { return (unsigned)__builtin_amdgcn_s_getreg((3 << 11) | 20) & 0xFu; }
#define XB_SPIN(cond, bar) do { unsigned _sp = 0; while (cond) { __builtin_amdgcn_s_sleep(1); \
    if ((++_sp & 255u) == 0u) { if (xb_ld(&(bar)[XB_TMO])) break; if (_sp > XB_SPIN_CAP) { atomicAdd(&(bar)[XB_TMO], 1u); break; } } } } while (0)

struct XcdBarrier {
    unsigned* bar; unsigned x;
    volatile LAS unsigned* st;
};

__device__ __forceinline__ XcdBarrier xcd_barrier_post(unsigned* bar, volatile LAS unsigned* st) {
    XcdBarrier b; b.bar = bar; b.x = xb_xcc_id(); b.st = st;
    if (threadIdx.x == 0) (void)xb_add(&bar[XB_XCNT(b.x)], 1u);
    return b;
}
__device__ __forceinline__ void xcd_barrier_complete(unsigned* bar, unsigned x, unsigned& nloc, unsigned& nx) {
    const unsigned G = gridDim.x * gridDim.y * gridDim.z;
    unsigned sum, cnt, mine, sp = 0u;
    for (;;) {
        sum = 0u; cnt = 0u; mine = 0u;
#pragma unroll
        for (unsigned j = 0; j < 16; ++j) { const unsigned c = xb_ld(&bar[XB_XCNT(j)]); sum += c; cnt += (c > 0u) ? 1u : 0u; mine = (j == x) ? c : mine; }
        if (sum == G) break;
        __builtin_amdgcn_s_sleep(1);
        if ((++sp & 255u) == 0u) { if (xb_ld(&bar[XB_TMO])) break; if (sp > XB_SPIN_CAP) { atomicAdd(&bar[XB_TMO], 1u); break; } }
    }
    nloc = mine > 0u ? mine : 1u; nx = cnt > 0u ? cnt : 1u;
}

__device__ __forceinline__ void xcd_barrier(const XcdBarrier& b) {
    asm volatile("s_waitcnt vmcnt(0)" ::: "memory");
    __syncthreads();
    if (threadIdx.x == 0) {
        unsigned* bar = b.bar;
        __builtin_amdgcn_s_waitcnt(0);
        unsigned nloc = b.st[0], nx = b.st[1];
        if (nloc == 0u) { xcd_barrier_complete(bar, b.x, nloc, nx); b.st[0] = nloc; b.st[1] = nx; }
        const unsigned old = xb_add(&bar[XB_XSUB(b.x)], 1u);
        const unsigned gen = old / nloc;
        if (old + 1u == (gen + 1u) * nloc) {
            __builtin_amdgcn_fence(__ATOMIC_RELEASE, "agent");
            asm volatile("s_waitcnt vmcnt(0)" ::: "memory");
            const unsigned og = xb_add(&bar[XB_TOP], 1u);
            const unsigned tg = og / nx;
            if (og + 1u == (tg + 1u) * nx) xb_add(&bar[XB_TOPGEN], 1u);
            else XB_SPIN(xb_ld(&bar[XB_TOPGEN]) == tg, bar);
            __builtin_amdgcn_fence(__ATOMIC_ACQUIRE, "agent");
            xb_add(&bar[XB_XGEN(b.x)], 1u);
            asm volatile("s_waitcnt vmcnt(0)" ::: "memory");
        } else {
            XB_SPIN(xb_ld(&bar[XB_XGEN(b.x)]) == gen, bar);
            __builtin_amdgcn_fence(__ATOMIC_ACQUIRE, "agent");
            asm volatile("s_waitcnt vmcnt(0)" ::: "memory");
        }
    }
    __syncthreads();
}
constexpr int NWAVES = 8;
#ifndef MK_N_LAUNCHES
#define MK_N_LAUNCHES 1
#endif
constexpr int N_PHASES = 13;
constexpr int N_LAUNCHES = MK_N_LAUNCHES;

constexpr int S = 8192, D = 2048, GW = 1024, QL = 512, AW = 1024, FF = 5632;
constexpr int NPROJ = 8960;
constexpr int SRC_INC = 8784;
constexpr float NORM_EPS = 1e-6f;
constexpr float QSCALE = 0.08838834764831845f * 1.4426950408889634f;

constexpr size_t MiB = 1u << 20;
constexpr size_t WS_CTL = 0, CTL_ZERO_BYTES = 128 * 1024;
constexpr size_t WS_WSUM = 1 * MiB + 64 * 1024;
constexpr size_t WS_MOD = 1 * MiB, WS_COSA = 2 * MiB, WS_SINA = 4 * MiB, WS_COSI = 6 * MiB, WS_SINI = 6 * MiB + 512 * 1024, WS_STATS = 7 * MiB, WS_IDXW = 8 * MiB, WS_KIDX = 8 * MiB + 512 * 1024, WS_WM = 9 * MiB + 512 * 1024, WS_STATS2 = 9 * MiB + 768 * 1024;
constexpr size_t WS_WIN = 10 * MiB, WS_WQQ = 45 * MiB, WS_WPA = 47 * MiB, WS_WPB = 51 * MiB, WS_WOUT = 55 * MiB, WS_WGU = 63 * MiB, WS_WDOWN = 107 * MiB;
constexpr size_t WS_H = 129 * MiB;
constexpr size_t WS_U = 161 * MiB, WS_VG = 177 * MiB, WS_QLAT = 193 * MiB, WS_K = 201 * MiB, WS_V = 217 * MiB, WS_GATE = 233 * MiB, WS_SMALL = 297 * MiB;
constexpr size_t WS_ACT = 161 * MiB;
constexpr size_t WS_Q = 301 * MiB, WS_QIDX = 317 * MiB, WS_YB = 341 * MiB;
constexpr size_t WS_MASKB0 = WS_H, WS_MASKB1 = WS_WIN + 2 * MiB;
constexpr size_t WS_X1 = 249 * MiB;
constexpr size_t WS_F2 = 333 * MiB;
constexpr size_t WS_F = 301 * MiB;
constexpr size_t WS_END = 365 * MiB;
static_assert(WS_WIN + (size_t)NPROJ * D * 2 <= WS_WQQ && WS_WGU + (size_t)2 * FF * D * 2 <= WS_WDOWN && WS_WDOWN + (size_t)D * FF * 2 <= WS_H && WS_ACT + (size_t)S * FF * 2 <= WS_Q, "d_ws map");
constexpr int CW_TMO = 0, CW_CODE = 1, CW_BAR = 4096, CW_ATT = 16384;
static_assert((size_t)(CW_ATT + 256 * 64) * 4 <= CTL_ZERO_BYTES, "every polled word inside the memset region");

constexpr int RING_OFF = 0, RING_BYTES = 131072;
constexpr int LDSCTL_OFF = RING_BYTES, MISC_OFF = LDSCTL_OFF + 320;
constexpr int AUX_OFF = RING_BYTES + 1024;
constexpr int LDS_BYTES = 163840;
struct Frame {
    LAS unsigned char* lds;
    volatile LAS unsigned* MISC;
    gu32* ctl;
    int tid, lane, wave;
    int vcu, G;
    const float* in[24];
    float* out; unsigned char* ws;
};
__device__ __forceinline__ float wave_sum(float v) {
#pragma unroll
    for (int o = 1; o < 64; o <<= 1) v += __shfl_xor(v, o);
    return v;
}
__device__ __forceinline__ float wave_max(float v) {
#pragma unroll
    for (int o = 1; o < 64; o <<= 1) v = fmaxf(v, __shfl_xor(v, o));
    return v;
}
__device__ __forceinline__ float bf2f(bf16 b) { return __builtin_bit_cast(float, (unsigned)b << 16); }
__device__ __forceinline__ float bflo(unsigned w) { return __builtin_bit_cast(float, w << 16); }
__device__ __forceinline__ float bfhi(unsigned w) { return __builtin_bit_cast(float, w & 0xffff0000u); }

enum { MAT_WIN = 0, MAT_WQ, MAT_WQI, MAT_WPA, MAT_WPB, MAT_WOUT, MAT_WGATE, MAT_WUP, MAT_WDOWN };
__device__ __forceinline__ int dst_of(int mat, int c) {
    switch (mat) {
    case MAT_WIN:
        if (c < 2560) return c;
        if (c < 3584) { const int h = (c - 2560) >> 7, d = (c - 2560) & 127; return 2560 + h * 128 + (d < 64 ? 2 * d : 2 * (d - 64) + 1); }
        if (c < 4608) return c;
        if (c < 4688) return 8704 + (c - 4608);
        return c - 4688 + 4608;
    case MAT_WQ: { const int h = c >> 7, d = c & 127; return h * 128 + (d < 64 ? 2 * d : 2 * (d - 64) + 1); }
    case MAT_WQI: { const int h = c >> 6, d = c & 63; return 1024 + h * 64 + (d < 32 ? (d < 16 ? 2 * d : 2 * (d - 16) + 1) : d); }
    case MAT_WGATE: return (c >> 7) * 256 + (c & 127);
    case MAT_WUP: return (c >> 7) * 256 + 128 + (c & 127);
    default: return c;
    }
}
__device__ __forceinline__ void p0_transpose_item(int mat, const float* __restrict__ W, int K, int N, bf16* WT, const float* ksc, LAS unsigned char* scr, int item, int lane) {
    const int nblk = (N + 63) / 64, kb = item / nblk, nb = item % nblk, k0 = 64 * kb, c0 = 64 * nb;
    const int kq = lane >> 4, nq = lane & 15;
    const bool colok = (c0 + 4 * nq) < N;
    f32x4 v[16];
#pragma unroll
    for (int i = 0; i < 16; ++i) { const int k = k0 + 16 * (i >> 2) + 4 * kq + (i & 3); v[i] = colok ? *(const f32x4*)(W + (size_t)k * N + c0 + 4 * nq) : (f32x4){0.f, 0.f, 0.f, 0.f}; }
    if (ksc) {
#pragma unroll
        for (int i = 0; i < 16; ++i) v[i] = v[i] * ksc[k0 + 16 * (i >> 2) + 4 * kq + (i & 3)];
    }
#pragma unroll
    for (int j = 0; j < 4; ++j)
#pragma unroll
        for (int e = 0; e < 4; ++e) {
            const unsigned lo = pk2(v[4 * j][e], v[4 * j + 1][e]), hi = pk2(v[4 * j + 2][e], v[4 * j + 3][e]);
            *(LAS unsigned long long*)(scr + (4 * nq + e) * 144 + (16 * j + 4 * kq) * 2) = (unsigned long long)lo | ((unsigned long long)hi << 32);
        }
    LDS_WAIT(); asm volatile("" ::: "memory");
#pragma unroll
    for (int j = 0; j < 8; ++j) {
        const int ch = lane + 64 * j, cl = ch >> 3, k8 = ch & 7;
        const v4u o = *(const LAS v4u*)(scr + cl * 144 + k8 * 16);
        if (c0 + cl < N) *(GAS v4u*)(WT + (size_t)dst_of(mat, c0 + cl) * K + k0 + 8 * k8) = o;
    }
    LDS_WAIT(); asm volatile("" ::: "memory");
}
__device__ __forceinline__ void p0_prologue(const Frame& F) {
    unsigned char* ws = F.ws;
    LAS unsigned char* scr = F.lds + RING_OFF + F.wave * 16384;
    const int gw = F.vcu * NWAVES + F.wave, NGW = F.G * NWAVES;
    constexpr int I_WIN = (D / 64) * ((SRC_INC + 63) / 64), I_WQ = (QL / 64) * (1024 / 64);
    constexpr int NITEMS = I_WIN + 2 * I_WQ;
    for (int it = gw; it < NITEMS; it += NGW) {
        int r = it;
        if (r < I_WIN) { p0_transpose_item(MAT_WIN, F.in[6], D, SRC_INC, (bf16*)(ws + WS_WIN), nullptr, scr, r, F.lane); continue; } r -= I_WIN;
        if (r < I_WQ) { p0_transpose_item(MAT_WQ, F.in[12], QL, 1024, (bf16*)(ws + WS_WQQ), F.in[11], scr, r, F.lane); continue; } r -= I_WQ;
        p0_transpose_item(MAT_WQI, F.in[13], QL, 1024, (bf16*)(ws + WS_WQQ), F.in[11], scr, r, F.lane);
    }
    {
        v4u* z = (v4u*)(ws + WS_WIN + (size_t)8784 * D * 2);
        for (int i = F.vcu * 512 + F.tid; i < (NPROJ - 8784) * D * 2 / 16; i += F.G * 512) z[i] = (v4u){0u, 0u, 0u, 0u};
    }
    {
        const float* wsrc = F.in[9]; bf16* wm = (bf16*)(ws + WS_WM);
        for (int i = (F.vcu * 512 + F.tid); i < 8 * 128 * 128; i += F.G * 512) { const int t = (i >> 7) & 127, s = i & 127; wm[i] = (bf16)f2bf(s <= t ? wsrc[i] : 0.f); }
        float* wsum = (float*)(ws + WS_WSUM);
        for (int row = gw; row < 8 * 128; row += NGW) { const int t = row & 127; const int s0 = 2 * F.lane;
            const float a = s0 <= t ? bf2f((bf16)f2bf(wsrc[row * 128 + s0])) : 0.f, b = s0 + 1 <= t ? bf2f((bf16)f2bf(wsrc[row * 128 + s0 + 1])) : 0.f;
            const float r = wave_sum(a + b); if (F.lane == 0) wsum[row] = r; }
    }
    {
        float* cosA = (float*)(ws + WS_COSA); float* sinA = (float*)(ws + WS_SINA); float* cosI = (float*)(ws + WS_COSI); float* sinI = (float*)(ws + WS_SINI);
        for (int i = F.vcu * 512 + F.tid; i < S * 64; i += F.G * 512) {
            const int t = i >> 6, k = i & 63;
            const float inv = 1.0f / powf(10000.0f, (float)(2 * k) / 128.0f); const float ang = (float)t * inv;
            { const double a = (double)ang, rr = a - 6.283185307179586476925 * rint(a * 0.15915494309189533577); float sn, cs; sincosf((float)rr, &sn, &cs); cosA[i] = cs; sinA[i] = sn; }
            if (k < 16) { const float inv2 = 1.0f / powf(10000.0f, (float)(2 * k) / 32.0f); const float ang2 = (float)t * inv2;
                const double a = (double)ang2, rr = a - 6.283185307179586476925 * rint(a * 0.15915494309189533577); float sn, cs; sincosf((float)rr, &sn, &cs); cosI[t * 16 + k] = cs; sinI[t * 16 + k] = sn; }
        }
    }
    {
        __syncthreads();
        LAS f32x4* red = (LAS f32x4*)(F.lds + RING_OFF);
        const float* cv = F.in[1]; const float* wmod = F.in[2]; const float* bmod = F.in[3]; float* mod = (float*)(ws + WS_MOD);
        for (int cb = F.vcu; cb < 256; cb += F.G) {
            const int kg = F.tid / 12, c4 = F.tid % 12;
            if (kg < 42) {
                f32x4 acc = {0.f, 0.f, 0.f, 0.f};
#pragma unroll 8
                for (int k = kg; k < D; k += 42) acc += *(const f32x4*)(wmod + (size_t)k * (6 * D) + cb * 48 + 4 * c4) * cv[k];
                red[kg * 12 + c4] = acc;
            }
            __syncthreads();
            if (F.tid < 48) { float a = bmod[cb * 48 + F.tid]; const LAS float* rf = (const LAS float*)red; for (int g = 0; g < 42; ++g) a += rf[g * 48 + F.tid]; mod[cb * 48 + F.tid] = a; }
            __syncthreads();
        }
    }
}
__device__ __forceinline__ void p_late_convert(const Frame& F, int part, int widx, int nwg) {
    unsigned char* ws = F.ws;
    LAS unsigned char* scr = F.lds + RING_OFF + F.wave * 16384;
    constexpr int I_WPA = (GW / 64) * (D / 64), I_WOUT = (D / 64) * (D / 64), I_WG = (D / 64) * (FF / 64), I_WDOWN = (FF / 64) * (D / 64);
    const int n = part == 0 ? 2 * I_WPA + I_WOUT + 2 * I_WG : I_WDOWN;
    for (int it = widx * NWAVES + F.wave; it < n; it += nwg * NWAVES) {
        if (part == 1) { p0_transpose_item(MAT_WDOWN, F.in[23], FF, D, (bf16*)(ws + WS_WDOWN), nullptr, scr, it, F.lane); continue; }
        int r = it;
        if (r < I_WPA) { p0_transpose_item(MAT_WPA, F.in[16], GW, D, (bf16*)(ws + WS_WPA), nullptr, scr, r, F.lane); continue; } r -= I_WPA;
        if (r < I_WPA) { p0_transpose_item(MAT_WPB, F.in[17], AW, D, (bf16*)(ws + WS_WPB), nullptr, scr, r, F.lane); continue; } r -= I_WPA;
        if (r < I_WOUT) { p0_transpose_item(MAT_WOUT, F.in[18], D, D, (bf16*)(ws + WS_WOUT), nullptr, scr, r, F.lane); continue; } r -= I_WOUT;
        if (r < I_WG) { p0_transpose_item(MAT_WGATE, F.in[21], D, FF, (bf16*)(ws + WS_WGU), nullptr, scr, r, F.lane); continue; } r -= I_WG;
        p0_transpose_item(MAT_WUP, F.in[22], D, FF, (bf16*)(ws + WS_WGU), nullptr, scr, r, F.lane);
    }
}
__device__ __forceinline__ void p1_prenorm(const Frame& F) {
    const int gw = F.vcu * NWAVES + F.wave, NGW = F.G * NWAVES;
    const float* x = F.in[0]; const float* g = F.in[4]; const float* mod = (const float*)(F.ws + WS_MOD); bf16* H = (bf16*)(F.ws + WS_H);
    for (int m = gw; m < S; m += NGW) {
        const f32x4* xr = (const f32x4*)(x + (size_t)m * D) + F.lane;
        f32x4 v[8]; float ss = 0.f;
#pragma unroll
        for (int j = 0; j < 8; ++j) { v[j] = xr[64 * j]; ss += (v[j].x * v[j].x + v[j].y * v[j].y) + (v[j].z * v[j].z + v[j].w * v[j].w); }
        const float r = rsqrtf(wave_sum(ss) * (1.f / D) + NORM_EPS);
        unsigned long long* o8 = (unsigned long long*)(H + (size_t)m * D) + F.lane;
#pragma unroll
        for (int j = 0; j < 8; ++j) {
            const int n = 4 * F.lane + 256 * j;
            const f32x4 gg = *(const f32x4*)(g + n), sh = *(const f32x4*)(mod + n), sc = *(const f32x4*)(mod + D + n);
            const f32x4 o = v[j] * r * gg * (sc + 1.0f) + sh;
            o8[64 * j] = (unsigned long long)pk2(o.x, o.y) | ((unsigned long long)pk2(o.z, o.w) << 32);
        }
    }
}
struct SpatialW { bf16x8 bw[8][4]; };
__device__ __forceinline__ void p3_spatial_load(const Frame& F, int g, SpatialW& W) {
    const bf16* WM = (const bf16*)(F.ws + WS_WM) + (size_t)g * 128 * 128; const int fr = F.lane & 15, fq = F.lane >> 4;
#pragma unroll
    for (int ks = 0; ks < 4; ++ks)
#pragma unroll
        for (int nt = 0; nt < 8; ++nt) if (nt >= 2 * ks) W.bw[nt][ks] = *(const bf16x8*)(WM + (size_t)(16 * nt + fr) * 128 + 32 * ks + 8 * fq);
}
__device__ __forceinline__ void p3_spatial_item(const Frame& F, int c, int g, const SpatialW& W) {
    constexpr int VP = 136;
    LAS bf16* VT = (LAS bf16*)(F.lds + RING_OFF);
    const bf16* Vg = (const bf16*)(F.ws + WS_VG); bf16* U = (bf16*)(F.ws + WS_U);
    const float* stats = (const float*)(F.ws + WS_STATS); const float* gam = F.in[7] + g * 128; const float* bet = F.in[8] + g * 128; const float* bs = F.in[10] + g * 128;
    const float* wsum = (const float*)(F.ws + WS_WSUM) + g * 128;
    const int w = F.wave, fr = F.lane & 15, fq = F.lane >> 4;
    {
        const int s = F.tid >> 2, dq = F.tid & 3, row = c * 128 + s;
        const f32x4 p0 = *(const f32x4*)(stats + ((size_t)row * 16 + 4 * dq) * 2), p1 = *(const f32x4*)(stats + ((size_t)row * 16 + 4 * dq + 2) * 2);
        float sm = (p0.x + p0.z) + (p1.x + p1.z), sq = (p0.y + p0.w) + (p1.y + p1.w);
        sm += __shfl_xor(sm, 1); sq += __shfl_xor(sq, 1); sm += __shfl_xor(sm, 2); sq += __shfl_xor(sq, 2);
        const float mu = sm * (1.f / GW), var = sq * (1.f / GW) - mu * mu, r = rsqrtf(fmaxf(var, 0.f) + NORM_EPS);
        const v4u* vp = (const v4u*)(Vg + (size_t)row * GW + g * 128 + dq * 32);
#pragma unroll
        for (int i = 0; i < 4; ++i) {
            const v4u w = vp[i];
            const unsigned ww[4] = {w.x, w.y, w.z, w.w};
#pragma unroll
            for (int e = 0; e < 4; ++e) {
                const int d = dq * 32 + i * 8 + e * 2;
                VT[d * VP + s] = (bf16)f2bf((bflo(ww[e]) - mu) * r); VT[(d + 1) * VP + s] = (bf16)f2bf((bfhi(ww[e]) - mu) * r);
            }
        }
    }
    __syncthreads();
    {
        f32x4 acc[8];
#pragma unroll
        for (int nt = 0; nt < 8; ++nt) acc[nt] = (f32x4){0.f, 0.f, 0.f, 0.f};
#pragma unroll
        for (int ks = 0; ks < 4; ++ks) {
            const bf16x8 a = *(const LAS bf16x8*)(VT + (16 * w + fr) * VP + 32 * ks + 8 * fq);
#pragma unroll
            for (int nt = 0; nt < 8; ++nt) if (nt >= 2 * ks) acc[nt] = __builtin_amdgcn_mfma_f32_16x16x32_bf16(a, W.bw[nt][ks], acc[nt], 0, 0, 0);
        }
        const f32x4 g4 = *(const f32x4*)(gam + 16 * w + 4 * fq), b4 = *(const f32x4*)(bet + 16 * w + 4 * fq);
#pragma unroll
        for (int nt = 0; nt < 8; ++nt) {
            const int t = 16 * nt + fr; const float bb = bs[t], wsm = wsum[t];
            unsigned long long* up = (unsigned long long*)(U + (size_t)(c * 128 + t) * GW + g * 128 + 16 * w + 4 * fq);
            const unsigned long long uu = *up; const unsigned lo = (unsigned)uu, hi = (unsigned)(uu >> 32);
            const float o0 = bflo(lo) * (acc[nt][0] * g4.x + (b4.x * wsm + bb)), o1 = bfhi(lo) * (acc[nt][1] * g4.y + (b4.y * wsm + bb));
            const float o2 = bflo(hi) * (acc[nt][2] * g4.z + (b4.z * wsm + bb)), o3 = bfhi(hi) * (acc[nt][3] * g4.w + (b4.w * wsm + bb));
            *up = (unsigned long long)pk2(o0, o1) | ((unsigned long long)pk2(o2, o3) << 32);
        }
    }
    __syncthreads();
}
__device__ __forceinline__ void p3_kidx(const Frame& F) {
    const int gw = F.vcu * NWAVES + F.wave, NGW = F.G * NWAVES, l = F.lane;
    const bf16* SM = (const bf16*)(F.ws + WS_SMALL); bf16* KIDX = (bf16*)(F.ws + WS_KIDX); float* IDXW = (float*)(F.ws + WS_IDXW);
    const float* kg = F.in[14]; const float* kb = F.in[15]; const float* cosI = (const float*)(F.ws + WS_COSI); const float* sinI = (const float*)(F.ws + WS_SINI);
    for (int t0 = gw; t0 < S; t0 += 4 * NGW) {
        float z[4], cs[4], sn[4], wv[4];
#pragma unroll
        for (int u = 0; u < 4; ++u) { const int t = (t0 + u * NGW < S) ? t0 + u * NGW : t0; z[u] = bf2f(SM[(size_t)t * 256 + l]); cs[u] = cosI[t * 16 + (l & 15)]; sn[u] = sinI[t * 16 + (l & 15)]; wv[u] = bf2f(SM[(size_t)t * 256 + 64 + (l & 15)]); }
        const float gl = kg[l], bl = kb[l];
#pragma unroll
        for (int u = 0; u < 4; ++u) {
            const int t = t0 + u * NGW;
            const float mu = wave_sum(z[u]) * (1.f / 64.f); const float dd = z[u] - mu;
            const float r = rsqrtf(wave_sum(dd * dd) * (1.f / 64.f) + NORM_EPS);
            const float y = dd * r * gl + bl;
            const float yp = __shfl(y, (l < 16) ? l + 16 : ((l < 32) ? l - 16 : l));
            float o; int pos;
            if (l < 16) { o = y * cs[u] - yp * sn[u]; pos = 2 * l; } else if (l < 32) { o = y * cs[u] + yp * sn[u]; pos = 2 * (l - 16) + 1; } else { o = y; pos = l; }
            if (t < S) {
                KIDX[(size_t)(t >> 5) * 2048 + (pos >> 4) * 512 + (((pos >> 3) & 1) * 32 + (t & 31)) * 8 + (pos & 7)] = (bf16)f2bf(o);
                if (l < 16) IDXW[t * 16 + l] = wv[u] * 0.03125f;
            }
        }
    }
}
__device__ __forceinline__ void p3_rt(const Frame& F, int pm, LAS float* rt) {
    const float* st2 = (const float*)(F.ws + WS_STATS2);
    if (F.tid < 256) {
        const f32x4 a = *(const f32x4*)(st2 + (size_t)(pm * 256 + F.tid) * 8), b = *(const f32x4*)(st2 + (size_t)(pm * 256 + F.tid) * 8 + 4);
        const float ss = ((a.x + a.y) + (a.z + a.w)) + ((b.x + b.y) + (b.z + b.w));
        rt[F.tid] = rsqrtf(ss * (1.f / QL) + NORM_EPS);
    }
}
typedef float f32x16 __attribute__((ext_vector_type(16)));
__device__ __forceinline__ float key2f(unsigned k) { return __uint_as_float((k & 0x80000000u) ? (k ^ 0x80000000u) : ~k); }
__device__ __forceinline__ unsigned f2key(float f) { const unsigned b = __float_as_uint(f); return b ^ ((b >> 31) ? 0xFFFFFFFFu : 0x80000000u); }
__device__ __forceinline__ int wave_isum(int v) {
#pragma unroll
    for (int o = 1; o < 64; o <<= 1) v += __shfl_xor(v, o);
    return v;
}
__device__ __forceinline__ int idx_count_ge(const LAS f32x4* row4, int n256, float p, int lane) {
    int c = 0;
    for (int it = 0; it < n256; ++it) { const f32x4 v = row4[it * 64 + lane]; c += (v.x >= p ? 1 : 0) + (v.y >= p ? 1 : 0) + (v.z >= p ? 1 : 0) + (v.w >= p ? 1 : 0); }
    return wave_isum(c);
}
constexpr int IDX_NBIN = 1024;
constexpr float IDX_ZOOM = 8.0f;
__device__ __forceinline__ float relu_asm(float x) { const int b = __float_as_int(x); return __int_as_float(b > 0 ? b : 0); }
__device__ __forceinline__ float idx_kmax(const Frame& F) {
    const float g = fabsf(F.in[14][F.lane]), b = F.in[15][F.lane];
    return wave_max(g) * 8.0f + sqrtf(wave_sum(b * b));
}
template <bool FIRST>
__device__ __forceinline__ void p_rows(const Frame& F) {
    const int gw = F.vcu * NWAVES + F.wave, NGW = F.G * NWAVES;
    const float* mod = (const float*)(F.ws + WS_MOD);
    const float* gpost = F.in[5]; const float* gate = mod + 2 * D;
    const bf16* ysrc = (const bf16*)(F.ws + WS_F); const float* xsrc = F.in[0];
    bf16* H2 = (bf16*)(F.ws + WS_H);
    for (int m = gw; m < S; m += NGW) {
        const unsigned long long* yr = (const unsigned long long*)(ysrc + (size_t)m * D) + F.lane; const f32x4* xr = (const f32x4*)(xsrc + (size_t)m * D) + F.lane;
        f32x4 v[8]; float ss = 0.f;
#pragma unroll
        for (int j = 0; j < 8; ++j) { const unsigned long long yw = yr[64 * j]; const unsigned ylo = (unsigned)yw, yhi = (unsigned)(yw >> 32);
            v[j] = (f32x4){bflo(ylo), bfhi(ylo), bflo(yhi), bfhi(yhi)}; ss += (v[j].x * v[j].x + v[j].y * v[j].y) + (v[j].z * v[j].z + v[j].w * v[j].w); }
        f32x4 f[8]; float sf = 0.f;
        if (!FIRST) {
            const unsigned long long* fr = (const unsigned long long*)((const bf16*)(F.ws + WS_F2) + (size_t)m * D) + F.lane;
#pragma unroll
            for (int j = 0; j < 8; ++j) { const unsigned long long yw = fr[64 * j]; const unsigned ylo = (unsigned)yw, yhi = (unsigned)(yw >> 32);
                f[j] = (f32x4){bflo(ylo), bfhi(ylo), bflo(yhi), bfhi(yhi)}; sf += (f[j].x * f[j].x + f[j].y * f[j].y) + (f[j].z * f[j].z + f[j].w * f[j].w); }
        }
        const float r = rsqrtf(wave_sum(ss) * (1.f / D) + NORM_EPS);
        float s2 = 0.f;
#pragma unroll
        for (int j = 0; j < 8; ++j) {
            const int n = 4 * F.lane + 256 * j;
            const f32x4 gg = *(const f32x4*)(gpost + n), gt = *(const f32x4*)(gate + n);
            v[j] = xr[64 * j] + gt * (v[j] * r * gg);
            s2 += (v[j].x * v[j].x + v[j].y * v[j].y) + (v[j].z * v[j].z + v[j].w * v[j].w);
        }
        if (FIRST) {
            const float r2 = rsqrtf(wave_sum(s2) * (1.f / D) + NORM_EPS);
            const float* g2 = F.in[19];
            unsigned long long* o8 = (unsigned long long*)(H2 + (size_t)m * D) + F.lane;
#pragma unroll
            for (int j = 0; j < 8; ++j) {
                const int n = 4 * F.lane + 256 * j;
                const f32x4 gg = *(const f32x4*)(g2 + n), sh = *(const f32x4*)(mod + 3 * D + n), sc = *(const f32x4*)(mod + 4 * D + n);
                const f32x4 o = v[j] * r2 * gg * (sc + 1.0f) + sh;
                o8[64 * j] = (unsigned long long)pk2(o.x, o.y) | ((unsigned long long)pk2(o.z, o.w) << 32);
            }
        } else {
            const float rf = rsqrtf(wave_sum(sf) * (1.f / D) + NORM_EPS);
            const float* gpf = F.in[20]; const float* gatef = mod + 5 * D;
            f32x4* orow = (f32x4*)(F.out + (size_t)m * D) + F.lane;
#pragma unroll
            for (int j = 0; j < 8; ++j) {
                const int n = 4 * F.lane + 256 * j;
                const f32x4 gg = *(const f32x4*)(gpf + n), gt = *(const f32x4*)(gatef + n);
                orow[64 * j] = v[j] + gt * (f[j] * rf * gg);
            }
        }
    }
}
constexpr int X8_CAP = 128;
constexpr int X8_HIST_OFF = AUX_OFF, X8_MASKW_OFF = X8_HIST_OFF + 8 * (IDX_NBIN / 2) * 4, X8_CI_OFF = X8_MASKW_OFF + 8 * 128 * 8, X8_CX_OFF = X8_CI_OFF + 8 * X8_CAP * 2, X8_END = X8_CX_OFF + 8 * X8_CAP * 4;
constexpr int X8_SCALE_OFF = LDSCTL_OFF + 512, X8_CNT_OFF = X8_SCALE_OFF + 32, X8_FB_OFF = X8_CNT_OFF + 32;
constexpr int X8_WQ_OFF = X8_END;
static_assert(X8_WQ_OFF + 512 <= LDS_BYTES && X8_END <= LDS_BYTES && 8 * 8192 * 2 <= RING_BYTES && X8_FB_OFF + 32 <= LDSCTL_OFF + 640, "8-query indexer LDS map");
struct X8Regs { bf16x8 a[4][4]; f32x4 wq[4][4]; bf16x8 bA[4], bB[4], bC[4]; };
#define X8_ZERO16 ((f32x16){0.f, 0.f, 0.f, 0.f, 0.f, 0.f, 0.f, 0.f, 0.f, 0.f, 0.f, 0.f, 0.f, 0.f, 0.f, 0.f})
#define X8_HEADSUM(S_, WQ_, DD_) do { S_ = 0.f; _Pragma("unroll") for (int i_ = 0; i_ < 16; ++i_) S_ = __builtin_fmaf((WQ_)[i_ >> 2][i_ & 3], relu_asm((DD_)[i_]), S_); S_ += 0.0f; } while (0)
__device__ __forceinline__ unsigned x8_y16(float s, float scale64) { const unsigned u = (unsigned)fmaxf(fmaf(s, scale64, 64.0f * (float)(IDX_NBIN / 2)), 0.0f); return u < 65535u ? u : 65535u; }
__device__ __forceinline__ void x8_prefetch(const Frame& F, int t0, X8Regs& R) {
    const bf16* QIDX = (const bf16*)(F.ws + WS_QIDX); const bf16* KIDX = (const bf16*)(F.ws + WS_KIDX);
    const int lane = F.lane, r = lane & 31, hh = lane >> 5, w = F.wave, NT = t0 / 32 + 1;
#define X8_LOAD0(B_, kt_) do { const int ktc_ = (kt_) < NT ? (kt_) : NT - 1; \
        _Pragma("unroll") for (int ks = 0; ks < 4; ++ks) B_[ks] = *(const bf16x8*)(KIDX + (size_t)ktc_ * 2048 + ks * 512 + lane * 8); } while (0)
    X8_LOAD0(R.bA, w); X8_LOAD0(R.bB, w + 8); X8_LOAD0(R.bC, w + 16);
#undef X8_LOAD0
#pragma unroll
    for (int m = 0; m < 4; ++m) {
        const int tq = t0 + 2 * m + ((r >> 2) & 1), head = (r & 3) + 4 * (r >> 3);
#pragma unroll
        for (int ks = 0; ks < 4; ++ks) R.a[m][ks] = *(const bf16x8*)(QIDX + (size_t)tq * 1024 + head * 64 + 16 * ks + 8 * hh);
    }
}
__device__ __forceinline__ void x8_stage_wq(const Frame& F, int t0) { if (F.tid < 128) ((LAS float*)(F.lds + X8_WQ_OFF))[F.tid] = ((const float*)(F.ws + WS_IDXW))[t0 * 16 + F.tid]; }
__device__ __forceinline__ void x8_fetch_wq(const Frame& F, X8Regs& R) {
    const LAS f32x4* wl = (const LAS f32x4*)(F.lds + X8_WQ_OFF) + (F.lane >> 5) * 4;
#pragma unroll
    for (int m = 0; m < 4; ++m)
#pragma unroll
        for (int i4 = 0; i4 < 4; ++i4) R.wq[m][i4] = wl[m * 8 + i4];
}
__device__ __forceinline__ float x8_score_q(const X8Regs& R, int qi, const bf16x8 (&Bg)[4]) {
    float s = 0.f;
#define X8_CASE(M_) { asm volatile("; x8 row tile %0" :: "n"(M_));     \
        f32x16 d_ = X8_ZERO16; _Pragma("unroll") for (int ks = 0; ks < 4; ++ks) d_ = __builtin_amdgcn_mfma_f32_32x32x16_bf16(R.a[M_][ks], Bg[ks], d_, 0, 0, 0); X8_HEADSUM(s, R.wq[M_], d_); asm volatile("; x8 row tile %0 done" :: "n"(M_), "v"(s)); }
    const int m = qi >> 1;
    if (m == 0) X8_CASE(0) else if (m == 1) X8_CASE(1) else if (m == 2) X8_CASE(2) else X8_CASE(3)
#undef X8_CASE
    return s;
}
template <int G>
__device__ __forceinline__ void x8_pass_group(const LAS unsigned short* rp, unsigned thrLo, unsigned thrHi, unsigned& hlo, unsigned& hhi, unsigned& clo, unsigned& chi) {
    unsigned xv[8];
#pragma unroll
    for (int u = 0; u < 8; ++u) xv[u] = rp[512 * G + 64 * u];
    __builtin_amdgcn_sched_barrier(0);
#define X8_W(u_) { const unsigned long long hiw = __ballot(xv[u_] >= thrHi), cw = __ballot(xv[u_] >= thrLo) & ~hiw; \
        asm("s_nop 0\n\tv_writelane_b32 %0, %4, %8\n\tv_writelane_b32 %1, %5, %8\n\tv_writelane_b32 %2, %6, %8\n\tv_writelane_b32 %3, %7, %8" \
            : "+v"(hlo), "+v"(hhi), "+v"(clo), "+v"(chi) : "s"((unsigned)hiw), "s"((unsigned)(hiw >> 32)), "s"((unsigned)cw), "s"((unsigned)(cw >> 32)), "n"((8 * G + u_) & 63)); }
    X8_W(0) X8_W(1) X8_W(2) X8_W(3) X8_W(4) X8_W(5) X8_W(6) X8_W(7)
#undef X8_W
}
__device__ __forceinline__ void x8_zero_hist(const Frame& F) { LAS unsigned* hist = (LAS unsigned*)(F.lds + X8_HIST_OFF); for (int i = F.tid; i < 8 * (IDX_NBIN / 2); i += 512) hist[i] = 0u; }
__device__ __forceinline__ void x8_item(const Frame& F, int t0, int t0n, float kmax, X8Regs& R) {
    LAS unsigned short* sc = (LAS unsigned short*)(F.lds + RING_OFF);
    LAS unsigned* hist = (LAS unsigned*)(F.lds + X8_HIST_OFF);
    LAS unsigned* ccount = (LAS unsigned*)(F.lds + X8_CNT_OFF);
    LAS unsigned* fbflag = (LAS unsigned*)(F.lds + X8_FB_OFF);
    const bf16* KIDX = (const bf16*)(F.ws + WS_KIDX);
    const int w = F.wave;
    const int NT = t0 / 32 + 1;
    {
        const int lane = F.lane, r = lane & 31, hh = lane >> 5;
        float bs[4];
        x8_fetch_wq(F, R);
        bf16x8 (&a)[4][4] = R.a; f32x4 (&wq)[4][4] = R.wq;
#pragma unroll
        for (int m = 0; m < 4; ++m) {
            const int tq = t0 + 2 * m + ((r >> 2) & 1), head = (r & 3) + 4 * (r >> 3);
            float ss = 0.f;
#pragma unroll
            for (int ks = 0; ks < 4; ++ks) { const v4u x = __builtin_bit_cast(v4u, a[m][ks]); const unsigned ww[4] = {x.x, x.y, x.z, x.w};
#pragma unroll
                for (int e = 0; e < 4; ++e) ss += bflo(ww[e]) * bflo(ww[e]) + bfhi(ww[e]) * bfhi(ww[e]); }
            ss += __shfl_xor(ss, 32);
            float term = sqrtf(ss) * fabsf(((const LAS float*)(F.lds + X8_WQ_OFF))[(tq - t0) * 16 + head]);
            term += __shfl_xor(term, 1); term += __shfl_xor(term, 2); term += __shfl_xor(term, 8); term += __shfl_xor(term, 16);
            const float scl = (float)(IDX_NBIN / 2 - 1) / (term * kmax * (1.03f / IDX_ZOOM) + 1e-30f);
            const float other = __shfl_xor(scl, 4);
            const float s_even = ((r >> 2) & 1) ? other : scl, s_odd = ((r >> 2) & 1) ? scl : other;
            bs[m] = 64.0f * (hh ? s_odd : s_even);
        }
#define X8_LOAD(B_, kt_) do { const int ktc_ = (kt_) < NT ? (kt_) : NT - 1;     \
        _Pragma("unroll") for (int ks = 0; ks < 4; ++ks) B_[ks] = *(const bf16x8*)(KIDX + (size_t)ktc_ * 2048 + ks * 512 + lane * 8); } while (0)
#define X8_COMP_(B_, kt_, MASKED_) do { \
            _Pragma("unroll") for (int m = 0; m < 4; ++m) { \
                f32x16 dd = X8_ZERO16;     \
                _Pragma("unroll") for (int ks = 0; ks < 4; ++ks) dd = __builtin_amdgcn_mfma_f32_32x32x16_bf16(a[m][ks], B_[ks], dd, 0, 0, 0); \
                float s; X8_HEADSUM(s, wq[m], dd); \
                const int key = 32 * (kt_) + r, q = 2 * m + hh; const bool ok = !(MASKED_) || key <= t0 + q; \
                const unsigned u = x8_y16(s, bs[m]); \
                sc[q * 8192 + key] = (unsigned short)(ok ? u : 0u); \
                if (ok) __hip_atomic_fetch_add(hist + q * (IDX_NBIN / 2) + (u >> 7), 1u + 0xFFFFu * ((u >> 6) & 1u), __ATOMIC_RELAXED, __HIP_MEMORY_SCOPE_WORKGROUP); \
                __builtin_amdgcn_sched_barrier(0); } } while (0)
#define X8_COMP(B_, kt_) do { if ((kt_) < NT - 1) X8_COMP_(B_, kt_, 0); else if ((kt_) < NT) X8_COMP_(B_, kt_, 1); } while (0)
#define X8_PIN() __builtin_amdgcn_sched_barrier(0)
        bf16x8 (&bA)[4] = R.bA, (&bB)[4] = R.bB, (&bC)[4] = R.bC;
        X8_PIN();
        for (int kt = w; kt < NT; kt += 24) {
            X8_COMP(bA, kt); X8_PIN(); X8_LOAD(bA, kt + 24); X8_PIN();
            X8_COMP(bB, kt + 8); X8_PIN(); X8_LOAD(bB, kt + 32); X8_PIN();
            X8_COMP(bC, kt + 16); X8_PIN(); X8_LOAD(bC, kt + 40); X8_PIN();
        }
        X8_PIN();
#undef X8_PIN
#undef X8_LOAD
#undef X8_COMP
#undef X8_COMP_
    }
    int lane_o = F.lane; asm volatile("" : "+v"(lane_o));
    const int lane = lane_o, r = lane & 31, hh = lane >> 5;
    if (F.tid < 8) { ccount[F.tid] = 0u; fbflag[F.tid] = 0u; }
    if ((NT & 1) && F.tid < 256) sc[(F.tid >> 5) * 8192 + 32 * NT + (F.tid & 31)] = 0;
    LDS_WAIT(); __syncthreads();
    const int q = w, t = t0 + q, n = t + 1, nw = (n + 63) >> 6;
    LAS unsigned long long* mw = (LAS unsigned long long*)(F.lds + X8_MASKW_OFF) + q * 128;
    LAS unsigned short* ci = (LAS unsigned short*)(F.lds + X8_CI_OFF) + q * X8_CAP;
    LAS float* cx = (LAS float*)(F.lds + X8_CX_OFF) + q * X8_CAP;
    {
        LAS unsigned* hq = hist + q * (IDX_NBIN / 2);
        int Bbin = 0, inB = 0, need = 0; bool usehist = false;
        constexpr int BPL = IDX_NBIN / 64;
        static_assert(BPL == 16, "16 bins = 8 packed words per lane");
        {
            LAS v4u* h4 = (LAS v4u*)hq + 2 * lane;
            int hv[BPL];
#pragma unroll
            for (int q4 = 0; q4 < 2; ++q4) { const v4u hh4 = h4[q4]; const unsigned pw[4] = {hh4.x, hh4.y, hh4.z, hh4.w};
#pragma unroll
                for (int e = 0; e < 4; ++e) { hv[8 * q4 + 2 * e] = (int)(pw[e] & 0xffffu); hv[8 * q4 + 2 * e + 1] = (int)(pw[e] >> 16); } }
            h4[0] = (v4u){0u, 0u, 0u, 0u}; h4[1] = (v4u){0u, 0u, 0u, 0u};
            if (t >= 256) {
                int mine = 0;
#pragma unroll
                for (int e = 0; e < BPL; ++e) mine += hv[e];
                int suf = mine;
#pragma unroll
                for (int o = 1; o < 64; o <<= 1) { const int v = __shfl_down(suf, o); if (lane + o < 64) suf += v; }
                const unsigned long long ge = __ballot(suf >= 256);
                const int L = 63 - __builtin_clzll(ge);
                int acc = suf - mine, bsel = 0, csel = 0, asel = 0; bool found = false;
#pragma unroll
                for (int e = BPL - 1; e >= 0; --e) { const bool hit = !found && (acc + hv[e] >= 256); bsel = hit ? e : bsel; csel = hit ? hv[e] : csel; asel = hit ? acc : asel; found = found || hit; acc += hv[e]; }
                Bbin = BPL * L + __builtin_amdgcn_readlane(bsel, L); inB = __builtin_amdgcn_readlane(csel, L);
                need = 256 - __builtin_amdgcn_readlane(asel, L);
                usehist = inB <= X8_CAP && Bbin >= 1;
            }
        }
        if (usehist) {
            const unsigned thrLo = (unsigned)Bbin << 6, thrHi = ((unsigned)Bbin + 1u) << 6;
            unsigned h0l = 0u, h0h = 0u, c0l = 0u, c0h = 0u, h1l = 0u, h1h = 0u, c1l = 0u, c1h = 0u;
            const LAS unsigned short* rp = sc + q * 8192 + lane;
#define X8_G0(G_) if (nw > 8 * (G_)) x8_pass_group<G_>(rp, thrLo, thrHi, h0l, h0h, c0l, c0h);
#define X8_G1(G_) if (nw > 8 * (G_)) x8_pass_group<G_>(rp, thrLo, thrHi, h1l, h1h, c1l, c1h);
            X8_G0(0) X8_G0(1) X8_G0(2) X8_G0(3) X8_G0(4) X8_G0(5) X8_G0(6) X8_G0(7) X8_G1(8) X8_G1(9) X8_G1(10) X8_G1(11) X8_G1(12) X8_G1(13) X8_G1(14) X8_G1(15)
#undef X8_G0
#undef X8_G1
            const bool v0 = lane < nw, v1 = 64 + lane < nw;
            mw[lane] = v0 ? (((unsigned long long)h0h << 32) | h0l) : 0ull; mw[64 + lane] = v1 ? (((unsigned long long)h1h << 32) | h1l) : 0ull;
            unsigned long long cw0 = v0 ? (((unsigned long long)c0h << 32) | c0l) : 0ull, cw1 = v1 ? (((unsigned long long)c1h << 32) | c1l) : 0ull;
            const int nc = __builtin_popcountll(cw0) + __builtin_popcountll(cw1);
            if (nc) {
                int off = (int)__hip_atomic_fetch_add(ccount + q, (unsigned)nc, __ATOMIC_RELAXED, __HIP_MEMORY_SCOPE_WORKGROUP);
                while (cw0) { ci[off++] = (unsigned short)(64 * lane + __builtin_ctzll(cw0)); cw0 &= cw0 - 1ull; }
                while (cw1) { ci[off++] = (unsigned short)(64 * (64 + lane) + __builtin_ctzll(cw1)); cw1 &= cw1 - 1ull; }
            }
            LDS_WAIT();
            const int cnt = (int)*(volatile LAS unsigned*)(ccount + q);
            for (int c0 = 0; c0 < cnt; c0 += 32) {
                const int idx = c0 + r; const int key = idx < cnt ? (int)ci[idx] : 0;
                const bf16* kp = KIDX + (size_t)(key >> 5) * 2048 + (hh * 32 + (key & 31)) * 8;
                bf16x8 Bg[4];
#pragma unroll
                for (int ks = 0; ks < 4; ++ks) Bg[ks] = *(const bf16x8*)(kp + ks * 512);
                const float s = x8_score_q(R, q, Bg);
                if (hh == (q & 1) && idx < cnt) cx[idx] = s;
            }
            LDS_WAIT();
            for (int i0 = 0; i0 < cnt; i0 += 64) {
                const int i = i0 + lane; const bool act = i < cnt;
                const int ii = act ? (int)ci[i] : 0; const float xi = act ? cx[i] : 0.f;
                int rank = 0;
                for (int cb = 0; cb < cnt; cb += 64) {
                    const int jl = cb + lane; const bool jact = jl < cnt; const int ijv = jact ? (int)ci[jl] : 0; const float xjv = jact ? cx[jl] : 0.f;
                    const int cn = (cnt - cb < 64) ? cnt - cb : 64;
                    for (int l = 0; l < cn; ++l) {
                        const float xj = __builtin_bit_cast(float, __builtin_amdgcn_readlane(__builtin_bit_cast(int, xjv), l)); const int ij = __builtin_amdgcn_readlane(ijv, l);
                        rank += (xj > xi || (xj == xi && ij < ii)) ? 1 : 0;
                    }
                }
                if (act && rank < need) __hip_atomic_fetch_or(mw + (ii >> 6), 1ull << (ii & 63), __ATOMIC_RELAXED, __HIP_MEMORY_SCOPE_WORKGROUP);
            }
        } else if (t < 256) {
#pragma unroll
            for (int hf = 0; hf < 2; ++hf) { const int j = 64 * hf + lane; unsigned long long wv = 0ull;
                if (64 * j <= t) wv = (t - 64 * j >= 63) ? ~0ull : ((1ull << (t - 64 * j + 1)) - 1ull);
                mw[j] = wv; }
        } else if (lane == 0) fbflag[q] = 1u;
    }
    LDS_WAIT(); __syncthreads();
    {
        unsigned anyfb = 0u;
#pragma unroll
        for (int qf = 0; qf < 8; ++qf) anyfb |= fbflag[qf];
        if (anyfb) {
            LAS float* row = (LAS float*)(F.lds + RING_OFF);
            for (int qf = 0; qf < 8; ++qf) {
                if (fbflag[qf] == 0u) continue;
                const int tf = t0 + qf, nf = tf + 1, nwf = (nf + 63) >> 6, n256 = (nf + 255) >> 8;
                for (int kt = w; kt < NT; kt += 8) {
                    bf16x8 Bg[4];
#pragma unroll
                    for (int ks = 0; ks < 4; ++ks) Bg[ks] = *(const bf16x8*)(KIDX + (size_t)kt * 2048 + ks * 512 + lane * 8);
                    const float s = x8_score_q(R, qf, Bg);
                    const int key = 32 * kt + r;
                    if (hh == (qf & 1)) row[key] = (key <= tf) ? s : -INFINITY;
                }
                for (int idx = 32 * NT + F.tid; idx < 256 * n256; idx += 512) row[idx] = -INFINITY;
                LDS_WAIT(); __syncthreads();
                if (w == 0) {
                    LAS unsigned long long* mwf = (LAS unsigned long long*)(F.lds + X8_MASKW_OFF) + qf * 128;
                    unsigned long long w0 = 0ull, w1 = 0ull;
                    const LAS f32x4* row4 = (const LAS f32x4*)row;
                    unsigned T = 0u; bool exact = false; float pf = 0.f;
                    for (int bit = 31; bit >= 0; --bit) {
                        const unsigned cand = T | (1u << bit);
                        const float p = key2f(cand);
                        const int c = idx_count_ge(row4, n256, p, lane);
                        if (c >= 256) { T = cand; pf = p; if (c == 256) { exact = true; break; } }
                    }
                    int need2 = 0;
                    if (!exact) {
                        int cg = 0;
                        for (int it = 0; it < n256; ++it) { const f32x4 v = row4[it * 64 + lane]; cg += (v.x > pf ? 1 : 0) + (v.y > pf ? 1 : 0) + (v.z > pf ? 1 : 0) + (v.w > pf ? 1 : 0); }
                        need2 = 256 - wave_isum(cg);
                    }
                    for (int j = 0; j < nwf; ++j) {
                        const float x = row[64 * j + lane];
                        unsigned long long b;
                        if (exact) b = __ballot(x >= pf);
                        else {
                            b = __ballot(x > pf);
                            unsigned long long eq = __ballot(x == pf);
                            while (need2 > 0 && eq) { const unsigned long long low = eq & (~eq + 1ull); b |= low; eq ^= low; --need2; }
                        }
                        if (lane == (j & 63)) { if (j < 64) w0 = b; else w1 = b; }
                    }
                    mwf[lane] = w0; mwf[64 + lane] = w1;
                }
                LDS_WAIT(); __syncthreads();
            }
        }
    }
    x8_prefetch(F, t0n, R);
    x8_stage_wq(F, t0n);
    {
        const LAS unsigned long long* mwa = (const LAS unsigned long long*)(F.lds + X8_MASKW_OFF);
        const int ntw = 4 * (t0 >> 8) + 4;
        for (int g = F.tid; g < ntw * 32; g += 512) {
            const int j = g >> 5, qq = (g >> 2) & 7, hs = g & 3;
            const unsigned nib = (unsigned)(mwa[qq * 128 + j] >> (32 * (hs & 1) + 4 * (hs >> 1)));
            v4u o;
#pragma unroll
            for (int k = 0; k < 4; ++k) { const unsigned b = (((nib >> (8 * k)) & 15u) * 0x00204081u) & 0x01010101u; o[k] = (b ^ 0x01010101u) * 0xFCu; }
            unsigned char* mb = F.ws + (j < 64 ? WS_MASKB0 : WS_MASKB1 - (size_t)64 * 524288) + (size_t)j * 524288 + (size_t)t0 * 64;
            *(v4u*)(mb + (g & 31) * 16) = o;
        }
    }
    __syncthreads();
}
namespace att {
constexpr int D = 128, PITCH = 1024, NW = 8, QBLK = 32, KVBLK = 64, QB = NW * QBLK;
constexpr int SHM_V = KVBLK * D * 2, SHM_K = KVBLK * D * 2;
constexpr int LDS_BYTES = 2 * SHM_V + 2 * SHM_K + NW * 64 * 4;
constexpr float SCALE = 0.08838834764831845f, THR = 8.f;
constexpr float C2 = 1.4426950408889634f * SCALE;
typedef unsigned short bf16;
typedef short bf16x8 __attribute__((ext_vector_type(8)));
typedef short s16x4 __attribute__((ext_vector_type(4)));
typedef float f32x16 __attribute__((ext_vector_type(16)));
typedef float f32x4 __attribute__((ext_vector_type(4)));
typedef float f32x2 __attribute__((ext_vector_type(2)));
typedef unsigned u32x4 __attribute__((ext_vector_type(4)));
typedef unsigned long long u64;
#define KSWZ(row, colB) ((row) * 256 + ((colB) ^ (((row) & 7) << 4)))
#define SBAR() __builtin_amdgcn_sched_barrier(0)
__device__ __forceinline__ int v_st(int k, int c) { const int kk = (k & ~0xC) | ((k & 4) << 1) | ((k & 8) >> 1); return ((kk >> 3) * 4 + (c >> 5)) * 512 + ((kk & 7) * 32 + (c & 31)) * 2; }
__device__ __forceinline__ int v_rd_base(int lane) { return ((lane & 3) << 3) | (((lane >> 2) & 3) << 6) | (((lane >> 4) & 1) << 5) | (((lane >> 5) & 1) << 8); }
constexpr int v_rd_off(int d0, int ks, int half) { return d0 * 512 + ks * 4096 + half * 2048; }
__device__ __forceinline__ int crow(int r, int hi) { return (r & 3) + 8 * (r >> 2) + 4 * hi; }
typedef __bf16 bf16x2_t __attribute__((ext_vector_type(2)));
__device__ __forceinline__ unsigned cvtpk(float lo, float hi) { const float __attribute__((ext_vector_type(2))) v = {lo, hi}; const bf16x2_t b = __builtin_convertvector(v, bf16x2_t); return __builtin_bit_cast(unsigned, b); }
__device__ __forceinline__ bf16x8 load8(const bf16* p) { return *reinterpret_cast<const bf16x8*>(p); }
__device__ __forceinline__ void partialSM(f32x16& p0, f32x16& p1, float& m_reg, float& mn, float& alpha) {
    float pmax = p0[0]; for (int r = 1; r < 16; ++r) pmax = fmaxf(pmax, p0[r]); for (int r = 0; r < 16; ++r) pmax = fmaxf(pmax, p1[r]);
    { auto rr = __builtin_amdgcn_permlane32_swap(__float_as_uint(pmax), __float_as_uint(pmax), false, false);
      pmax = fmaxf(__uint_as_float(rr[0]), __uint_as_float(rr[1])); }
    if (__builtin_expect(__all((pmax - m_reg) * SCALE <= THR), 1)) { mn = m_reg; alpha = 1.f; }
    else { mn = fmaxf(m_reg, pmax); alpha = __builtin_amdgcn_exp2f((m_reg - mn) * C2); m_reg = mn; }
    const float mnL = -mn * C2;
    for (int r = 0; r < 16; ++r) p0[r] = fmaf(p0[r], C2, mnL); for (int r = 0; r < 16; ++r) p1[r] = fmaf(p1[r], C2, mnL);
    for (int r = 0; r < 16; ++r) p0[r] = __builtin_amdgcn_exp2f(p0[r]);
}
__device__ __forceinline__ void finishSM(f32x16& p0, f32x16& p1, float alpha, float& l_reg, bf16x8& pa0, bf16x8& pa1, bf16x8& pa2, bf16x8& pa3) {
    for (int r = 0; r < 16; ++r) p1[r] = __builtin_amdgcn_exp2f(p1[r]);
    float ps = 0; for (int r = 0; r < 16; ++r) ps += p0[r]; for (int r = 0; r < 16; ++r) ps += p1[r];
    { auto rr = __builtin_amdgcn_permlane32_swap(__float_as_uint(ps), __float_as_uint(ps), false, false);
      ps = __uint_as_float(rr[0]) + __uint_as_float(rr[1]); }
    l_reg = l_reg * alpha + ps;
#define PK4(P, B_, OUT) do { unsigned a0 = cvtpk(P[B_+0], P[B_+1]), a1 = cvtpk(P[B_+2], P[B_+3]);                          \
        unsigned b0 = cvtpk(P[B_+4], P[B_+5]), b1 = cvtpk(P[B_+6], P[B_+7]);                                             \
        auto r0 = __builtin_amdgcn_permlane32_swap(a0, b0, false, false); auto r1 = __builtin_amdgcn_permlane32_swap(a1, b1, false, false); \
        u32x4 w = {r0[0], r1[0], r0[1], r1[1]}; OUT = *reinterpret_cast<bf16x8*>(&w); } while (0)
    PK4(p0, 0, pa0); PK4(p0, 8, pa1); PK4(p1, 0, pa2); PK4(p1, 8, pa3);
#undef PK4
}
template <int KB>
__device__ __forceinline__ void qkt(f32x16& p0, f32x16& p1, const char* K_lds, int r32, int hi, const bf16x8* qr, u32x4 wa, u32x4 wb) {
#pragma unroll
    for (int w4 = 0; w4 < 4; ++w4) {
        const f32x2 a0 = __builtin_amdgcn_cvt_pk_f32_bf8((int)wa[w4], false), a1 = __builtin_amdgcn_cvt_pk_f32_bf8((int)wa[w4], true);
        const f32x2 b0 = __builtin_amdgcn_cvt_pk_f32_bf8((int)wb[w4], false), b1 = __builtin_amdgcn_cvt_pk_f32_bf8((int)wb[w4], true);
        p0[4 * w4] = a0.x; p0[4 * w4 + 1] = a0.y; p0[4 * w4 + 2] = a1.x; p0[4 * w4 + 3] = a1.y;
        p1[4 * w4] = b0.x; p1[4 * w4 + 1] = b0.y; p1[4 * w4 + 2] = b1.x; p1[4 * w4 + 3] = b1.y;
    }
    const char* kb[4];
#pragma unroll
    for (int dd = 0; dd < 4; ++dd) kb[dd] = K_lds + KB * SHM_K + KSWZ(r32, (dd * 16 + hi * 8) * 2);
#pragma unroll
    for (int d0 = 0; d0 < 8; ++d0) { const char* a = kb[d0 & 3] + (d0 >> 2) * 128;
        bf16x8 b0 = *reinterpret_cast<const bf16x8*>(a);
        bf16x8 b1 = *reinterpret_cast<const bf16x8*>(a + 32 * 256);
        p0 = __builtin_amdgcn_mfma_f32_32x32x16_bf16(b0, qr[d0], p0, 0, 0, 0);
        p1 = __builtin_amdgcn_mfma_f32_32x32x16_bf16(b1, qr[d0], p1, 0, 0, 0); }
}
template <int VB>
__device__ __forceinline__ void pv_tile(f32x16* o, int vb0, bf16x8 pa0, bf16x8 pa1, bf16x8 pa2, bf16x8 pa3) {
#define TRRD(dst, off) asm volatile("ds_read_b64_tr_b16 %0, %1 offset:%2" : "=&v"(dst) : "v"(vb0), "i"(off) : "memory")
#define PV_D0(d0) do { s16x4 l0, l1, l2, l3, h0, h1, h2, h3; constexpr int b_ = VB * SHM_V + v_rd_off(d0, 0, 0); \
        TRRD(l0, b_); TRRD(h0, b_ + 2048); TRRD(l1, b_ + 4096); TRRD(h1, b_ + 6144); TRRD(l2, b_ + 8192); TRRD(h2, b_ + 10240); TRRD(l3, b_ + 12288); TRRD(h3, b_ + 14336); \
        asm volatile("s_waitcnt lgkmcnt(0)" ::: "memory"); SBAR();   \
        o[d0] = __builtin_amdgcn_mfma_f32_32x32x16_bf16(pa0, (bf16x8){l0[0], l0[1], l0[2], l0[3], h0[0], h0[1], h0[2], h0[3]}, o[d0], 0, 0, 0);   \
        o[d0] = __builtin_amdgcn_mfma_f32_32x32x16_bf16(pa1, (bf16x8){l1[0], l1[1], l1[2], l1[3], h1[0], h1[1], h1[2], h1[3]}, o[d0], 0, 0, 0);   \
        o[d0] = __builtin_amdgcn_mfma_f32_32x32x16_bf16(pa2, (bf16x8){l2[0], l2[1], l2[2], l2[3], h2[0], h2[1], h2[2], h2[3]}, o[d0], 0, 0, 0);   \
        o[d0] = __builtin_amdgcn_mfma_f32_32x32x16_bf16(pa3, (bf16x8){l3[0], l3[1], l3[2], l3[3], h3[0], h3[1], h3[2], h3[3]}, o[d0], 0, 0, 0); } while (0)
    PV_D0(0); PV_D0(1); PV_D0(2); PV_D0(3);
#undef PV_D0
#undef TRRD
}
struct BlockRef { int P0, j_lo, j_hi; int uid, pid; unsigned* cnt; };
struct Bufs { bf16* YBh; const char* Qh; const char* Kh; const char* Vh; const char* Mh0; const char* Mh1; };
__device__ __forceinline__ bf16x8 bload8(__amdgpu_buffer_rsrc_t r, unsigned voff, unsigned soff) { return __builtin_bit_cast(bf16x8, __builtin_amdgcn_raw_buffer_load_b128(r, voff, soff, 0)); }
typedef unsigned u32x2 __attribute__((ext_vector_type(2)));
__device__ __forceinline__ u64 bload_u64(__amdgpu_buffer_rsrc_t r, unsigned voff, unsigned soff) { const u32x2 w = __builtin_amdgcn_raw_buffer_load_b64(r, voff, soff, 0); return (u64)w.x | ((u64)w.y << 32); }
struct Seam { bf16x8 qr[8]; bf16x8 st_v0, st_v1, st_k0, st_k1; };
#define VMW() asm volatile("s_waitcnt vmcnt(0)" ::: "memory")
#define VMWN(n) asm volatile("s_waitcnt vmcnt(%0)" :: "i"(n) : "memory")
#define GLD8(base_, voff_) (*(const bf16x8*)((const char*)(base_) + (size_t)(unsigned)(voff_)))
#define SLOAD_H(k0) do { const char* kb_ = B.Kh + (size_t)(k0) * (PITCH * 2); const char* vb_ = B.Vh + (size_t)(k0) * (PITCH * 2);                    \
                         S.st_v0 = GLD8(vb_, voff); S.st_v1 = GLD8(vb_ + 32 * PITCH * 2, voff); S.st_k0 = GLD8(kb_, voff); S.st_k1 = GLD8(kb_ + 32 * PITCH * 2, voff); } while (0)
#define QLOAD(R_) do { const char* qb_ = B.Qh + (size_t)((R_).P0) * (PITCH * 2); _Pragma("unroll") for (int d0 = 0; d0 < 8; ++d0) S.qr[d0] = GLD8(qb_ + d0 * 32, voffq); } while (0)
#define SWRITE_HK(bf) do { *(bf16x8*)(K_lds + (bf) * SHM_K + kws) = S.st_k0; *(bf16x8*)(K_lds + (bf) * SHM_K + kws + 32 * 256) = S.st_k1; } while (0)
#define SWRITE_HV(bf) do { *(bf16x8*)(V_lds + (bf) * SHM_V + vst0) = S.st_v0; *(bf16x8*)(V_lds + (bf) * SHM_V + vst1) = S.st_v1; } while (0)
#define SWRITE_H(bf) do { SWRITE_HV(bf); SWRITE_HK(bf); } while (0)
__device__ __forceinline__ void prime(const BlockRef& cur, const Bufs& B, char* lds, Seam& S) {
    const int tid = threadIdx.x, wid = __builtin_amdgcn_readfirstlane(tid >> 6), lane = tid & 63, r32 = lane & 31, hi = lane >> 5;
    const int sr = tid >> 4, sc = (tid & 15) * 8, kws = KSWZ(sr, sc * 2); char* K_lds = lds + 2 * SHM_V;
    const unsigned voff = (unsigned)(sr * PITCH + sc) * 2u, voffq = (unsigned)((wid * QBLK + r32) * PITCH + hi * 8) * 2u;
    const int kb0 = cur.j_lo * KVBLK;
    QLOAD(cur);
    SLOAD_H(kb0); VMW(); SWRITE_HK(0);
    __syncthreads();
}
__device__ __forceinline__ void block(const BlockRef& cur, const BlockRef& nxt, const Bufs& B, float* PART, f32x2* ML, char* lds, Seam& S) {
    const int tid = threadIdx.x, wid = __builtin_amdgcn_readfirstlane(tid >> 6), lane = tid & 63, r32 = lane & 31, hi = lane >> 5;
    const int j_lo = cur.j_lo, NT = cur.j_hi - cur.j_lo;
    const int kbn = nxt.j_lo * KVBLK;
    char* V_lds = lds; char* K_lds = lds + 2 * SHM_V;
    float* ws = (float*)(lds + 2 * SHM_V + 2 * SHM_K) + wid * 64; float* li_l = ws, * al_l = ws + 32;
    float m_reg = -1e30f, l_reg = 0; f32x16 o[4] = {};
    const int sr = tid >> 4, sc = (tid & 15) * 8, vst0 = v_st(sr, sc), vst1 = v_st(32 + sr, sc), kws = KSWZ(sr, sc * 2);
    const int vb0 = (int)(uintptr_t)V_lds + v_rd_base(lane);
    const unsigned voff = (unsigned)(sr * PITCH + sc) * 2u, voffq = (unsigned)((wid * QBLK + r32) * PITCH + hi * 8) * 2u;
    const unsigned voffm = (unsigned)((wid * QBLK + r32) * 64 + hi * 32);
#define MBASE(t) (((j_lo + (t)) < 64 ? B.Mh0 : B.Mh1) + (size_t)(j_lo + (t)) * 524288u + (size_t)cur.P0 * 64u)
#define MLOAD(WA, WB, t) do { const char* mb_ = MBASE(t); WA = *(const u32x4*)(mb_ + (size_t)voffm); WB = *(const u32x4*)(mb_ + 16 + (size_t)voffm); } while (0)
#define RESC(a) do { if (__any((a) < 1.f)) { if (hi == 0) al_l[r32] = (a); asm volatile("s_waitcnt lgkmcnt(0)" ::: "memory");              \
                     for (int d_ = 0; d_ < 4; ++d_) for (int r = 0; r < 16; ++r) o[d_][r] *= al_l[crow(r, hi)]; } } while (0)
#define KBASE(t) ((j_lo + (t)) * KVBLK)
    constexpr int NQL = 8;
#define SEAM_K0() do { VMWN(NQL); SWRITE_HK(0); SBAR(); } while (0)
    f32x16 pA0, pA1, pB0, pB1; float mnA, mnB, alA, alB; bf16x8 pa0, pa1, pa2, pa3;
    u32x4 wcA, wcB, wnA = {0u, 0u, 0u, 0u}, wnB = {0u, 0u, 0u, 0u}; MLOAD(wcA, wcB, 0);
    SWRITE_HV(0); SBAR();
    if (NT > 1) { SLOAD_H(KBASE(1)); MLOAD(wnA, wnB, 1); }
    SBAR(); qkt<0>(pA0, pA1, K_lds, r32, hi, S.qr, wcA, wcB);
    partialSM(pA0, pA1, m_reg, mnA, alA);
    if (NT > 1) { VMW(); SWRITE_H(1); }
    __syncthreads();
#define HALF_STEP(PX0, PX1, mnX, alX, PY0, PY1, alY, t, KB, VB, SB) do {                                                      \
        wcA = wnA; wcB = wnB;                                                                                                 \
        SBAR(); qkt<KB>(PX0, PX1, K_lds, r32, hi, S.qr, wcA, wcB);                                                           \
        finishSM(PY0, PY1, alY, l_reg, pa0, pa1, pa2, pa3); SBAR();                                                           \
        if ((t) + 1 < NT) { SLOAD_H(KBASE((t) + 1)); MLOAD(wnA, wnB, (t) + 1); SBAR(); }               \
        pv_tile<VB>(o, vb0, pa0, pa1, pa2, pa3); partialSM(PX0, PX1, m_reg, mnX, alX);                                        \
        __syncthreads();                                                                                                      \
        if ((t) + 1 < NT) { VMW(); SWRITE_H(SB); }                                                                            \
        RESC(alX); __syncthreads(); } while (0)
    for (int t = 1; t + 1 < NT; t += 2) {
        HALF_STEP(pB0, pB1, mnB, alB, pA0, pA1, alA, t, 1, 0, 0);
        HALF_STEP(pA0, pA1, mnA, alA, pB0, pB1, alB, t + 1, 0, 1, 1);
    }
    const bool even = (NT & 1) == 0;
    if (even) { wcA = wnA; wcB = wnB; SBAR(); qkt<1>(pB0, pB1, K_lds, r32, hi, S.qr, wcA, wcB); SBAR(); }
    SLOAD_H(kbn); SBAR();
    QLOAD(nxt);
    SBAR();
    finishSM(pA0, pA1, alA, l_reg, pa0, pa1, pa2, pa3); SBAR();
    pv_tile<0>(o, vb0, pa0, pa1, pa2, pa3);
    if (even) { partialSM(pB0, pB1, m_reg, mnB, alB); __syncthreads(); RESC(alB);
        finishSM(pB0, pB1, alB, l_reg, pa0, pa1, pa2, pa3); SBAR(); pv_tile<1>(o, vb0, pa0, pa1, pa2, pa3); }
    SBAR(); SEAM_K0();
    {
        float* po = PART + ((size_t)cur.uid * NW + wid) * 4096 + lane;
#pragma unroll
        for (int r = 0; r < 16; ++r)
#pragma unroll
            for (int d0 = 0; d0 < 4; ++d0) po[(r * 4 + d0) * 64] = o[d0][r];
        ML[((size_t)cur.uid * NW + wid) * 64 + lane] = (f32x2){m_reg, l_reg};
    }
    VMW();
    __syncthreads();
    unsigned* flag = (unsigned*)(lds + 2 * SHM_V + 2 * SHM_K + NW * 64 * 4);
    if (tid == 0) {
        __builtin_amdgcn_fence(__ATOMIC_RELEASE, "agent");
        asm volatile("s_waitcnt vmcnt(0)" ::: "memory");
        const unsigned old = __hip_atomic_fetch_add(cur.cnt, 1u, __ATOMIC_RELAXED, __HIP_MEMORY_SCOPE_AGENT);
        if (old == 1u) { __builtin_amdgcn_fence(__ATOMIC_ACQUIRE, "agent"); asm volatile("s_waitcnt vmcnt(0)" ::: "memory"); }
        *flag = old;
    }
    asm volatile("s_waitcnt lgkmcnt(0)" ::: "memory");
    __syncthreads();
    const bool last = (*(volatile unsigned*)flag) == 1u;
    if (last) {
        const f32x2 ml2 = ML[((size_t)cur.pid * NW + wid) * 64 + lane];
        const float m2 = ml2.x, l2 = ml2.y, mm = fmaxf(m_reg, m2);
        const float a1 = __builtin_amdgcn_exp2f((m_reg - mm) * C2), a2 = __builtin_amdgcn_exp2f((m2 - mm) * C2);
        const float linv = __builtin_amdgcn_rcpf(__fadd_rn(__fmul_rn(l_reg, a1), __fmul_rn(l2, a2)));
        if (hi == 0) { li_l[r32] = a1 * linv; al_l[r32] = a2 * linv; }
        asm volatile("s_waitcnt lgkmcnt(0)" ::: "memory");
        float o2[64];
        { const float* pp = PART + ((size_t)cur.pid * NW + wid) * 4096 + lane;
#pragma unroll
        for (int i = 0; i < 64; ++i) o2[i] = pp[i * 64]; }
#pragma unroll
        for (int r = 0; r < 16; ++r) { const int orow = crow(r, hi); const float f1 = li_l[orow], f2 = al_l[orow];
#pragma unroll
            for (int d0 = 0; d0 < 4; ++d0) o2[r * 4 + d0] = __fadd_rn(__fmul_rn(o[d0][r], f1), __fmul_rn(o2[r * 4 + d0], f2)); }
        const unsigned vo = (unsigned)(hi * 4 * PITCH + r32) * 2u, so = (unsigned)(cur.P0 + wid * QBLK) * (PITCH * 2);
#pragma unroll
        for (int r = 0; r < 16; ++r)
#pragma unroll
            for (int d0 = 0; d0 < 4; ++d0) { const float v = o2[r * 4 + d0]; const float vn = __shfl_xor(v, 1);
                if ((r32 & 1) == 0) *(unsigned*)((char*)B.YBh + (size_t)(so + ((r & 3) + 8 * (r >> 2)) * (PITCH * 2) + d0 * 64) + vo) = cvtpk(v, vn); }
    }
    __syncthreads();
#undef RESC
#undef KBASE
#undef SEAM_K0
#undef HALF_STEP
#undef MLOAD
#undef MBASE
}
#undef QLOAD
#undef GLD8
#undef VMW
#undef VMWN
#undef SLOAD_H
#undef SWRITE_HK
#undef SWRITE_HV
#undef SWRITE_H
#undef KSWZ
#undef SBAR
}
struct Args { const float* in[24]; float* out; unsigned char* ws; int ph_lo, ph_hi, li, pad; };
__global__ void __launch_bounds__(NWAVES * 64, 2) skel_fwd(Args args) {
    extern __shared__ __attribute__((aligned(16))) unsigned char lds[];
    Frame F;
    F.lds = (LAS unsigned char*)lds;
    F.MISC = (volatile LAS unsigned*)(F.lds + MISC_OFF);
    F.tid = threadIdx.x; F.lane = F.tid & 63; F.wave = __builtin_amdgcn_readfirstlane(F.tid >> 6);
    F.G = gridDim.x; { const int bx = blockIdx.x; F.vcu = (F.G % 8 == 0) ? (bx % 8) * (F.G / 8) + bx / 8 : bx; }
#pragma unroll
    for (int i = 0; i < 24; ++i) F.in[i] = args.in[i];
    F.out = args.out; F.ws = args.ws;
    F.ctl = (gu32*)(args.ws + WS_CTL);
    for (int u = F.tid; u < (LDS_BYTES - LDSCTL_OFF) / 4; u += NWAVES * 64) ((LAS unsigned*)(F.lds + LDSCTL_OFF))[u] = 0u;
    __syncthreads();
    XcdBarrier bar; bar.bar = (unsigned*)(F.ctl + CW_BAR); bar.x = 0; bar.st = nullptr;
    if (N_LAUNCHES == 1) bar = xcd_barrier_post((unsigned*)(F.ctl + CW_BAR), F.MISC + 8);
#define GRID_BAR() do { if (N_LAUNCHES == 1) xcd_barrier(bar); } while (0)
    const int lo = args.ph_lo, hi = args.ph_hi;
#define IN(k) (lo <= (k) && (k) < hi)
#define BOTH(k) (IN(k) && IN((k) + 1))
    unsigned char* ws = args.ws;
    const float* cosA = (const float*)(ws + WS_COSA); const float* sinA = (const float*)(ws + WS_SINA); const float* cosI = (const float*)(ws + WS_COSI); const float* sinI = (const float*)(ws + WS_SINI);

    if (IN(0)) { p0_prologue(F); if (BOTH(0)) GRID_BAR(); }
    if (IN(1)) { p1_prenorm(F); if (BOTH(1)) GRID_BAR(); }
    if (IN(2)) {
        pg8::Gemm g{(const pg8::bf16_t*)(ws + WS_H), (const pg8::bf16_t*)(ws + WS_WIN), S, NPROJ, D}; pg8::StaticOrder So; So.init(S, NPROJ, F.G, (int)blockIdx.x);
        pg8::EpiProj E{(pg8::bf16_t*)(ws + WS_U), (pg8::bf16_t*)(ws + WS_VG), (pg8::bf16_t*)(ws + WS_QLAT), (pg8::bf16_t*)(ws + WS_K), (pg8::bf16_t*)(ws + WS_V), (pg8::bf16_t*)(ws + WS_GATE), (pg8::bf16_t*)(ws + WS_SMALL),
                       (float*)(ws + WS_STATS), (float*)(ws + WS_STATS2), cosA, sinA};
        pg8::gemm_phase<pg8::EpiProj, pg8::StaticOrder, true, true>(F.lds + RING_OFF, g, So, E);
        { const int nun = (S / 256) * (NPROJ / 256), rem = nun % F.G;
          if (rem != 0 && (int)blockIdx.x >= rem) p_late_convert(F, 0, (int)blockIdx.x - rem, F.G - rem); else if (rem == 0) p_late_convert(F, 0, (int)blockIdx.x, F.G); }
        if (BOTH(2)) GRID_BAR();
    }
    if (IN(3)) {
        pg8::Gemm g{(const pg8::bf16_t*)(ws + WS_QLAT), (const pg8::bf16_t*)(ws + WS_WQQ), S, 2048, QL}; pg8::StaticOrder So; So.init(S, 2048, F.G, (int)blockIdx.x);
        LAS float* rt = (LAS float*)(F.lds + AUX_OFF);
        { pg8::Unit u0; if (So.next(0, u0)) p3_rt(F, u0.pm, rt); }
        LDS_WAIT(); __syncthreads();
        pg8::EpiQ E{(pg8::bf16_t*)(ws + WS_Q), (pg8::bf16_t*)(ws + WS_QIDX), (const PG8_LAS float*)rt, cosA, sinA, cosI, sinI, 1.0f};
        pg8::gemm_phase<pg8::EpiQ, pg8::StaticOrder, true, true>(F.lds + RING_OFF, g, So, E);
        __syncthreads();
        { SpatialW Wm; p3_spatial_load(F, F.vcu & 7, Wm);
          for (int it = F.vcu; it < 512; it += F.G) p3_spatial_item(F, it >> 3, it & 7, Wm); }
        p3_kidx(F);
        if (BOTH(3)) GRID_BAR();
    }
    if (IN(4)) {
        const float kmax = idx_kmax(F);
        {
            X8Regs R;
#define P4_ITEM(rr_) ((rr_) * F.G + (((rr_) & 1) ? (F.G - 1 - F.vcu) : F.vcu))
            if (P4_ITEM(0) < S / 8) { x8_prefetch(F, 8 * P4_ITEM(0), R); x8_stage_wq(F, 8 * P4_ITEM(0)); }
            x8_zero_hist(F); LDS_WAIT(); __syncthreads();
            for (int rr = 0; rr * F.G < S / 8; ++rr) { const int it = P4_ITEM(rr), itn = P4_ITEM(rr + 1); if (it < S / 8) x8_item(F, 8 * it, (itn < S / 8) ? 8 * itn : 8 * it, kmax, R); }
#undef P4_ITEM
        }
        if (BOTH(4)) GRID_BAR();
    }
    if (IN(5)) {
        const int v = F.vcu & 255, h = v >> 5, i = v & 31, a = i & 15, zz = i >> 4;
        const att::bf16* Qb = (const att::bf16*)(ws + WS_Q); const att::bf16* Kb = (const att::bf16*)(ws + WS_K); const att::bf16* Vb = (const att::bf16*)(ws + WS_V); att::bf16* YB = (att::bf16*)(ws + WS_YB);
        att::BlockRef u0, u1;
#define MKREF(R, x_) do { const int x = (x_); R.P0 = 256 * x; const int half = 2 * (x + 1); R.j_lo = zz * half; R.j_hi = R.j_lo + half; R.uid = (h * 32 + x) * 2 + zz; R.pid = R.uid ^ 1; \
        R.cnt = (unsigned*)(F.ctl + CW_ATT) + (h * 32 + x) * 64; } while (0)
        MKREF(u0, a); MKREF(u1, 31 - a);
#undef MKREF
        att::Bufs B;
        B.YBh = YB + h * 128;
        B.Qh = (const char*)(Qb + h * 128); B.Kh = (const char*)(Kb + h * 128); B.Vh = (const char*)(Vb + h * 128); B.Mh0 = (const char*)(ws + WS_MASKB0); B.Mh1 = (const char*)(ws + WS_MASKB1) - (size_t)64 * 524288;
        att::Seam Sm;
        float* PART = F.out; att::f32x2* ML = (att::f32x2*)(ws + WS_WIN);
        { att::prime(u0, B, (char*)lds + RING_OFF, Sm);
        att::block(u0, u1, B, PART, ML, (char*)lds + RING_OFF, Sm);
        att::block(u1, u1, B, PART, ML, (char*)lds + RING_OFF, Sm); }
        if (BOTH(5)) GRID_BAR();
    }
    if (IN(6)) {
        pg8::Gemm g{(const pg8::bf16_t*)(ws + WS_U), (const pg8::bf16_t*)(ws + WS_WPA), S, D, GW, (const pg8::bf16_t*)(ws + WS_YB), (const pg8::bf16_t*)(ws + WS_WPB)};
        pg8::PairOrder So; So.init(S, D, F.G, (int)blockIdx.x);
        pg8::EpiGate2 E{(const pg8::bf16_t*)(ws + WS_GATE), (pg8::bf16_t*)(ws + WS_H)};
        pg8::gemm_phase<pg8::EpiGate2, pg8::PairOrder, true, true>(F.lds + RING_OFF, g, So, E);
    }
    if (IN(7)) { if (BOTH(7)) GRID_BAR(); }
    if (IN(8)) {
        pg8::Gemm g{(const pg8::bf16_t*)(ws + WS_H), (const pg8::bf16_t*)(ws + WS_WOUT), S, D, D}; pg8::StaticOrder So; So.init(S, D, F.G, (int)blockIdx.x);
        pg8::EpiOutBf16 E{(pg8::bf16_t*)(ws + WS_F)};
        pg8::gemm_phase<pg8::EpiOutBf16, pg8::StaticOrder, true, true>(F.lds + RING_OFF, g, So, E);
        if (BOTH(8)) GRID_BAR();
    }
    if (IN(9)) { p_rows<true>(F); if (BOTH(9)) GRID_BAR(); }
    if (IN(10)) {
        pg8::Gemm g{(const pg8::bf16_t*)(ws + WS_H), (const pg8::bf16_t*)(ws + WS_WGU), S, 2 * FF, D}; pg8::StaticOrder So; So.init(S, 2 * FF, F.G, (int)blockIdx.x);
        pg8::EpiSwiGLU E{(pg8::bf16_t*)(ws + WS_ACT), FF};
        pg8::gemm_phase<pg8::EpiSwiGLU, pg8::StaticOrder, true, true>(F.lds + RING_OFF, g, So, E);
        { const int nun = (S / 256) * (2 * FF / 256), rem = nun % F.G;
          if (rem != 0 && (int)blockIdx.x >= rem) p_late_convert(F, 1, (int)blockIdx.x - rem, F.G - rem); else if (rem == 0) p_late_convert(F, 1, (int)blockIdx.x, F.G); }
        if (BOTH(10)) GRID_BAR();
    }
    if (IN(11)) {
        pg8::Gemm g{(const pg8::bf16_t*)(ws + WS_ACT), (const pg8::bf16_t*)(ws + WS_WDOWN), S, D, FF}; pg8::StaticOrder So; So.init(S, D, F.G, (int)blockIdx.x);
        pg8::EpiOutBf16 E{(pg8::bf16_t*)(ws + WS_F2)};
        pg8::gemm_phase<pg8::EpiOutBf16, pg8::StaticOrder, true, true>(F.lds + RING_OFF, g, So, E);
        if (BOTH(11)) GRID_BAR();
    }
    if (IN(12)) { p_rows<false>(F); }
#undef IN
#undef BOTH
#undef GRID_BAR
}

extern "C" void kernel_launch(void* const* d_in, const int* in_sizes, int n_in, void* d_out, int out_size, void* d_ws, size_t ws_size, hipStream_t stream) {
    static int grid = 0;
    if (grid == 0) {
        if (n_in != 24 || out_size != S * D || ws_size < WS_END) { fprintf(stderr, "kernel_launch: unexpected problem (n_in %d, out %d, ws %zu)\n", n_in, out_size, ws_size); grid = -1; return; }
        if (hipFuncSetAttribute((const void*)skel_fwd, hipFuncAttributeMaxDynamicSharedMemorySize, LDS_BYTES) != hipSuccess) { fprintf(stderr, "kernel_launch: hipFuncSetAttribute failed\n"); grid = -1; return; }
        int dev = 0, cus = 0;
        if (hipGetDevice(&dev) != hipSuccess || hipDeviceGetAttribute(&cus, hipDeviceAttributeMultiprocessorCount, dev) != hipSuccess) { grid = -1; return; }
        (void)hipGetLastError();
        grid = 256;
        if (cus != 256) fprintf(stderr, "kernel_launch: device reports %d CUs; this kernel is built for 256\n", cus);
    }
    if (grid < 0) return;
    if (hipMemsetAsync((char*)d_ws + WS_CTL, 0, CTL_ZERO_BYTES, stream) != hipSuccess) return;
    Args a{};
    for (int i = 0; i < 24; ++i) a.in[i] = (const float*)d_in[i];
    a.out = (float*)d_out; a.ws = (unsigned char*)d_ws;
    if (N_LAUNCHES == 1) {
        a.ph_lo = 0; a.ph_hi = N_PHASES; a.li = 0;
        hipLaunchKernelGGL(skel_fwd, dim3(grid), dim3(NWAVES * 64), LDS_BYTES, stream, a);
    } else {
        for (int p = 0; p < N_PHASES; ++p) { a.ph_lo = p; a.ph_hi = p + 1; a.li = p; hipLaunchKernelGGL(skel_fwd, dim3(grid), dim3(NWAVES * 64), LDS_BYTES, stream, a); }
    }
}
```

```cpp
#include <hip/hip_runtime.h>
#include <cstdio>
#include <cstdint>
#include <cmath>
#define MK_N_LAUNCHES 1
namespace pg8 {
#define PG8_LAS __attribute__((address_space(3)))
typedef unsigned short bf16_t;
typedef short bf16x8 __attribute__((ext_vector_type(8)));
typedef float f32x4 __attribute__((ext_vector_type(4)));
typedef unsigned u32x4 __attribute__((ext_vector_type(4)));
constexpr int BM = 256, BK = 64, HALF = 128, HTB = HALF * BK * 2  , STAGE_BYTES = 8 * HTB, NXCD = 8, WGM = 8;

__host__ __device__ __forceinline__ int lds_byte(int r, int c) { const int st = (r >> 4) * 2 + (c >> 5), rr = r & 15, cc = c & 31, ob = rr * 64 + cc * 2; return st * 1024 + (ob ^ (((ob >> 9) & 1) << 5)); }
__host__ __device__ __forceinline__ void stage_rc(int b, int& R, int& C) { const int st = b / 1024, sb = b % 1024, swz = sb ^ (((sb >> 9) & 1) << 5); R = (st >> 1) * 16 + swz / 64; C = (st & 1) * 32 + (swz % 64) / 2; }
__host__ __device__ __forceinline__ int perm32(int rho) { const int n = rho >> 4, i = rho & 15; return 8 * (i >> 2) + 4 * n + (i & 3); }

struct Unit { int pm, pn, seg; };
struct Gemm { const bf16_t* A; const bf16_t* Bt; int M, N, K; const bf16_t* A2 = nullptr; const bf16_t* Bt2 = nullptr; };

struct StaticOrder {
    int nM, nN, nwg, G, c;
    __host__ __device__ __forceinline__ void init(int M, int N, int G_, int c_) { nM = M / BM; nN = N / BM; nwg = nM * nN; G = G_; c = c_; }
    __host__ __device__ __forceinline__ bool next(int i, Unit& u) const {
        const long L = (long)i * G + c; if (L >= nwg) return false;
        int wgid = (int)L; { const int q = nwg / NXCD, r = nwg % NXCD, xcd = wgid % NXCD, off = wgid / NXCD; wgid = (xcd < r ? xcd * (q + 1) : r * (q + 1) + (xcd - r) * q) + off; }
        const int nig = WGM * nN, gid = wgid / nig, fm = gid * WGM, gsz = (nM - fm) < WGM ? (nM - fm) : WGM;
        u.pm = fm + ((wgid % nig) % gsz); u.pn = (wgid % nig) / gsz; u.seg = 0; return true;
    }
    __device__ __forceinline__ void a_ready(const Unit&) const {}
    __device__ __forceinline__ void done(const Unit&) const {}
};
struct PairOrder {
    StaticOrder base;
    __host__ __device__ __forceinline__ void init(int M, int N, int G_, int c_) { base.init(M, N, G_, c_); }
    __host__ __device__ __forceinline__ bool next(int i, Unit& u) const { if (!base.next(i >> 1, u)) return false; u.seg = i & 1; return true; }
    __device__ __forceinline__ void a_ready(const Unit&) const {}
    __device__ __forceinline__ void done(const Unit&) const {}
};
typedef float f32x2 __attribute__((ext_vector_type(2)));
typedef __bf16 bf16x2_t __attribute__((ext_vector_type(2)));
__device__ __forceinline__ unsigned cvt_pk_bf16(float lo, float hi) { const f32x2 v = {lo, hi}; const bf16x2_t b = __builtin_convertvector(v, bf16x2_t); return __builtin_bit_cast(unsigned, b); }
__device__ __forceinline__ float fast_sigmoid(float x) { return __builtin_amdgcn_rcpf(1.0f + __builtin_amdgcn_exp2f(-1.4426950408889634f * x)); }
__device__ __forceinline__ float fast_gelu_tanh(float x) { const float u2 = 1.5957691216057308f * (x + 0.044715f * x * x * x); return x * fast_sigmoid(u2); }
__device__ __forceinline__ void store8_bf16(bf16_t* p, const f32x4& v0, const f32x4& v1) {
    u32x4 w; w.x = cvt_pk_bf16(v0[0], v0[1]); w.y = cvt_pk_bf16(v0[2], v0[3]); w.z = cvt_pk_bf16(v1[0], v1[1]); w.w = cvt_pk_bf16(v1[2], v1[3]); *(u32x4*)p = w;
}
__device__ __forceinline__ float bf_lo(unsigned w) { return __builtin_bit_cast(float, w << 16); }
__device__ __forceinline__ float bf_hi(unsigned w) { return __builtin_bit_cast(float, w & 0xffff0000u); }
__device__ __forceinline__ void rope4(f32x4& v0, f32x4& v1, const f32x4 c, const f32x4 s) {
    const float a0 = v0[0], b0 = v0[1], a1 = v0[2], b1 = v0[3], a2 = v1[0], b2 = v1[1], a3 = v1[2], b3 = v1[3];
    v0[0] = a0 * c[0] - b0 * s[0]; v0[1] = b0 * c[0] + a0 * s[0]; v0[2] = a1 * c[1] - b1 * s[1]; v0[3] = b1 * c[1] + a1 * s[1];
    v1[0] = a2 * c[2] - b2 * s[2]; v1[1] = b2 * c[2] + a2 * s[2]; v1[2] = a3 * c[3] - b3 * s[3]; v1[3] = b3 * c[3] + a3 * s[3];
}
struct EpiProj {
    static constexpr bool PERM = true, AFTER_DRAIN = false;
    bf16_t *U, *Vg, *QLAT, *Kb, *Vb, *GATE, *SMALL; float* stats; float* stats2; const float* cosA; const float* sinA;
    __device__ __forceinline__ void operator()(const f32x4 (&acc)[2][2][4][2], const Unit& u, int wr, int wc, int fr, int fq) const {
        const int pn = u.pn; int mode, ld, c0; bf16_t* dst;
        if (pn < 4) { mode = 1; dst = U; ld = 1024; c0 = pn * 256; }
        else if (pn < 8) { mode = 2; dst = Vg; ld = 1024; c0 = (pn - 4) * 256; }
        else if (pn < 10) { mode = 5; dst = QLAT; ld = 512; c0 = (pn - 8) * 256; }
        else if (pn < 14) { mode = 3; dst = Kb; ld = 1024; c0 = (pn - 10) * 256; }
        else if (pn < 18) { mode = 0; dst = Vb; ld = 1024; c0 = (pn - 14) * 256; }
        else if (pn < 34) { mode = 4; dst = GATE; ld = 4096; c0 = (pn - 18) * 128; }
        else { mode = 0; dst = SMALL; ld = 256; c0 = 0; }
        const int row0 = u.pm * BM + wr * 64 + fr, cl = wc * 32 + 8 * fq;
#pragma unroll
        for (int ai = 0; ai < 2; ++ai)
#pragma unroll
            for (int m = 0; m < 4; ++m) {
                const int row = row0 + ai * HALF + m * 16;
                f32x4 v[2][2];
#pragma unroll
                for (int bj = 0; bj < 2; ++bj) { v[bj][0] = acc[ai][bj][m][0]; v[bj][1] = acc[ai][bj][m][1]; }
                if (mode == 1 || mode == 2) {
#pragma unroll
                    for (int bj = 0; bj < 2; ++bj)
#pragma unroll
                        for (int n = 0; n < 2; ++n)
#pragma unroll
                            for (int e = 0; e < 4; ++e) v[bj][n][e] = fast_gelu_tanh(v[bj][n][e]);
                    if (mode == 2) {
                        float s = 0.f, q = 0.f;
#pragma unroll
                        for (int bj = 0; bj < 2; ++bj)
#pragma unroll
                            for (int n = 0; n < 2; ++n)
#pragma unroll
                                for (int e = 0; e < 4; ++e) { s += v[bj][n][e]; q += v[bj][n][e] * v[bj][n][e]; }
                        s += __shfl_xor(s, 16); s += __shfl_xor(s, 32); q += __shfl_xor(q, 16); q += __shfl_xor(q, 32);
                        if (fq == 0) { f32x2 o; o.x = s; o.y = q; *(f32x2*)(stats + ((size_t)row * 16 + (pn - 4) * 4 + wc) * 2) = o; }
                    }
                } else if (mode == 5) {
                    float q = 0.f;
#pragma unroll
                    for (int bj = 0; bj < 2; ++bj)
#pragma unroll
                        for (int n = 0; n < 2; ++n)
#pragma unroll
                            for (int e = 0; e < 4; ++e) q += v[bj][n][e] * v[bj][n][e];
                    q += __shfl_xor(q, 16); q += __shfl_xor(q, 32);
                    if (fq == 0) stats2[(size_t)row * 8 + (pn - 8) * 4 + wc] = q;
                } else if (mode == 3) {
                    const f32x4 c = *(const f32x4*)(cosA + (size_t)row * 64 + 16 * wc + 4 * fq), s = *(const f32x4*)(sinA + (size_t)row * 64 + 16 * wc + 4 * fq);
                    rope4(v[0][0], v[0][1], c, s); rope4(v[1][0], v[1][1], c, s);
                } else if (mode == 4) {
#pragma unroll
                    for (int n = 0; n < 2; ++n)
#pragma unroll
                        for (int e = 0; e < 4; ++e) { const float ea = __builtin_amdgcn_exp2f(-1.4426950408889634f * v[0][n][e]), eb = __builtin_amdgcn_exp2f(-1.4426950408889634f * v[1][n][e]);
                            v[0][n][e] = (1.0f + eb) * __builtin_amdgcn_rcpf(1.0f + ea); v[1][n][e] = __builtin_amdgcn_rcpf(1.0f + eb); }
                }
                bf16_t* rowp = dst + (size_t)row * ld + c0 + cl;
                store8_bf16(rowp, v[0][0], v[0][1]); store8_bf16(rowp + (mode == 4 ? 2048 : HALF), v[1][0], v[1][1]);
            }
    }
};
struct EpiQ {
    static constexpr bool PERM = true, AFTER_DRAIN = false;
    bf16_t *Q, *QIDX; const PG8_LAS float* rt; const float *cosA, *sinA, *cosI, *sinI; float qscale;
    __device__ __forceinline__ void operator()(const f32x4 (&acc)[2][2][4][2], const Unit& u, int wr, int wc, int fr, int fq) const {
        const int pn = u.pn; const bool isq = pn < 4;
        bf16_t* dst = isq ? Q : QIDX; const int c0 = (isq ? pn : pn - 4) * 256 + wc * 32 + 8 * fq;
#pragma unroll
        for (int ai = 0; ai < 2; ++ai)
#pragma unroll
            for (int m = 0; m < 4; ++m) {
                const int lrow = ai * HALF + wr * 64 + m * 16 + fr, row = u.pm * BM + lrow;
                const float sc = rt[lrow] * (isq ? qscale : 1.0f);
                f32x4 v[2][2];
#pragma unroll
                for (int bj = 0; bj < 2; ++bj) { v[bj][0] = acc[ai][bj][m][0] * sc; v[bj][1] = acc[ai][bj][m][1] * sc; }
                if (isq) {
                    const f32x4 c = *(const f32x4*)(cosA + (size_t)row * 64 + 16 * wc + 4 * fq), s = *(const f32x4*)(sinA + (size_t)row * 64 + 16 * wc + 4 * fq);
                    rope4(v[0][0], v[0][1], c, s); rope4(v[1][0], v[1][1], c, s);
                } else if ((wc & 1) == 0) {
                    const f32x4 c = *(const f32x4*)(cosI + (size_t)row * 16 + 4 * fq), s = *(const f32x4*)(sinI + (size_t)row * 16 + 4 * fq);
                    rope4(v[0][0], v[0][1], c, s); rope4(v[1][0], v[1][1], c, s);
                }
                bf16_t* rowp = dst + (size_t)row * 1024 + c0;
                store8_bf16(rowp, v[0][0], v[0][1]); store8_bf16(rowp + HALF, v[1][0], v[1][1]);
            }
    }
};
struct EpiGate2 {
    static constexpr bool PERM = true, AFTER_DRAIN = false;
    const bf16_t* GATE; bf16_t* MERGED;
    __device__ __forceinline__ void operator()(f32x4 (&acc)[2][2][4][2], const Unit& u, int wr, int wc, int fr, int fq) const {
        const int row0 = u.pm * BM + wr * 64 + fr, col0 = u.pn * BM + wc * 32 + 8 * fq;
#pragma unroll
        for (int ai = 0; ai < 2; ++ai)
#pragma unroll
            for (int m = 0; m < 4; ++m) {
                const int row = row0 + ai * HALF + m * 16;
#pragma unroll
                for (int bj = 0; bj < 2; ++bj) {
                    const int col = col0 + bj * HALF;
                    const u32x4 g = *(const u32x4*)(GATE + (size_t)row * 4096 + (u.seg == 0 ? 0 : 2048) + col);
                    const f32x4 g0 = {bf_lo(g.x), bf_hi(g.x), bf_lo(g.y), bf_hi(g.y)}, g1 = {bf_lo(g.z), bf_hi(g.z), bf_lo(g.w), bf_hi(g.w)};
                    if (u.seg == 0) { acc[ai][bj][m][0] = acc[ai][bj][m][0] * g0; acc[ai][bj][m][1] = acc[ai][bj][m][1] * g1; }
                    else store8_bf16(MERGED + (size_t)row * 2048 + col, acc[ai][bj][m][0] * g0, acc[ai][bj][m][1] * g1);
                }
            }
    }
};
struct EpiOutBf16 {
    static constexpr bool PERM = true, AFTER_DRAIN = false;
    bf16_t* O;
    __device__ __forceinline__ void operator()(const f32x4 (&acc)[2][2][4][2], const Unit& u, int wr, int wc, int fr, int fq) const {
        const int row0 = u.pm * BM + wr * 64 + fr, col0 = u.pn * BM + wc * 32 + 8 * fq;
#pragma unroll
        for (int ai = 0; ai < 2; ++ai)
#pragma unroll
            for (int m = 0; m < 4; ++m)
#pragma unroll
                for (int bj = 0; bj < 2; ++bj) store8_bf16(O + (size_t)(row0 + ai * HALF + m * 16) * 2048 + col0 + bj * HALF, acc[ai][bj][m][0], acc[ai][bj][m][1]);
    }
};
struct EpiSwiGLU {
    static constexpr bool PERM = true, AFTER_DRAIN = false;
    bf16_t* ACT; int ld;
    __device__ __forceinline__ void operator()(const f32x4 (&acc)[2][2][4][2], const Unit& u, int wr, int wc, int fr, int fq) const {
        const int row0 = u.pm * BM + wr * 64 + fr, col0 = u.pn * HALF + wc * 32 + 8 * fq;
#pragma unroll
        for (int ai = 0; ai < 2; ++ai)
#pragma unroll
            for (int m = 0; m < 4; ++m) {
                f32x4 o[2];
#pragma unroll
                for (int n = 0; n < 2; ++n)
#pragma unroll
                    for (int e = 0; e < 4; ++e) { const float g = acc[ai][0][m][n][e]; o[n][e] = g * fast_sigmoid(g) * acc[ai][1][m][n][e]; }
                store8_bf16(ACT + (size_t)(row0 + ai * HALF + m * 16) * ld + col0, o[0], o[1]);
            }
    }
};

struct RowSq {
    float* xbuf;
    unsigned* cnt;
    unsigned* tmo;
    float eps;
    __device__ __forceinline__ void run(const f32x4 (&v)[2][2][4][2], const Unit& u, int wr, int wc, int fr, int fq, PG8_LAS unsigned char* lds, int wid, int lane) const {
        PG8_LAS float* P = (PG8_LAS float*)lds;
        PG8_LAS float* S = (PG8_LAS float*)(lds + 4096);
#pragma unroll
        for (int ai = 0; ai < 2; ++ai)
#pragma unroll
            for (int m = 0; m < 4; ++m) {
                float q = 0.f;
#pragma unroll
                for (int bj = 0; bj < 2; ++bj)
#pragma unroll
                    for (int n = 0; n < 2; ++n) { const f32x4 x = v[ai][bj][m][n]; q += (x[0] * x[0] + x[1] * x[1]) + (x[2] * x[2] + x[3] * x[3]); }
                q += __shfl_xor(q, 16); q += __shfl_xor(q, 32);
                if (fq == 0) P[(ai * HALF + wr * 64 + m * 16 + fr) * 4 + wc] = q;
            }
        asm volatile("s_waitcnt lgkmcnt(0)" ::: "memory"); __builtin_amdgcn_s_barrier(); asm volatile("" ::: "memory");
        const int row = wid * 32 + (lane & 31);
        if (lane < 32) {
            const f32x4 p4 = *(const PG8_LAS f32x4*)(P + row * 4);
            __hip_atomic_store(xbuf + (size_t)(u.pm * BM + row) * 8 + u.pn, (p4[0] + p4[1]) + (p4[2] + p4[3]), __ATOMIC_RELAXED, __HIP_MEMORY_SCOPE_AGENT);
        }
        asm volatile("s_waitcnt vmcnt(0)" ::: "memory");
        if (lane == 0) __hip_atomic_fetch_add(cnt + 64 * u.pm, 1u, __ATOMIC_RELAXED, __HIP_MEMORY_SCOPE_AGENT);
        if (wid == 0) {
            unsigned sp = 0u;
            while ((unsigned)__builtin_amdgcn_readfirstlane(__hip_atomic_load(cnt + 64 * u.pm, __ATOMIC_RELAXED, __HIP_MEMORY_SCOPE_AGENT)) < 64u) {
                __builtin_amdgcn_s_sleep(2);
                if ((++sp & 1023u) == 0u) { if (__hip_atomic_load(tmo, __ATOMIC_RELAXED, __HIP_MEMORY_SCOPE_AGENT)) break; if (sp > (1u << 22)) { if (lane == 0) __hip_atomic_store(tmo, 1u, __ATOMIC_RELAXED, __HIP_MEMORY_SCOPE_AGENT); break; } }
            }
            __builtin_amdgcn_fence(__ATOMIC_ACQUIRE, "agent");
        }
        asm volatile("s_waitcnt vmcnt(0) lgkmcnt(0)" ::: "memory"); __builtin_amdgcn_s_barrier(); asm volatile("" ::: "memory");
        if (lane < 32) {
            const float* slot = xbuf + (size_t)(u.pm * BM + row) * 8; float q = 0.f;
#pragma unroll
            for (int t = 0; t < 8; ++t) q += __hip_atomic_load(slot + t, __ATOMIC_RELAXED, __HIP_MEMORY_SCOPE_AGENT);
            S[row] = 1.0f / sqrtf(q * (1.0f / 2048.0f) + eps);
        }
        asm volatile("s_waitcnt lgkmcnt(0)" ::: "memory"); __builtin_amdgcn_s_barrier(); asm volatile("" ::: "memory");
    }
};
struct EpiMixNorm {
    static constexpr bool PERM = true, AFTER_DRAIN = true;
    const float* x; bf16_t* X1; bf16_t* H2; const float *gate_m, *gpost, *g2, *sc_f, *sh_f; RowSq st1, st2;
    __device__ __forceinline__ void fused(f32x4 (&acc)[2][2][4][2], const Unit& u, int wr, int wc, int fr, int fq, PG8_LAS unsigned char* lds, int wid, int lane) const {
        const PG8_LAS float* S = (const PG8_LAS float*)(lds + 4096);
        const int col0 = u.pn * BM + wc * 32 + 8 * fq;
        f32x4 xr[4][2][2];
#define EPI_LOADX(ai_, m_) do { const size_t off_ = (size_t)(u.pm * BM + (ai_) * HALF + wr * 64 + (m_) * 16 + fr) * 2048 + col0; \
            _Pragma("unroll") for (int bj = 0; bj < 2; ++bj) _Pragma("unroll") for (int n = 0; n < 2; ++n) xr[m_][bj][n] = *(const f32x4*)(x + off_ + bj * HALF + 4 * n); } while (0)
#pragma unroll
        for (int m = 0; m < 4; ++m) EPI_LOADX(0, m);
        f32x4 pm[2][2];
#pragma unroll
        for (int bj = 0; bj < 2; ++bj)
#pragma unroll
            for (int n = 0; n < 2; ++n) { const int c = col0 + bj * HALF + 4 * n; pm[bj][n] = *(const f32x4*)(gate_m + c) * *(const f32x4*)(gpost + c); }
        st1.run(acc, u, wr, wc, fr, fq, lds, wid, lane);
#pragma unroll
        for (int ai = 0; ai < 2; ++ai)
#pragma unroll
            for (int m = 0; m < 4; ++m) { const float rr = S[ai * HALF + wr * 64 + m * 16 + fr];
#pragma unroll
                for (int bj = 0; bj < 2; ++bj)
#pragma unroll
                    for (int n = 0; n < 2; ++n) acc[ai][bj][m][n] = xr[m][bj][n] + acc[ai][bj][m][n] * rr * pm[bj][n];
                asm volatile("" : "+v"(acc[ai][0][m][0]), "+v"(acc[ai][0][m][1]), "+v"(acc[ai][1][m][0]), "+v"(acc[ai][1][m][1]));
                if (ai == 0) EPI_LOADX(1, m); }
#undef EPI_LOADX
        st2.run(acc, u, wr, wc, fr, fq, lds, wid, lane);
        {
            f32x4 pa[2][2], pb[2][2];
#pragma unroll
            for (int bj = 0; bj < 2; ++bj)
#pragma unroll
                for (int n = 0; n < 2; ++n) { const int c = col0 + bj * HALF + 4 * n; pa[bj][n] = *(const f32x4*)(g2 + c) * (*(const f32x4*)(sc_f + c) + 1.0f); pb[bj][n] = *(const f32x4*)(sh_f + c); }
#pragma unroll
            for (int ai = 0; ai < 2; ++ai)
#pragma unroll
                for (int m = 0; m < 4; ++m) { const int r = ai * HALF + wr * 64 + m * 16 + fr; const float r2 = S[r]; const size_t off = (size_t)(u.pm * BM + r) * 2048 + col0;
#pragma unroll
                    for (int bj = 0; bj < 2; ++bj) {
                        store8_bf16(X1 + off + bj * HALF, acc[ai][bj][m][0], acc[ai][bj][m][1]);
                        store8_bf16(H2 + off + bj * HALF, acc[ai][bj][m][0] * r2 * pa[bj][0] + pb[bj][0], acc[ai][bj][m][1] * r2 * pa[bj][1] + pb[bj][1]); } }
        }
    }
};
struct EpiFfnOut {
    static constexpr bool PERM = true, AFTER_DRAIN = true;
    const bf16_t* X1; float* out; const float *gate_f, *gpost; RowSq st;
    __device__ __forceinline__ void fused(f32x4 (&acc)[2][2][4][2], const Unit& u, int wr, int wc, int fr, int fq, PG8_LAS unsigned char* lds, int wid, int lane) const {
        const PG8_LAS float* S = (const PG8_LAS float*)(lds + 4096);
        const int col0 = u.pn * BM + wc * 32 + 8 * fq;
        u32x4 xr[2][4][2];
#pragma unroll
        for (int ai = 0; ai < 2; ++ai)
#pragma unroll
            for (int m = 0; m < 4; ++m) { const size_t off = (size_t)(u.pm * BM + ai * HALF + wr * 64 + m * 16 + fr) * 2048 + col0;
#pragma unroll
                for (int bj = 0; bj < 2; ++bj) xr[ai][m][bj] = *(const u32x4*)(X1 + off + bj * HALF); }
        f32x4 pf[2][2];
#pragma unroll
        for (int bj = 0; bj < 2; ++bj)
#pragma unroll
            for (int n = 0; n < 2; ++n) { const int c = col0 + bj * HALF + 4 * n; pf[bj][n] = *(const f32x4*)(gate_f + c) * *(const f32x4*)(gpost + c); }
        st.run(acc, u, wr, wc, fr, fq, lds, wid, lane);
#pragma unroll
        for (int ai = 0; ai < 2; ++ai)
#pragma unroll
            for (int m = 0; m < 4; ++m) { const int r = ai * HALF + wr * 64 + m * 16 + fr; const float rr = S[r]; const size_t off = (size_t)(u.pm * BM + r) * 2048 + col0;
#pragma unroll
                for (int bj = 0; bj < 2; ++bj) { const u32x4 w = xr[ai][m][bj];
                    const f32x4 x0 = {bf_lo(w.x), bf_hi(w.x), bf_lo(w.y), bf_hi(w.y)}, x1 = {bf_lo(w.z), bf_hi(w.z), bf_lo(w.w), bf_hi(w.w)};
                    *(f32x4*)(out + off + bj * HALF) = x0 + acc[ai][bj][m][0] * rr * pf[bj][0]; *(f32x4*)(out + off + bj * HALF + 4) = x1 + acc[ai][bj][m][1] * rr * pf[bj][1]; } }
    }
};
template <class Epi, class Sched, bool ALIGN_EPI = false, bool SP2 = false>
__device__ __forceinline__ void gemm_phase(PG8_LAS unsigned char* lds, const Gemm g, const Sched& S, const Epi& E) {
    const int tid = threadIdx.x, wid = __builtin_amdgcn_readfirstlane(tid >> 6), lane = tid & 63, wr = wid >> 2, wc = wid & 3, fr = lane & 15, fq = lane >> 4;
    const int K = g.K, nt = K / BK;
    unsigned voffA[2], voffB[2];
#pragma unroll
    for (int i = 0; i < 2; ++i) { int R, C; stage_rc(tid * 16 + i * 8192, R, C); const int Rb = Epi::PERM ? ((R & ~31) + perm32(R & 31)) : R;
        voffA[i] = (unsigned)(R * K + C) * 2u; voffB[i] = (unsigned)(Rb * K + C) * 2u; }
    const size_t kstep = (size_t)(BK * 2);
    const size_t hstep = (size_t)HALF * K * 2;
    const size_t tstep = 2 * hstep;
    const unsigned ldsw = (unsigned)wid * 1024u;
    const int aoff = lds_byte(wr * 64 + fr, fq * 8), boff = lds_byte(wc * 32 + fr, fq * 8);
#define PG8_SA(b, h) (((b) * 2 + (h)) * HTB)
#define PG8_SB(b, h) ((4 + (b) * 2 + (h)) * HTB)
#define PG8_STAGE(bufoff, gbase, voff) do { _Pragma("unroll") for (int _i = 0; _i < 2; ++_i) \
        __builtin_amdgcn_global_load_lds((const unsigned*)((const char*)(gbase) + (voff)[_i]), (PG8_LAS unsigned*)(lds + (bufoff) + ldsw + _i * 8192), 16, 0, 0); } while (0)
#define PG8_LDA(dst, b, h) do { _Pragma("unroll") for (int m = 0; m < 4; ++m) _Pragma("unroll") for (int k = 0; k < 2; ++k) dst[m][k] = *(const PG8_LAS bf16x8*)(lds + PG8_SA(b, h) + aoff + m * 2048 + k * 1024); } while (0)
#define PG8_LDB(dst, b, h) do { _Pragma("unroll") for (int n = 0; n < 2; ++n) _Pragma("unroll") for (int k = 0; k < 2; ++k) dst[n][k] = *(const PG8_LAS bf16x8*)(lds + PG8_SB(b, h) + boff + n * 2048 + k * 1024); } while (0)
#define PG8_MMA(ai, bj, At, Bt) do { __builtin_amdgcn_s_setprio(1); _Pragma("unroll") for (int m = 0; m < 4; ++m) _Pragma("unroll") for (int n = 0; n < 2; ++n) _Pragma("unroll") for (int k = 0; k < 2; ++k) \
        acc[ai][bj][m][n] = __builtin_amdgcn_mfma_f32_16x16x32_bf16(Bt[n][k], At[m][k], acc[ai][bj][m][n], 0, 0, 0); __builtin_amdgcn_s_setprio(0); } while (0)
#define PG8_WAIT_V(n) asm volatile("s_waitcnt vmcnt(" #n ")" ::: "memory")
#define PG8_WAIT_L(n) asm volatile("s_waitcnt lgkmcnt(" #n ")" ::: "memory")
#define PG8_BAR __builtin_amdgcn_s_barrier()
#define PG8_SCHED __builtin_amdgcn_sched_barrier(0)
    Unit cur, nxt; int ui = 0;
    if (!S.next(0, cur)) return;
    f32x4 acc[2][2][4][2];
#pragma unroll
    for (int a = 0; a < 2; ++a)
#pragma unroll
        for (int b = 0; b < 2; ++b)
#pragma unroll
            for (int m = 0; m < 4; ++m)
#pragma unroll
                for (int n = 0; n < 2; ++n) acc[a][b][m][n] = (f32x4){0.f, 0.f, 0.f, 0.f};
    bf16x8 At[4][2], B0[2][2], B1[2][2];
    const char* cA = (const char*)(cur.seg ? g.A2 : g.A) + (size_t)cur.pm * tstep; const char* cB = (const char*)(cur.seg ? g.Bt2 : g.Bt) + (size_t)cur.pn * tstep;
    S.a_ready(cur);
    if constexpr (SP2) {
        PG8_STAGE(PG8_SB(0, 0), cB, voffB); PG8_STAGE(PG8_SB(0, 1), cB + hstep, voffB); PG8_STAGE(PG8_SA(0, 0), cA, voffA); PG8_STAGE(PG8_SA(0, 1), cA + hstep, voffA);
        if (wr == 1) PG8_BAR;
        PG8_WAIT_V(2); PG8_BAR;
        PG8_STAGE(PG8_SB(1, 0), cB + kstep, voffB); PG8_STAGE(PG8_SA(1, 0), cA + kstep, voffA); PG8_STAGE(PG8_SB(1, 1), cB + hstep + kstep, voffB);
        PG8_WAIT_V(6); PG8_BAR;
    } else {
        PG8_STAGE(PG8_SB(0, 0), cB, voffB); PG8_STAGE(PG8_SA(0, 0), cA, voffA); PG8_STAGE(PG8_SB(0, 1), cB + hstep, voffB); PG8_STAGE(PG8_SA(0, 1), cA + hstep, voffA);
        if (wr == 1) PG8_BAR;
        PG8_WAIT_V(4); PG8_BAR;
        PG8_STAGE(PG8_SB(1, 0), cB + kstep, voffB); PG8_STAGE(PG8_SA(1, 0), cA + kstep, voffA); PG8_STAGE(PG8_SB(1, 1), cB + hstep + kstep, voffB);
        PG8_WAIT_V(6); PG8_BAR;
    }
    for (;;) {
        const bool has_next = S.next(ui + 1, nxt);
        const char* nA = has_next ? (const char*)(nxt.seg ? g.A2 : g.A) + (size_t)nxt.pm * tstep : cA; const char* nB = has_next ? (const char*)(nxt.seg ? g.Bt2 : g.Bt) + (size_t)nxt.pn * tstep : cB;
        for (int t = 0; t < nt; t += 2) {
            const bool last = (t == nt - 2);
            const char* a1 = cA + (size_t)(t + 1) * kstep;
            const char* a2 = last ? nA : cA + (size_t)(t + 2) * kstep; const char* b2 = last ? nB : cB + (size_t)(t + 2) * kstep;
            const char* a3 = a2 + kstep; const char* b3 = b2 + kstep;
            if (last && has_next) S.a_ready(nxt);
            if constexpr (SP2) {
            PG8_LDB(B0, 0, 0); PG8_LDB(B1, 0, 1); PG8_SCHED; PG8_LDA(At, 0, 0); PG8_STAGE(PG8_SA(1, 1), a1 + hstep, voffA);
            PG8_WAIT_V(8); PG8_WAIT_L(0); PG8_BAR; PG8_MMA(0, 0, At, B0); PG8_MMA(0, 1, At, B1); PG8_BAR; PG8_SCHED;
            PG8_LDA(At, 0, 1); PG8_STAGE(PG8_SB(0, 0), b2, voffB); PG8_STAGE(PG8_SB(0, 1), b2 + hstep, voffB); PG8_STAGE(PG8_SA(0, 0), a2, voffA);
            PG8_WAIT_V(8); PG8_WAIT_L(0); PG8_BAR; PG8_MMA(1, 0, At, B0); PG8_MMA(1, 1, At, B1); PG8_BAR; PG8_SCHED;
            PG8_LDB(B0, 1, 0); PG8_LDB(B1, 1, 1); PG8_SCHED; PG8_LDA(At, 1, 0); PG8_STAGE(PG8_SA(0, 1), a2 + hstep, voffA);
            PG8_WAIT_V(8); PG8_WAIT_L(0); PG8_BAR; PG8_MMA(0, 0, At, B0); PG8_MMA(0, 1, At, B1); PG8_BAR; PG8_SCHED;
            PG8_LDA(At, 1, 1); PG8_STAGE(PG8_SB(1, 0), b3, voffB); PG8_STAGE(PG8_SB(1, 1), b3 + hstep, voffB); PG8_STAGE(PG8_SA(1, 0), a3, voffA);
            PG8_WAIT_V(8); PG8_WAIT_L(0); PG8_BAR; PG8_MMA(1, 0, At, B0); PG8_MMA(1, 1, At, B1); PG8_BAR; PG8_SCHED;
            } else {
            PG8_LDB(B0, 0, 0); PG8_SCHED; PG8_LDA(At, 0, 0); PG8_STAGE(PG8_SA(1, 1), a1 + hstep, voffA);
            PG8_WAIT_L(8); PG8_BAR; PG8_WAIT_L(0); PG8_MMA(0, 0, At, B0); PG8_BAR; PG8_SCHED;
            PG8_LDB(B1, 0, 1); PG8_STAGE(PG8_SB(0, 0), b2, voffB);
            PG8_BAR; PG8_WAIT_L(0); PG8_MMA(0, 1, At, B1); PG8_BAR;
            PG8_LDA(At, 0, 1); PG8_STAGE(PG8_SA(0, 0), a2, voffA);
            PG8_BAR; PG8_WAIT_L(0); PG8_MMA(1, 0, At, B0); PG8_BAR; PG8_SCHED;
            PG8_STAGE(PG8_SB(0, 1), b2 + hstep, voffB);
            PG8_WAIT_V(6); PG8_BAR; PG8_MMA(1, 1, At, B1); PG8_BAR;
            PG8_LDB(B0, 1, 0); PG8_SCHED; PG8_LDA(At, 1, 0); PG8_STAGE(PG8_SA(0, 1), a2 + hstep, voffA);
            PG8_WAIT_L(8); PG8_BAR; PG8_WAIT_L(0); PG8_MMA(0, 0, At, B0); PG8_BAR; PG8_SCHED;
            PG8_LDB(B1, 1, 1); PG8_STAGE(PG8_SB(1, 0), b3, voffB);
            PG8_BAR; PG8_WAIT_L(0); PG8_MMA(0, 1, At, B1); PG8_BAR;
            PG8_LDA(At, 1, 1); PG8_STAGE(PG8_SA(1, 0), a3, voffA);
            PG8_BAR; PG8_WAIT_L(0); PG8_MMA(1, 0, At, B0); PG8_BAR; PG8_SCHED;
            PG8_STAGE(PG8_SB(1, 1), b3 + hstep, voffB);
            PG8_WAIT_V(6); PG8_BAR; PG8_MMA(1, 1, At, B1); PG8_BAR;
            }
        }
        if constexpr (ALIGN_EPI) { if (wr == 0) PG8_BAR; }
        if constexpr (!Epi::AFTER_DRAIN) { E(acc, cur, wr, wc, fr, fq); S.done(cur); }
        if (!has_next) break;
        if (nxt.seg == 0)
#pragma unroll
        for (int a = 0; a < 2; ++a)
#pragma unroll
            for (int b = 0; b < 2; ++b)
#pragma unroll
                for (int m = 0; m < 4; ++m)
#pragma unroll
                    for (int n = 0; n < 2; ++n) acc[a][b][m][n] = (f32x4){0.f, 0.f, 0.f, 0.f};
        cur = nxt; cA = nA; cB = nB; ++ui;
        if constexpr (ALIGN_EPI) { if (wr == 1) PG8_BAR; }
    }
    PG8_WAIT_V(0);
    if constexpr (!ALIGN_EPI) { if (wr == 0) PG8_BAR; }
    PG8_BAR;
    if constexpr (Epi::AFTER_DRAIN) { E.fused(acc, cur, wr, wc, fr, fq, lds, wid, lane); S.done(cur); }
#undef PG8_SA
#undef PG8_SB
#undef PG8_STAGE
#undef PG8_LDA
#undef PG8_LDB
#undef PG8_MMA
#undef PG8_WAIT_V
#undef PG8_WAIT_L
#undef PG8_BAR
#undef PG8_SCHED
}
}
#define GAS __attribute__((address_space(1)))
#define LAS __attribute__((address_space(3)))
typedef unsigned short bf16;
typedef unsigned v4u __attribute__((ext_vector_type(4)));
typedef float f32x4 __attribute__((ext_vector_type(4)));
typedef short bf16x8 __attribute__((ext_vector_type(8)));
typedef GAS unsigned gu32;
typedef GAS unsigned long long gu64;
#define RLX_AGENT __ATOMIC_RELAXED, __HIP_MEMORY_SCOPE_AGENT
#define LDS_WAIT() asm volatile("s_waitcnt lgkmcnt(0)" ::: "memory")
#define VM_WAIT() asm volatile("s_waitcnt vmcnt(0)" ::: "memory")
__device__ __forceinline__ unsigned long long rt() { return __builtin_amdgcn_s_memrealtime(); }
__device__ __forceinline__ unsigned f2bf(float f) { unsigned u = __builtin_bit_cast(unsigned, f); return (u + 0x7fffu + ((u >> 16) & 1u)) >> 16; }
__device__ __forceinline__ unsigned pk2(float lo, float hi) { return f2bf(lo) | (f2bf(hi) << 16); }
#define XB_TMO      128
#define XB_XCNT(j)  (256  + 64 * (j))
#define XB_XSUB(j)  (1280 + 64 * (j))
#define XB_XGEN(j)  (2304 + 64 * (j))
#define XB_TOP      3328
#define XB_TOPGEN   3392
#define XCD_BAR_WORDS 3456
#define XB_SPIN_CAP (1u << 18)

__device__ __forceinline__ unsigned xb_ld(unsigned* p)              { return __hip_atomic_load(p, __ATOMIC_RELAXED, __HIP_MEMORY_SCOPE_AGENT); }
__device__ __forceinline__ unsigned xb_add(unsigned* p, unsigned v) { return __hip_atomic_fetch_add(p, v, __ATOMIC_RELAXED, __HIP_MEMORY_SCOPE_AGENT); }
__device__ __forceinline__ unsigned xb_xcc_id() { return (unsigned)__builtin_amdgcn_s_getreg((3 << 11) | 20) & 0xFu; }
#define XB_SPIN(cond, bar) do { unsigned _sp = 0; while (cond) { __builtin_amdgcn_s_sleep(1); \
    if ((++_sp & 255u) == 0u) { if (xb_ld(&(bar)[XB_TMO])) break; if (_sp > XB_SPIN_CAP) { atomicAdd(&(bar)[XB_TMO], 1u); break; } } } } while (0)

struct XcdBarrier {
    unsigned* bar; unsigned x;
    volatile LAS unsigned* st;
};

__device__ __forceinline__ XcdBarrier xcd_barrier_post(unsigned* bar, volatile LAS unsigned* st) {
    XcdBarrier b; b.bar = bar; b.x = xb_xcc_id(); b.st = st;
    if (threadIdx.x == 0) (void)xb_add(&bar[XB_XCNT(b.x)], 1u);
    return b;
}
__device__ __forceinline__ void xcd_barrier_complete(unsigned* bar, unsigned x, unsigned& nloc, unsigned& nx) {
    const unsigned G = gridDim.x * gridDim.y * gridDim.z;
    unsigned sum, cnt, mine, sp = 0u;
    for (;;) {
        sum = 0u; cnt = 0u; mine = 0u;
#pragma unroll
        for (unsigned j = 0; j < 16; ++j) { const unsigned c = xb_ld(&bar[XB_XCNT(j)]); sum += c; cnt += (c > 0u) ? 1u : 0u; mine = (j == x) ? c : mine; }
        if (sum == G) break;
        __builtin_amdgcn_s_sleep(1);
        if ((++sp & 255u) == 0u) { if (xb_ld(&bar[XB_TMO])) break; if (sp > XB_SPIN_CAP) { atomicAdd(&bar[XB_TMO], 1u); break; } }
    }
    nloc = mine > 0u ? mine : 1u; nx = cnt > 0u ? cnt : 1u;
}

__device__ __forceinline__ void xcd_barrier(const XcdBarrier& b) {
    asm volatile("s_waitcnt vmcnt(0)" ::: "memory");
    __syncthreads();
    if (threadIdx.x == 0) {
        unsigned* bar = b.bar;
        __builtin_amdgcn_s_waitcnt(0);
        unsigned nloc = b.st[0], nx = b.st[1];
        if (nloc == 0u) { xcd_barrier_complete(bar, b.x, nloc, nx); b.st[0] = nloc; b.st[1] = nx; }
        const unsigned old = xb_add(&bar[XB_XSUB(b.x)], 1u);
        const unsigned gen = old / nloc;
        if (old + 1u == (gen + 1u) * nloc) {
            __builtin_amdgcn_fence(__ATOMIC_RELEASE, "agent");
            asm volatile("s_waitcnt vmcnt(0)" ::: "memory");
            const unsigned og = xb_add(&bar[XB_TOP], 1u);
            const unsigned tg = og / nx;
            if (og + 1u == (tg + 1u) * nx) xb_add(&bar[XB_TOPGEN], 1u);
            else XB_SPIN(xb_ld(&bar[XB_TOPGEN]) == tg, bar);
            __builtin_amdgcn_fence(__ATOMIC_ACQUIRE, "agent");
            xb_add(&bar[XB_XGEN(b.x)], 1u);
            asm volatile("s_waitcnt vmcnt(0)" ::: "memory");
        } else {
            XB_SPIN(xb_ld(&bar[XB_XGEN(b.x)]) == gen, bar);
            __builtin_amdgcn_fence(__ATOMIC_ACQUIRE, "agent");
            asm volatile("s_waitcnt vmcnt(0)" ::: "memory");
        }
    }
    __syncthreads();
}
constexpr int NWAVES = 8;
#ifndef MK_N_LAUNCHES
#define MK_N_LAUNCHES 1
#endif
constexpr int N_PHASES = 13;
constexpr int N_LAUNCHES = MK_N_LAUNCHES;

constexpr int S = 8192, D = 2048, GW = 1024, QL = 512, AW = 1024, FF = 5632;
constexpr int NPROJ = 8960;
constexpr int SRC_INC = 8784;
constexpr float NORM_EPS = 1e-6f;
constexpr float QSCALE = 0.08838834764831845f * 1.4426950408889634f;

constexpr size_t MiB = 1u << 20;
constexpr size_t WS_CTL = 0, CTL_ZERO_BYTES = 128 * 1024;
constexpr size_t WS_WSUM = 1 * MiB + 64 * 1024;
constexpr size_t WS_MOD = 1 * MiB, WS_COSA = 2 * MiB, WS_SINA = 4 * MiB, WS_COSI = 6 * MiB, WS_SINI = 6 * MiB + 512 * 1024, WS_STATS = 7 * MiB, WS_IDXW = 8 * MiB, WS_KIDX = 8 * MiB + 512 * 1024, WS_WM = 9 * MiB + 512 * 1024, WS_STATS2 = 9 * MiB + 768 * 1024;
constexpr size_t WS_WIN = 10 * MiB, WS_WQQ = 45 * MiB, WS_WPA = 47 * MiB, WS_WPB = 51 * MiB, WS_WOUT = 55 * MiB, WS_WGU = 63 * MiB, WS_WDOWN = 107 * MiB;
constexpr size_t WS_H = 129 * MiB;
constexpr size_t WS_U = 161 * MiB, WS_VG = 177 * MiB, WS_QLAT = 193 * MiB, WS_K = 201 * MiB, WS_V = 217 * MiB, WS_GATE = 233 * MiB, WS_SMALL = 297 * MiB;
constexpr size_t WS_ACT = 161 * MiB;
constexpr size_t WS_Q = 301 * MiB, WS_QIDX = 317 * MiB, WS_YB = 341 * MiB;
constexpr size_t WS_MASKB0 = WS_H, WS_MASKB1 = WS_WIN + 2 * MiB;
constexpr size_t WS_X1 = 249 * MiB;
constexpr size_t WS_XCH = 44 * MiB;
constexpr size_t WS_F2 = 333 * MiB;
constexpr size_t WS_F = 301 * MiB;
constexpr size_t WS_END = 365 * MiB;
static_assert(WS_WIN + (size_t)NPROJ * D * 2 <= WS_WQQ && WS_WGU + (size_t)2 * FF * D * 2 <= WS_WDOWN && WS_WDOWN + (size_t)D * FF * 2 <= WS_H && WS_ACT + (size_t)S * FF * 2 <= WS_Q, "d_ws map");
constexpr int CW_MASKCNT = 14336;
constexpr int CW_YBCNT = 1024;
constexpr int CW_MODCNT = 2048;
constexpr int CW_TMO = 0, CW_CODE = 1, CW_BAR = 4096, CW_XCH = 8192, CW_ATT = 16384;
static_assert((size_t)(CW_ATT + 256 * 64) * 4 <= CTL_ZERO_BYTES, "every polled word inside the memset region");

constexpr int RING_OFF = 0, RING_BYTES = 131072;
constexpr int LDSCTL_OFF = RING_BYTES, MISC_OFF = LDSCTL_OFF + 320;
constexpr int AUX_OFF = RING_BYTES + 1024;
constexpr int LDS_BYTES = 163840;
struct Frame {
    LAS unsigned char* lds;
    volatile LAS unsigned* MISC;
    gu32* ctl;
    int tid, lane, wave;
    int vcu, G;
    const float* in[24];
    float* out; unsigned char* ws;
};
__device__ __forceinline__ float wave_sum(float v) {
#pragma unroll
    for (int o = 1; o < 64; o <<= 1) v += __shfl_xor(v, o);
    return v;
}
__device__ __forceinline__ float wave_max(float v) {
#pragma unroll
    for (int o = 1; o < 64; o <<= 1) v = fmaxf(v, __shfl_xor(v, o));
    return v;
}
__device__ __forceinline__ float bf2f(bf16 b) { return __builtin_bit_cast(float, (unsigned)b << 16); }
__device__ __forceinline__ float bflo(unsigned w) { return __builtin_bit_cast(float, w << 16); }
__device__ __forceinline__ float bfhi(unsigned w) { return __builtin_bit_cast(float, w & 0xffff0000u); }

enum { MAT_WIN = 0, MAT_WQ, MAT_WQI, MAT_WPA, MAT_WPB, MAT_WOUT, MAT_WGATE, MAT_WUP, MAT_WDOWN };
__device__ __forceinline__ int dst_of(int mat, int c) {
    switch (mat) {
    case MAT_WIN:
        if (c < 2560) return c;
        if (c < 3584) { const int h = (c - 2560) >> 7, d = (c - 2560) & 127; return 2560 + h * 128 + (d < 64 ? 2 * d : 2 * (d - 64) + 1); }
        if (c < 4608) return c;
        if (c < 4688) return 8704 + (c - 4608);
        { const int g = c - 4688, which = g >> 11, cc = g & 2047; return 4608 + (cc >> 7) * 256 + which * 128 + (cc & 127); }
    case MAT_WQ: { const int h = c >> 7, d = c & 127; return h * 128 + (d < 64 ? 2 * d : 2 * (d - 64) + 1); }
    case MAT_WQI: { const int h = c >> 6, d = c & 63; return 1024 + h * 64 + (d < 32 ? (d < 16 ? 2 * d : 2 * (d - 16) + 1) : d); }
    case MAT_WGATE: return (c >> 7) * 256 + (c & 127);
    case MAT_WUP: return (c >> 7) * 256 + 128 + (c & 127);
    default: return c;
    }
}
__device__ __forceinline__ void p0_transpose_item(int mat, const float* __restrict__ W, int K, int N, bf16* WT, const float* ksc, LAS unsigned char* scr, int item, int lane) {
    const int nblk = (N + 63) / 64, kb = item / nblk, nb = item % nblk, k0 = 64 * kb, c0 = 64 * nb;
    const int kq = lane >> 4, nq = lane & 15;
    const bool colok = (c0 + 4 * nq) < N;
    f32x4 v[16];
#pragma unroll
    for (int i = 0; i < 16; ++i) { const int k = k0 + 16 * (i >> 2) + 4 * kq + (i & 3); v[i] = colok ? *(const f32x4*)(W + (size_t)k * N + c0 + 4 * nq) : (f32x4){0.f, 0.f, 0.f, 0.f}; }
    if (ksc) {
#pragma unroll
        for (int i = 0; i < 16; ++i) v[i] = v[i] * ksc[k0 + 16 * (i >> 2) + 4 * kq + (i & 3)];
    }
#pragma unroll
    for (int j = 0; j < 4; ++j)
#pragma unroll
        for (int e = 0; e < 4; ++e) {
            const unsigned lo = pk2(v[4 * j][e], v[4 * j + 1][e]), hi = pk2(v[4 * j + 2][e], v[4 * j + 3][e]);
            *(LAS unsigned long long*)(scr + (4 * nq + e) * 144 + (16 * j + 4 * kq) * 2) = (unsigned long long)lo | ((unsigned long long)hi << 32);
        }
    LDS_WAIT(); asm volatile("" ::: "memory");
#pragma unroll
    for (int j = 0; j < 8; ++j) {
        const int ch = lane + 64 * j, cl = ch >> 3, k8 = ch & 7;
        const v4u o = *(const LAS v4u*)(scr + cl * 144 + k8 * 16);
        if (c0 + cl < N) *(GAS v4u*)(WT + (size_t)dst_of(mat, c0 + cl) * K + k0 + 8 * k8) = o;
    }
    LDS_WAIT(); asm volatile("" ::: "memory");
}
constexpr int MOD_P10 = 214;
__device__ __forceinline__ void p_mod_strips(const Frame& F, int cb0, int cb1, int step) {
    unsigned char* ws = F.ws;
    {
        LAS f32x4* red = (LAS f32x4*)(F.lds + RING_OFF);
        const float* cv = F.in[1]; const float* wmod = F.in[2]; const float* bmod = F.in[3]; float* mod = (float*)(ws + WS_MOD);
        for (int cb = cb0; cb < cb1; cb += step) {
            const int kg = F.tid / 12, c4 = F.tid % 12;
            if (kg < 42) {
                f32x4 acc = {0.f, 0.f, 0.f, 0.f};
#pragma unroll 16
                for (int k = kg; k < D; k += 42) acc += *(const f32x4*)(wmod + (size_t)k * (6 * D) + cb * 48 + 4 * c4) * cv[k];
                red[kg * 12 + c4] = acc;
            }
            __syncthreads();
            if (F.tid < 48) { int tt = F.tid; asm volatile("" : "+v"(tt));
                float a = bmod[cb * 48 + tt]; const LAS float* rf = (const LAS float*)red; for (int g = 0; g < 42; ++g) a += rf[g * 48 + tt];
                __hip_atomic_store(mod + cb * 48 + tt, a, __ATOMIC_RELAXED, __HIP_MEMORY_SCOPE_AGENT); }
            if (F.wave == 0) { asm volatile("s_waitcnt vmcnt(0)" ::: "memory"); if (F.lane == 0) __hip_atomic_fetch_add(((unsigned*)(F.ws + WS_CTL) + CW_MODCNT), 1u, __ATOMIC_RELAXED, __HIP_MEMORY_SCOPE_AGENT); }
            __syncthreads();
        }
    }
}
__device__ __forceinline__ void p0_prologue(const Frame& F) {
    unsigned char* ws = F.ws;
    LAS unsigned char* scr = F.lds + RING_OFF + F.wave * 16384;
    const int gw = F.vcu * NWAVES + F.wave, NGW = F.G * NWAVES;
    p_mod_strips(F, F.vcu, MOD_P10, F.G);
    constexpr int I_WIN = (D / 64) * ((SRC_INC + 63) / 64), I_WQ = (QL / 64) * (1024 / 64);
    constexpr int NITEMS = I_WIN + 2 * I_WQ;
    const bool stripwg = F.vcu < MOD_P10; const int nsl = stripwg ? 2 : 4, NSLOT = (F.G - MOD_P10) * NWAVES * 4 + MOD_P10 * NWAVES * 2;
    const int sl0 = stripwg ? (F.G - MOD_P10) * NWAVES * 4 + gw * 2 : (gw - MOD_P10 * NWAVES) * 4;
    for (int sl = 0; sl < nsl; ++sl)
    for (int it = sl0 + sl; it < NITEMS; it += NSLOT) {
        int r = it;
        if (r < I_WIN) { p0_transpose_item(MAT_WIN, F.in[6], D, SRC_INC, (bf16*)(ws + WS_WIN), nullptr, scr, r, F.lane); continue; } r -= I_WIN;
        if (r < I_WQ) { p0_transpose_item(MAT_WQ, F.in[12], QL, 1024, (bf16*)(ws + WS_WQQ), F.in[11], scr, r, F.lane); continue; } r -= I_WQ;
        p0_transpose_item(MAT_WQI, F.in[13], QL, 1024, (bf16*)(ws + WS_WQQ), F.in[11], scr, r, F.lane);
    }
    {
        v4u* z = (v4u*)(ws + WS_WIN + (size_t)8784 * D * 2);
        for (int i = F.vcu * 512 + F.tid; i < (NPROJ - 8784) * D * 2 / 16; i += F.G * 512) z[i] = (v4u){0u, 0u, 0u, 0u};
    }
    {
        const float* wsrc = F.in[9]; bf16* wm = (bf16*)(ws + WS_WM);
        for (int i = (F.vcu * 512 + F.tid); i < 8 * 128 * 128; i += F.G * 512) { const int t = (i >> 7) & 127, s = i & 127; wm[i] = (bf16)f2bf(s <= t ? wsrc[i] : 0.f); }
        float* wsum = (float*)(ws + WS_WSUM);
        for (int row = gw; row < 8 * 128; row += NGW) { const int t = row & 127; const int s0 = 2 * F.lane;
            const float a = s0 <= t ? bf2f((bf16)f2bf(wsrc[row * 128 + s0])) : 0.f, b = s0 + 1 <= t ? bf2f((bf16)f2bf(wsrc[row * 128 + s0 + 1])) : 0.f;
            const float r = wave_sum(a + b); if (F.lane == 0) wsum[row] = r; }
    }
    {
        float* cosA = (float*)(ws + WS_COSA); float* sinA = (float*)(ws + WS_SINA); float* cosI = (float*)(ws + WS_COSI); float* sinI = (float*)(ws + WS_SINI);
        for (int i = F.vcu * 512 + F.tid; i < S * 64; i += F.G * 512) {
            const int t = i >> 6, k = i & 63;
            const float inv = 1.0f / powf(10000.0f, (float)(2 * k) / 128.0f); const float ang = (float)t * inv;
            { const double a = (double)ang, rr = a - 6.283185307179586476925 * rint(a * 0.15915494309189533577); float sn, cs; sincosf((float)rr, &sn, &cs); cosA[i] = cs; sinA[i] = sn; }
            if (k < 16) { const float inv2 = 1.0f / powf(10000.0f, (float)(2 * k) / 32.0f); const float ang2 = (float)t * inv2;
                const double a = (double)ang2, rr = a - 6.283185307179586476925 * rint(a * 0.15915494309189533577); float sn, cs; sincosf((float)rr, &sn, &cs); cosI[t * 16 + k] = cs; sinI[t * 16 + k] = sn; }
        }
    }
}
__device__ __forceinline__ void p_late_convert(const Frame& F, int part, int widx, int nwg) {
    unsigned char* ws = F.ws;
    LAS unsigned char* scr = F.lds + RING_OFF + F.wave * 16384;
    constexpr int I_WPA = (GW / 64) * (D / 64), I_WOUT = (D / 64) * (D / 64), I_WG = (D / 64) * (FF / 64), I_WDOWN = (FF / 64) * (D / 64);
    const int n = part == 0 ? 2 * I_WPA + I_WOUT + 2 * I_WG : I_WDOWN;
    for (int it = widx * NWAVES + F.wave; it < n; it += nwg * NWAVES) {
        if (part == 1) { p0_transpose_item(MAT_WDOWN, F.in[23], FF, D, (bf16*)(ws + WS_WDOWN), nullptr, scr, it, F.lane); continue; }
        int r = it;
        if (r < I_WPA) { p0_transpose_item(MAT_WPA, F.in[16], GW, D, (bf16*)(ws + WS_WPA), nullptr, scr, r, F.lane); continue; } r -= I_WPA;
        if (r < I_WPA) { p0_transpose_item(MAT_WPB, F.in[17], AW, D, (bf16*)(ws + WS_WPB), nullptr, scr, r, F.lane); continue; } r -= I_WPA;
        if (r < I_WOUT) { p0_transpose_item(MAT_WOUT, F.in[18], D, D, (bf16*)(ws + WS_WOUT), nullptr, scr, r, F.lane); continue; } r -= I_WOUT;
        if (r < I_WG) { p0_transpose_item(MAT_WGATE, F.in[21], D, FF, (bf16*)(ws + WS_WGU), nullptr, scr, r, F.lane); continue; } r -= I_WG;
        p0_transpose_item(MAT_WUP, F.in[22], D, FF, (bf16*)(ws + WS_WGU), nullptr, scr, r, F.lane);
    }
}
__device__ __forceinline__ void p1_prenorm(const Frame& F) {
    if (F.wave == 0) { unsigned sp = 0u;
        while ((unsigned)__builtin_amdgcn_readfirstlane(__hip_atomic_load(((unsigned*)(F.ws + WS_CTL) + CW_MODCNT), __ATOMIC_RELAXED, __HIP_MEMORY_SCOPE_AGENT)) < (unsigned)MOD_P10) { __builtin_amdgcn_s_sleep(2); if (++sp > (1u << 24)) break; }
        __builtin_amdgcn_fence(__ATOMIC_ACQUIRE, "agent"); }
    asm volatile("s_waitcnt vmcnt(0) lgkmcnt(0)" ::: "memory"); __syncthreads();
    const int gw = F.vcu * NWAVES + F.wave, NGW = F.G * NWAVES;
    const float* x = F.in[0]; const float* g = F.in[4]; const float* mod = (const float*)(F.ws + WS_MOD); bf16* H = (bf16*)(F.ws + WS_H);
    f32x4 pa[8], pb[8];
#pragma unroll
    for (int j = 0; j < 8; ++j) { const int n = 4 * F.lane + 256 * j; pa[j] = *(const f32x4*)(g + n) * (*(const f32x4*)(mod + D + n) + 1.0f); pb[j] = *(const f32x4*)(mod + n); }
    for (int m = gw; m < S; m += NGW) {
        const f32x4* xr = (const f32x4*)(x + (size_t)m * D) + F.lane;
        f32x4 v[8]; float ss = 0.f;
#pragma unroll
        for (int j = 0; j < 8; ++j) { v[j] = xr[64 * j]; ss += (v[j].x * v[j].x + v[j].y * v[j].y) + (v[j].z * v[j].z + v[j].w * v[j].w); }
        const float r = rsqrtf(wave_sum(ss) * (1.f / D) + NORM_EPS);
        unsigned long long* o8 = (unsigned long long*)(H + (size_t)m * D) + F.lane;
#pragma unroll
        for (int j = 0; j < 8; ++j) {
            const f32x4 o = v[j] * r * pa[j] + pb[j];
            o8[64 * j] = (unsigned long long)pk2(o.x, o.y) | ((unsigned long long)pk2(o.z, o.w) << 32);
        }
    }
}
struct SpatialW { bf16x8 bw[8][4]; };
__device__ __forceinline__ void p3_spatial_load(const Frame& F, int g, SpatialW& W) {
    const bf16* WM = (const bf16*)(F.ws + WS_WM) + (size_t)g * 128 * 128; const int fr = F.lane & 15, fq = F.lane >> 4;
#pragma unroll
    for (int ks = 0; ks < 4; ++ks)
#pragma unroll
        for (int nt = 0; nt < 8; ++nt) if (nt >= 2 * ks) W.bw[nt][ks] = *(const bf16x8*)(WM + (size_t)(16 * nt + fr) * 128 + 32 * ks + 8 * fq);
}
__device__ __forceinline__ void p3_spatial_item(const Frame& F, int c, int g, const SpatialW& W) {
    constexpr int VP = 136;
    LAS bf16* VT = (LAS bf16*)(F.lds + RING_OFF);
    const bf16* Vg = (const bf16*)(F.ws + WS_VG); bf16* U = (bf16*)(F.ws + WS_U);
    const float* stats = (const float*)(F.ws + WS_STATS); const float* gam = F.in[7] + g * 128; const float* bet = F.in[8] + g * 128; const float* bs = F.in[10] + g * 128;
    const float* wsum = (const float*)(F.ws + WS_WSUM) + g * 128;
    const int w = F.wave, fr = F.lane & 15, fq = F.lane >> 4;
    {
        const int s = F.tid >> 2, dq = F.tid & 3, row = c * 128 + s;
        const f32x4 p0 = *(const f32x4*)(stats + ((size_t)row * 16 + 4 * dq) * 2), p1 = *(const f32x4*)(stats + ((size_t)row * 16 + 4 * dq + 2) * 2);
        float sm = (p0.x + p0.z) + (p1.x + p1.z), sq = (p0.y + p0.w) + (p1.y + p1.w);
        sm += __shfl_xor(sm, 1); sq += __shfl_xor(sq, 1); sm += __shfl_xor(sm, 2); sq += __shfl_xor(sq, 2);
        const float mu = sm * (1.f / GW), var = sq * (1.f / GW) - mu * mu, r = rsqrtf(fmaxf(var, 0.f) + NORM_EPS);
        const v4u* vp = (const v4u*)(Vg + (size_t)row * GW + g * 128 + dq * 32);
#pragma unroll
        for (int i = 0; i < 4; ++i) {
            const v4u w = vp[i];
            const unsigned ww[4] = {w.x, w.y, w.z, w.w};
#pragma unroll
            for (int e = 0; e < 4; ++e) {
                const int d = dq * 32 + i * 8 + e * 2;
                VT[d * VP + s] = (bf16)f2bf((bflo(ww[e]) - mu) * r); VT[(d + 1) * VP + s] = (bf16)f2bf((bfhi(ww[e]) - mu) * r);
            }
        }
    }
    __syncthreads();
    {
        f32x4 acc[8];
#pragma unroll
        for (int nt = 0; nt < 8; ++nt) acc[nt] = (f32x4){0.f, 0.f, 0.f, 0.f};
#pragma unroll
        for (int ks = 0; ks < 4; ++ks) {
            const bf16x8 a = *(const LAS bf16x8*)(VT + (16 * w + fr) * VP + 32 * ks + 8 * fq);
#pragma unroll
            for (int nt = 0; nt < 8; ++nt) if (nt >= 2 * ks) acc[nt] = __builtin_amdgcn_mfma_f32_16x16x32_bf16(a, W.bw[nt][ks], acc[nt], 0, 0, 0);
        }
        const f32x4 g4 = *(const f32x4*)(gam + 16 * w + 4 * fq), b4 = *(const f32x4*)(bet + 16 * w + 4 * fq);
#pragma unroll
        for (int nt = 0; nt < 8; ++nt) {
            const int t = 16 * nt + fr; const float bb = bs[t], wsm = wsum[t];
            unsigned long long* up = (unsigned long long*)(U + (size_t)(c * 128 + t) * GW + g * 128 + 16 * w + 4 * fq);
            const unsigned long long uu = *up; const unsigned lo = (unsigned)uu, hi = (unsigned)(uu >> 32);
            const float o0 = bflo(lo) * (acc[nt][0] * g4.x + (b4.x * wsm + bb)), o1 = bfhi(lo) * (acc[nt][1] * g4.y + (b4.y * wsm + bb));
            const float o2 = bflo(hi) * (acc[nt][2] * g4.z + (b4.z * wsm + bb)), o3 = bfhi(hi) * (acc[nt][3] * g4.w + (b4.w * wsm + bb));
            *up = (unsigned long long)pk2(o0, o1) | ((unsigned long long)pk2(o2, o3) << 32);
        }
    }
    __syncthreads();
}
__device__ __forceinline__ void p3_kidx(const Frame& F) {
    const int gw = F.vcu * NWAVES + F.wave, NGW = F.G * NWAVES, l = F.lane;
    const bf16* SM = (const bf16*)(F.ws + WS_SMALL); bf16* KIDX = (bf16*)(F.ws + WS_KIDX); float* IDXW = (float*)(F.ws + WS_IDXW);
    const float* kg = F.in[14]; const float* kb = F.in[15]; const float* cosI = (const float*)(F.ws + WS_COSI); const float* sinI = (const float*)(F.ws + WS_SINI);
    for (int t0 = gw; t0 < S; t0 += 4 * NGW) {
        float z[4], cs[4], sn[4], wv[4];
#pragma unroll
        for (int u = 0; u < 4; ++u) { const int t = (t0 + u * NGW < S) ? t0 + u * NGW : t0; z[u] = bf2f(SM[(size_t)t * 256 + l]); cs[u] = cosI[t * 16 + (l & 15)]; sn[u] = sinI[t * 16 + (l & 15)]; wv[u] = bf2f(SM[(size_t)t * 256 + 64 + (l & 15)]); }
        const float gl = kg[l], bl = kb[l];
#pragma unroll
        for (int u = 0; u < 4; ++u) {
            const int t = t0 + u * NGW;
            const float mu = wave_sum(z[u]) * (1.f / 64.f); const float dd = z[u] - mu;
            const float r = rsqrtf(wave_sum(dd * dd) * (1.f / 64.f) + NORM_EPS);
            const float y = dd * r * gl + bl;
            const float yp = __shfl(y, (l < 16) ? l + 16 : ((l < 32) ? l - 16 : l));
            float o; int pos;
            if (l < 16) { o = y * cs[u] - yp * sn[u]; pos = 2 * l; } else if (l < 32) { o = y * cs[u] + yp * sn[u]; pos = 2 * (l - 16) + 1; } else { o = y; pos = l; }
            if (t < S) {
                KIDX[(size_t)(t >> 5) * 2048 + (pos >> 4) * 512 + (((pos >> 3) & 1) * 32 + (t & 31)) * 8 + (pos & 7)] = (bf16)f2bf(o);
                if (l < 16) IDXW[t * 16 + l] = wv[u] * 0.03125f;
            }
        }
    }
}
__device__ __forceinline__ void p3_rt(const Frame& F, int pm, LAS float* rt) {
    const float* st2 = (const float*)(F.ws + WS_STATS2);
    if (F.tid < 256) {
        const f32x4 a = *(const f32x4*)(st2 + (size_t)(pm * 256 + F.tid) * 8), b = *(const f32x4*)(st2 + (size_t)(pm * 256 + F.tid) * 8 + 4);
        const float ss = ((a.x + a.y) + (a.z + a.w)) + ((b.x + b.y) + (b.z + b.w));
        rt[F.tid] = rsqrtf(ss * (1.f / QL) + NORM_EPS);
    }
}
typedef float f32x16 __attribute__((ext_vector_type(16)));
__device__ __forceinline__ float key2f(unsigned k) { return __uint_as_float((k & 0x80000000u) ? (k ^ 0x80000000u) : ~k); }
__device__ __forceinline__ unsigned f2key(float f) { const unsigned b = __float_as_uint(f); return b ^ ((b >> 31) ? 0xFFFFFFFFu : 0x80000000u); }
__device__ __forceinline__ int wave_isum(int v) {
#pragma unroll
    for (int o = 1; o < 64; o <<= 1) v += __shfl_xor(v, o);
    return v;
}
__device__ __forceinline__ int idx_count_ge(const LAS f32x4* row4, int n256, float p, int lane) {
    int c = 0;
    for (int it = 0; it < n256; ++it) { const f32x4 v = row4[it * 64 + lane]; c += (v.x >= p ? 1 : 0) + (v.y >= p ? 1 : 0) + (v.z >= p ? 1 : 0) + (v.w >= p ? 1 : 0); }
    return wave_isum(c);
}
constexpr int IDX_NBIN = 1024;
constexpr float IDX_ZOOM = 8.0f;
__device__ __forceinline__ float relu_asm(float x) { const int b = __float_as_int(x); return __int_as_float(b > 0 ? b : 0); }
__device__ __forceinline__ float idx_kmax(const Frame& F) {
    const float g = fabsf(F.in[14][F.lane]), b = F.in[15][F.lane];
    return wave_max(g) * 8.0f + sqrtf(wave_sum(b * b));
}
constexpr int X8_CAP = 128;
constexpr int X8_HIST_OFF = AUX_OFF, X8_MASKW_OFF = X8_HIST_OFF + 8 * (IDX_NBIN / 2) * 4, X8_CI_OFF = X8_MASKW_OFF + 8 * 128 * 8, X8_CX_OFF = X8_CI_OFF + 8 * X8_CAP * 2, X8_END = X8_CX_OFF + 8 * X8_CAP * 4;
constexpr int X8_SCALE_OFF = LDSCTL_OFF + 512, X8_CNT_OFF = X8_SCALE_OFF + 32, X8_FB_OFF = X8_CNT_OFF + 32;
constexpr int X8_WQ_OFF = X8_END;
static_assert(X8_WQ_OFF + 512 <= LDS_BYTES && X8_END <= LDS_BYTES && 8 * 8192 * 2 <= RING_BYTES && X8_FB_OFF + 32 <= LDSCTL_OFF + 640, "8-query indexer LDS map");
struct X8Regs { bf16x8 a[4][4]; f32x4 wq[4][4]; bf16x8 bA[4], bB[4], bC[4]; };
#define X8_ZERO16 ((f32x16){0.f, 0.f, 0.f, 0.f, 0.f, 0.f, 0.f, 0.f, 0.f, 0.f, 0.f, 0.f, 0.f, 0.f, 0.f, 0.f})
#define X8_HEADSUM(S_, WQ_, DD_) do { S_ = 0.f; _Pragma("unroll") for (int i_ = 0; i_ < 16; ++i_) S_ = __builtin_fmaf((WQ_)[i_ >> 2][i_ & 3], relu_asm((DD_)[i_]), S_); S_ += 0.0f; } while (0)
__device__ __forceinline__ unsigned x8_y16(float s, float scale64) { const unsigned u = (unsigned)fmaxf(fmaf(s, scale64, 64.0f * (float)(IDX_NBIN / 2)), 0.0f); return u < 65535u ? u : 65535u; }
__device__ __forceinline__ void x8_prefetch(const Frame& F, int t0, X8Regs& R) {
    const bf16* QIDX = (const bf16*)(F.ws + WS_QIDX); const bf16* KIDX = (const bf16*)(F.ws + WS_KIDX);
    const int lane = F.lane, r = lane & 31, hh = lane >> 5, w = F.wave, NT = t0 / 32 + 1;
#define X8_LOAD0(B_, kt_) do { const int ktc_ = (kt_) < NT ? (kt_) : NT - 1; \
        _Pragma("unroll") for (int ks = 0; ks < 4; ++ks) B_[ks] = *(const bf16x8*)(KIDX + (size_t)ktc_ * 2048 + ks * 512 + lane * 8); } while (0)
    X8_LOAD0(R.bA, w); X8_LOAD0(R.bB, w + 8); X8_LOAD0(R.bC, w + 16);
#undef X8_LOAD0
#pragma unroll
    for (int m = 0; m < 4; ++m) {
        const int tq = t0 + 2 * m + ((r >> 2) & 1), head = (r & 3) + 4 * (r >> 3);
#pragma unroll
        for (int ks = 0; ks < 4; ++ks) R.a[m][ks] = *(const bf16x8*)(QIDX + (size_t)tq * 1024 + head * 64 + 16 * ks + 8 * hh);
    }
}
__device__ __forceinline__ void x8_stage_wq(const Frame& F, int t0) { if (F.tid < 128) ((LAS float*)(F.lds + X8_WQ_OFF))[F.tid] = ((const float*)(F.ws + WS_IDXW))[t0 * 16 + F.tid]; }
__device__ __forceinline__ void x8_fetch_wq(const Frame& F, X8Regs& R) {
    const LAS f32x4* wl = (const LAS f32x4*)(F.lds + X8_WQ_OFF) + (F.lane >> 5) * 4;
#pragma unroll
    for (int m = 0; m < 4; ++m)
#pragma unroll
        for (int i4 = 0; i4 < 4; ++i4) R.wq[m][i4] = wl[m * 8 + i4];
}
__device__ __forceinline__ float x8_score_q(const X8Regs& R, int qi, const bf16x8 (&Bg)[4]) {
    float s = 0.f;
#define X8_CASE(M_) { asm volatile("; x8 row tile %0" :: "n"(M_));     \
        f32x16 d_ = X8_ZERO16; _Pragma("unroll") for (int ks = 0; ks < 4; ++ks) d_ = __builtin_amdgcn_mfma_f32_32x32x16_bf16(R.a[M_][ks], Bg[ks], d_, 0, 0, 0); X8_HEADSUM(s, R.wq[M_], d_); asm volatile("; x8 row tile %0 done" :: "n"(M_), "v"(s)); }
    const int m = qi >> 1;
    if (m == 0) X8_CASE(0) else if (m == 1) X8_CASE(1) else if (m == 2) X8_CASE(2) else X8_CASE(3)
#undef X8_CASE
    return s;
}
template <int G>
__device__ __forceinline__ void x8_pass_group(const LAS unsigned short* rp, unsigned thrLo, unsigned thrHi, unsigned& hlo, unsigned& hhi, unsigned& clo, unsigned& chi) {
    unsigned xv[8];
#pragma unroll
    for (int u = 0; u < 8; ++u) xv[u] = rp[512 * G + 64 * u];
    __builtin_amdgcn_sched_barrier(0);
#define X8_W(u_) { const unsigned long long hiw = __ballot(xv[u_] >= thrHi), cw = __ballot(xv[u_] >= thrLo) & ~hiw; \
        asm("s_nop 0\n\tv_writelane_b32 %0, %4, %8\n\tv_writelane_b32 %1, %5, %8\n\tv_writelane_b32 %2, %6, %8\n\tv_writelane_b32 %3, %7, %8" \
            : "+v"(hlo), "+v"(hhi), "+v"(clo), "+v"(chi) : "s"((unsigned)hiw), "s"((unsigned)(hiw >> 32)), "s"((unsigned)cw), "s"((unsigned)(cw >> 32)), "n"((8 * G + u_) & 63)); }
    X8_W(0) X8_W(1) X8_W(2) X8_W(3) X8_W(4) X8_W(5) X8_W(6) X8_W(7)
#undef X8_W
}
__device__ __forceinline__ void x8_zero_hist(const Frame& F) { LAS unsigned* hist = (LAS unsigned*)(F.lds + X8_HIST_OFF); for (int i = F.tid; i < 8 * (IDX_NBIN / 2); i += 512) hist[i] = 0u; }
__device__ __forceinline__ void x8_item(const Frame& F, int t0, int t0n, float kmax, X8Regs& R) {
    LAS unsigned short* sc = (LAS unsigned short*)(F.lds + RING_OFF);
    LAS unsigned* hist = (LAS unsigned*)(F.lds + X8_HIST_OFF);
    LAS unsigned* ccount = (LAS unsigned*)(F.lds + X8_CNT_OFF);
    LAS unsigned* fbflag = (LAS unsigned*)(F.lds + X8_FB_OFF);
    const bf16* KIDX = (const bf16*)(F.ws + WS_KIDX);
    const int w = F.wave;
    const int NT = t0 / 32 + 1;
    {
        const int lane = F.lane, r = lane & 31, hh = lane >> 5;
        float bs[4];
        x8_fetch_wq(F, R);
        bf16x8 (&a)[4][4] = R.a; f32x4 (&wq)[4][4] = R.wq;
#pragma unroll
        for (int m = 0; m < 4; ++m) {
            const int tq = t0 + 2 * m + ((r >> 2) & 1), head = (r & 3) + 4 * (r >> 3);
            float ss = 0.f;
#pragma unroll
            for (int ks = 0; ks < 4; ++ks) { const v4u x = __builtin_bit_cast(v4u, a[m][ks]); const unsigned ww[4] = {x.x, x.y, x.z, x.w};
#pragma unroll
                for (int e = 0; e < 4; ++e) ss += bflo(ww[e]) * bflo(ww[e]) + bfhi(ww[e]) * bfhi(ww[e]); }
            ss += __shfl_xor(ss, 32);
            float term = sqrtf(ss) * fabsf(((const LAS float*)(F.lds + X8_WQ_OFF))[(tq - t0) * 16 + head]);
            term += __shfl_xor(term, 1); term += __shfl_xor(term, 2); term += __shfl_xor(term, 8); term += __shfl_xor(term, 16);
            const float scl = (float)(IDX_NBIN / 2 - 1) / (term * kmax * (1.03f / IDX_ZOOM) + 1e-30f);
            const float other = __shfl_xor(scl, 4);
            const float s_even = ((r >> 2) & 1) ? other : scl, s_odd = ((r >> 2) & 1) ? scl : other;
            bs[m] = 64.0f * (hh ? s_odd : s_even);
        }
#define X8_LOAD(B_, kt_) do { const int ktc_ = (kt_) < NT ? (kt_) : NT - 1;     \
        _Pragma("unroll") for (int ks = 0; ks < 4; ++ks) B_[ks] = *(const bf16x8*)(KIDX + (size_t)ktc_ * 2048 + ks * 512 + lane * 8); } while (0)
#define X8_COMP_(B_, kt_, MASKED_) do { \
            _Pragma("unroll") for (int m = 0; m < 4; ++m) { \
                f32x16 dd = X8_ZERO16;     \
                _Pragma("unroll") for (int ks = 0; ks < 4; ++ks) dd = __builtin_amdgcn_mfma_f32_32x32x16_bf16(a[m][ks], B_[ks], dd, 0, 0, 0); \
                float s; X8_HEADSUM(s, wq[m], dd); \
                const int key = 32 * (kt_) + r, q = 2 * m + hh; const bool ok = !(MASKED_) || key <= t0 + q; \
                const unsigned u = x8_y16(s, bs[m]); \
                sc[q * 8192 + key] = (unsigned short)(ok ? u : 0u); \
                if (ok) __hip_atomic_fetch_add(hist + q * (IDX_NBIN / 2) + (u >> 7), 1u + 0xFFFFu * ((u >> 6) & 1u), __ATOMIC_RELAXED, __HIP_MEMORY_SCOPE_WORKGROUP); \
                __builtin_amdgcn_sched_barrier(0); } } while (0)
#define X8_COMP(B_, kt_) do { if ((kt_) < NT - 1) X8_COMP_(B_, kt_, 0); else if ((kt_) < NT) X8_COMP_(B_, kt_, 1); } while (0)
#define X8_PIN() __builtin_amdgcn_sched_barrier(0)
        bf16x8 (&bA)[4] = R.bA, (&bB)[4] = R.bB, (&bC)[4] = R.bC;
        X8_PIN();
        for (int kt = w; kt < NT; kt += 24) {
            X8_COMP(bA, kt); X8_PIN(); X8_LOAD(bA, kt + 24); X8_PIN();
            X8_COMP(bB, kt + 8); X8_PIN(); X8_LOAD(bB, kt + 32); X8_PIN();
            X8_COMP(bC, kt + 16); X8_PIN(); X8_LOAD(bC, kt + 40); X8_PIN();
        }
        X8_PIN();
#undef X8_PIN
#undef X8_LOAD
#undef X8_COMP
#undef X8_COMP_
    }
    int lane_o = F.lane; asm volatile("" : "+v"(lane_o));
    const int lane = lane_o, r = lane & 31, hh = lane >> 5;
    if (F.tid < 8) { ccount[F.tid] = 0u; fbflag[F.tid] = 0u; }
    if ((NT & 1) && F.tid < 256) sc[(F.tid >> 5) * 8192 + 32 * NT + (F.tid & 31)] = 0;
    LDS_WAIT(); __syncthreads();
    const int q = w, t = t0 + q, n = t + 1, nw = (n + 63) >> 6;
    LAS unsigned long long* mw = (LAS unsigned long long*)(F.lds + X8_MASKW_OFF) + q * 128;
    LAS unsigned short* ci = (LAS unsigned short*)(F.lds + X8_CI_OFF) + q * X8_CAP;
    LAS float* cx = (LAS float*)(F.lds + X8_CX_OFF) + q * X8_CAP;
    {
        LAS unsigned* hq = hist + q * (IDX_NBIN / 2);
        int Bbin = 0, inB = 0, need = 0; bool usehist = false;
        constexpr int BPL = IDX_NBIN / 64;
        static_assert(BPL == 16, "16 bins = 8 packed words per lane");
        {
            LAS v4u* h4 = (LAS v4u*)hq + 2 * lane;
            int hv[BPL];
#pragma unroll
            for (int q4 = 0; q4 < 2; ++q4) { const v4u hh4 = h4[q4]; const unsigned pw[4] = {hh4.x, hh4.y, hh4.z, hh4.w};
#pragma unroll
                for (int e = 0; e < 4; ++e) { hv[8 * q4 + 2 * e] = (int)(pw[e] & 0xffffu); hv[8 * q4 + 2 * e + 1] = (int)(pw[e] >> 16); } }
            h4[0] = (v4u){0u, 0u, 0u, 0u}; h4[1] = (v4u){0u, 0u, 0u, 0u};
            if (t >= 256) {
                int mine = 0;
#pragma unroll
                for (int e = 0; e < BPL; ++e) mine += hv[e];
                int suf = mine;
#pragma unroll
                for (int o = 1; o < 64; o <<= 1) { const int v = __shfl_down(suf, o); if (lane + o < 64) suf += v; }
                const unsigned long long ge = __ballot(suf >= 256);
                const int L = 63 - __builtin_clzll(ge);
                int acc = suf - mine, bsel = 0, csel = 0, asel = 0; bool found = false;
#pragma unroll
                for (int e = BPL - 1; e >= 0; --e) { const bool hit = !found && (acc + hv[e] >= 256); bsel = hit ? e : bsel; csel = hit ? hv[e] : csel; asel = hit ? acc : asel; found = found || hit; acc += hv[e]; }
                Bbin = BPL * L + __builtin_amdgcn_readlane(bsel, L); inB = __builtin_amdgcn_readlane(csel, L);
                need = 256 - __builtin_amdgcn_readlane(asel, L);
                usehist = inB <= X8_CAP && Bbin >= 1;
            }
        }
        if (usehist) {
            const unsigned thrLo = (unsigned)Bbin << 6, thrHi = ((unsigned)Bbin + 1u) << 6;
            unsigned h0l = 0u, h0h = 0u, c0l = 0u, c0h = 0u, h1l = 0u, h1h = 0u, c1l = 0u, c1h = 0u;
            const LAS unsigned short* rp = sc + q * 8192 + lane;
#define X8_G0(G_) if (nw > 8 * (G_)) x8_pass_group<G_>(rp, thrLo, thrHi, h0l, h0h, c0l, c0h);
#define X8_G1(G_) if (nw > 8 * (G_)) x8_pass_group<G_>(rp, thrLo, thrHi, h1l, h1h, c1l, c1h);
            X8_G0(0) X8_G0(1) X8_G0(2) X8_G0(3) X8_G0(4) X8_G0(5) X8_G0(6) X8_G0(7) X8_G1(8) X8_G1(9) X8_G1(10) X8_G1(11) X8_G1(12) X8_G1(13) X8_G1(14) X8_G1(15)
#undef X8_G0
#undef X8_G1
            const bool v0 = lane < nw, v1 = 64 + lane < nw;
            mw[lane] = v0 ? (((unsigned long long)h0h << 32) | h0l) : 0ull; mw[64 + lane] = v1 ? (((unsigned long long)h1h << 32) | h1l) : 0ull;
            unsigned long long cw0 = v0 ? (((unsigned long long)c0h << 32) | c0l) : 0ull, cw1 = v1 ? (((unsigned long long)c1h << 32) | c1l) : 0ull;
            const int nc = __builtin_popcountll(cw0) + __builtin_popcountll(cw1);
            if (nc) {
                int off = (int)__hip_atomic_fetch_add(ccount + q, (unsigned)nc, __ATOMIC_RELAXED, __HIP_MEMORY_SCOPE_WORKGROUP);
                while (cw0) { ci[off++] = (unsigned short)(64 * lane + __builtin_ctzll(cw0)); cw0 &= cw0 - 1ull; }
                while (cw1) { ci[off++] = (unsigned short)(64 * (64 + lane) + __builtin_ctzll(cw1)); cw1 &= cw1 - 1ull; }
            }
            LDS_WAIT();
            const int cnt = (int)*(volatile LAS unsigned*)(ccount + q);
            for (int c0 = 0; c0 < cnt; c0 += 32) {
                const int idx = c0 + r; const int key = idx < cnt ? (int)ci[idx] : 0;
                const bf16* kp = KIDX + (size_t)(key >> 5) * 2048 + (hh * 32 + (key & 31)) * 8;
                bf16x8 Bg[4];
#pragma unroll
                for (int ks = 0; ks < 4; ++ks) Bg[ks] = *(const bf16x8*)(kp + ks * 512);
                const float s = x8_score_q(R, q, Bg);
                if (hh == (q & 1) && idx < cnt) cx[idx] = s;
            }
            LDS_WAIT();
            for (int i0 = 0; i0 < cnt; i0 += 64) {
                const int i = i0 + lane; const bool act = i < cnt;
                const int ii = act ? (int)ci[i] : 0; const float xi = act ? cx[i] : 0.f;
                int rank = 0;
                for (int cb = 0; cb < cnt; cb += 64) {
                    const int jl = cb + lane; const bool jact = jl < cnt; const int ijv = jact ? (int)ci[jl] : 0; const float xjv = jact ? cx[jl] : 0.f;
                    const int cn = (cnt - cb < 64) ? cnt - cb : 64;
                    for (int l = 0; l < cn; ++l) {
                        const float xj = __builtin_bit_cast(float, __builtin_amdgcn_readlane(__builtin_bit_cast(int, xjv), l)); const int ij = __builtin_amdgcn_readlane(ijv, l);
                        rank += (xj > xi || (xj == xi && ij < ii)) ? 1 : 0;
                    }
                }
                if (act && rank < need) __hip_atomic_fetch_or(mw + (ii >> 6), 1ull << (ii & 63), __ATOMIC_RELAXED, __HIP_MEMORY_SCOPE_WORKGROUP);
            }
        } else if (t < 256) {
#pragma unroll
            for (int hf = 0; hf < 2; ++hf) { const int j = 64 * hf + lane; unsigned long long wv = 0ull;
                if (64 * j <= t) wv = (t - 64 * j >= 63) ? ~0ull : ((1ull << (t - 64 * j + 1)) - 1ull);
                mw[j] = wv; }
        } else if (lane == 0) fbflag[q] = 1u;
    }
    LDS_WAIT(); __syncthreads();
    {
        unsigned anyfb = 0u;
#pragma unroll
        for (int qf = 0; qf < 8; ++qf) anyfb |= fbflag[qf];
        if (anyfb) {
            LAS float* row = (LAS float*)(F.lds + RING_OFF);
            for (int qf = 0; qf < 8; ++qf) {
                if (fbflag[qf] == 0u) continue;
                const int tf = t0 + qf, nf = tf + 1, nwf = (nf + 63) >> 6, n256 = (nf + 255) >> 8;
                for (int kt = w; kt < NT; kt += 8) {
                    bf16x8 Bg[4];
#pragma unroll
                    for (int ks = 0; ks < 4; ++ks) Bg[ks] = *(const bf16x8*)(KIDX + (size_t)kt * 2048 + ks * 512 + lane * 8);
                    const float s = x8_score_q(R, qf, Bg);
                    const int key = 32 * kt + r;
                    if (hh == (qf & 1)) row[key] = (key <= tf) ? s : -INFINITY;
                }
                for (int idx = 32 * NT + F.tid; idx < 256 * n256; idx += 512) row[idx] = -INFINITY;
                LDS_WAIT(); __syncthreads();
                if (w == 0) {
                    LAS unsigned long long* mwf = (LAS unsigned long long*)(F.lds + X8_MASKW_OFF) + qf * 128;
                    unsigned long long w0 = 0ull, w1 = 0ull;
                    const LAS f32x4* row4 = (const LAS f32x4*)row;
                    unsigned T = 0u; bool exact = false; float pf = 0.f;
                    for (int bit = 31; bit >= 0; --bit) {
                        const unsigned cand = T | (1u << bit);
                        const float p = key2f(cand);
                        const int c = idx_count_ge(row4, n256, p, lane);
                        if (c >= 256) { T = cand; pf = p; if (c == 256) { exact = true; break; } }
                    }
                    int need2 = 0;
                    if (!exact) {
                        int cg = 0;
                        for (int it = 0; it < n256; ++it) { const f32x4 v = row4[it * 64 + lane]; cg += (v.x > pf ? 1 : 0) + (v.y > pf ? 1 : 0) + (v.z > pf ? 1 : 0) + (v.w > pf ? 1 : 0); }
                        need2 = 256 - wave_isum(cg);
                    }
                    for (int j = 0; j < nwf; ++j) {
                        const float x = row[64 * j + lane];
                        unsigned long long b;
                        if (exact) b = __ballot(x >= pf);
                        else {
                            b = __ballot(x > pf);
                            unsigned long long eq = __ballot(x == pf);
                            while (need2 > 0 && eq) { const unsigned long long low = eq & (~eq + 1ull); b |= low; eq ^= low; --need2; }
                        }
                        if (lane == (j & 63)) { if (j < 64) w0 = b; else w1 = b; }
                    }
                    mwf[lane] = w0; mwf[64 + lane] = w1;
                }
                LDS_WAIT(); __syncthreads();
            }
        }
    }
    x8_prefetch(F, t0n, R);
    x8_stage_wq(F, t0n);
    {
        const LAS unsigned long long* mwa = (const LAS unsigned long long*)(F.lds + X8_MASKW_OFF);
        const int ntw = 4 * (t0 >> 8) + 4;
        for (int g = F.tid; g < ntw * 32; g += 512) {
            const int j = g >> 5, qq = (g >> 2) & 7, hs = g & 3;
            const unsigned nib = (unsigned)(mwa[qq * 128 + j] >> (32 * (hs & 1) + 4 * (hs >> 1)));
            v4u o;
#pragma unroll
            for (int k = 0; k < 4; ++k) { const unsigned b = (((nib >> (8 * k)) & 15u) * 0x00204081u) & 0x01010101u; o[k] = (b ^ 0x01010101u) * 0xFCu; }
            unsigned char* mb = F.ws + (j < 64 ? WS_MASKB0 : WS_MASKB1 - (size_t)64 * 524288) + (size_t)j * 524288 + (size_t)t0 * 64;
            asm volatile("global_store_dwordx4 %0, %1, off sc1\n\ts_nop 1" :: "v"(mb + (g & 31) * 16), "v"(o) : "memory");
        }
    }
    __syncthreads();
}
namespace att {
constexpr int D = 128, PITCH = 1024, NW = 8, QBLK = 32, KVBLK = 64, QB = NW * QBLK;
constexpr int SHM_V = KVBLK * D * 2, SHM_K = KVBLK * D * 2;
constexpr int LDS_BYTES = 2 * SHM_V + 2 * SHM_K + NW * 64 * 4;
constexpr float SCALE = 0.08838834764831845f, THR = 8.f;
constexpr float C2 = 1.4426950408889634f * SCALE;
typedef unsigned short bf16;
typedef short bf16x8 __attribute__((ext_vector_type(8)));
typedef short s16x4 __attribute__((ext_vector_type(4)));
typedef float f32x16 __attribute__((ext_vector_type(16)));
typedef float f32x4 __attribute__((ext_vector_type(4)));
typedef float f32x2 __attribute__((ext_vector_type(2)));
typedef unsigned u32x4 __attribute__((ext_vector_type(4)));
typedef unsigned long long u64;
#define KSWZ(row, colB) ((row) * 256 + ((colB) ^ (((row) & 7) << 4)))
#define SBAR() __builtin_amdgcn_sched_barrier(0)
__device__ __forceinline__ int v_st(int k, int c) { const int kk = (k & ~0xC) | ((k & 4) << 1) | ((k & 8) >> 1); return ((kk >> 3) * 4 + (c >> 5)) * 512 + ((kk & 7) * 32 + (c & 31)) * 2; }
__device__ __forceinline__ int v_rd_base(int lane) { return ((lane & 3) << 3) | (((lane >> 2) & 3) << 6) | (((lane >> 4) & 1) << 5) | (((lane >> 5) & 1) << 8); }
constexpr int v_rd_off(int d0, int ks, int half) { return d0 * 512 + ks * 4096 + half * 2048; }
__device__ __forceinline__ int crow(int r, int hi) { return (r & 3) + 8 * (r >> 2) + 4 * hi; }
typedef __bf16 bf16x2_t __attribute__((ext_vector_type(2)));
__device__ __forceinline__ unsigned cvtpk(float lo, float hi) { const float __attribute__((ext_vector_type(2))) v = {lo, hi}; const bf16x2_t b = __builtin_convertvector(v, bf16x2_t); return __builtin_bit_cast(unsigned, b); }
__device__ __forceinline__ bf16x8 load8(const bf16* p) { return *reinterpret_cast<const bf16x8*>(p); }
__device__ __forceinline__ void partialSM(f32x16& p0, f32x16& p1, float& m_reg, float& mn, float& alpha) {
    float pmax = p0[0]; for (int r = 1; r < 16; ++r) pmax = fmaxf(pmax, p0[r]); for (int r = 0; r < 16; ++r) pmax = fmaxf(pmax, p1[r]);
    { auto rr = __builtin_amdgcn_permlane32_swap(__float_as_uint(pmax), __float_as_uint(pmax), false, false);
      pmax = fmaxf(__uint_as_float(rr[0]), __uint_as_float(rr[1])); }
    if (__builtin_expect(__all((pmax - m_reg) * SCALE <= THR), 1)) { mn = m_reg; alpha = 1.f; }
    else { mn = fmaxf(m_reg, pmax); alpha = __builtin_amdgcn_exp2f((m_reg - mn) * C2); m_reg = mn; }
    const float mnL = -mn * C2;
    for (int r = 0; r < 16; ++r) p0[r] = fmaf(p0[r], C2, mnL); for (int r = 0; r < 16; ++r) p1[r] = fmaf(p1[r], C2, mnL);
    for (int r = 0; r < 16; ++r) p0[r] = __builtin_amdgcn_exp2f(p0[r]);
}
__device__ __forceinline__ void finishSM(f32x16& p0, f32x16& p1, float alpha, float& l_reg, bf16x8& pa0, bf16x8& pa1, bf16x8& pa2, bf16x8& pa3) {
    for (int r = 0; r < 16; ++r) p1[r] = __builtin_amdgcn_exp2f(p1[r]);
    float ps = 0; for (int r = 0; r < 16; ++r) ps += p0[r]; for (int r = 0; r < 16; ++r) ps += p1[r];
    { auto rr = __builtin_amdgcn_permlane32_swap(__float_as_uint(ps), __float_as_uint(ps), false, false);
      ps = __uint_as_float(rr[0]) + __uint_as_float(rr[1]); }
    l_reg = l_reg * alpha + ps;
#define PK4(P, B_, OUT) do { unsigned a0 = cvtpk(P[B_+0], P[B_+1]), a1 = cvtpk(P[B_+2], P[B_+3]);                          \
        unsigned b0 = cvtpk(P[B_+4], P[B_+5]), b1 = cvtpk(P[B_+6], P[B_+7]);                                             \
        auto r0 = __builtin_amdgcn_permlane32_swap(a0, b0, false, false); auto r1 = __builtin_amdgcn_permlane32_swap(a1, b1, false, false); \
        u32x4 w = {r0[0], r1[0], r0[1], r1[1]}; OUT = *reinterpret_cast<bf16x8*>(&w); } while (0)
    PK4(p0, 0, pa0); PK4(p0, 8, pa1); PK4(p1, 0, pa2); PK4(p1, 8, pa3);
#undef PK4
}
template <int KB>
__device__ __forceinline__ void qkt(f32x16& p0, f32x16& p1, const char* K_lds, int r32, int hi, const bf16x8* qr, u32x4 wa, u32x4 wb) {
#pragma unroll
    for (int w4 = 0; w4 < 4; ++w4) {
        const f32x2 a0 = __builtin_amdgcn_cvt_pk_f32_bf8((int)wa[w4], false), a1 = __builtin_amdgcn_cvt_pk_f32_bf8((int)wa[w4], true);
        const f32x2 b0 = __builtin_amdgcn_cvt_pk_f32_bf8((int)wb[w4], false), b1 = __builtin_amdgcn_cvt_pk_f32_bf8((int)wb[w4], true);
        p0[4 * w4] = a0.x; p0[4 * w4 + 1] = a0.y; p0[4 * w4 + 2] = a1.x; p0[4 * w4 + 3] = a1.y;
        p1[4 * w4] = b0.x; p1[4 * w4 + 1] = b0.y; p1[4 * w4 + 2] = b1.x; p1[4 * w4 + 3] = b1.y;
    }
    const char* kb[4];
#pragma unroll
    for (int dd = 0; dd < 4; ++dd) kb[dd] = K_lds + KB * SHM_K + KSWZ(r32, (dd * 16 + hi * 8) * 2);
#pragma unroll
    for (int d0 = 0; d0 < 8; ++d0) { const char* a = kb[d0 & 3] + (d0 >> 2) * 128;
        bf16x8 b0 = *reinterpret_cast<const bf16x8*>(a);
        bf16x8 b1 = *reinterpret_cast<const bf16x8*>(a + 32 * 256);
        p0 = __builtin_amdgcn_mfma_f32_32x32x16_bf16(b0, qr[d0], p0, 0, 0, 0);
        p1 = __builtin_amdgcn_mfma_f32_32x32x16_bf16(b1, qr[d0], p1, 0, 0, 0); }
}
template <int VB>
__device__ __forceinline__ void pv_tile(f32x16* o, int vb0, bf16x8 pa0, bf16x8 pa1, bf16x8 pa2, bf16x8 pa3) {
#define TRRD(dst, off) asm volatile("ds_read_b64_tr_b16 %0, %1 offset:%2" : "=&v"(dst) : "v"(vb0), "i"(off) : "memory")
#define PV_D0(d0) do { s16x4 l0, l1, l2, l3, h0, h1, h2, h3; constexpr int b_ = VB * SHM_V + v_rd_off(d0, 0, 0); \
        TRRD(l0, b_); TRRD(h0, b_ + 2048); TRRD(l1, b_ + 4096); TRRD(h1, b_ + 6144); TRRD(l2, b_ + 8192); TRRD(h2, b_ + 10240); TRRD(l3, b_ + 12288); TRRD(h3, b_ + 14336); \
        asm volatile("s_waitcnt lgkmcnt(0)" ::: "memory"); SBAR();   \
        o[d0] = __builtin_amdgcn_mfma_f32_32x32x16_bf16(pa0, (bf16x8){l0[0], l0[1], l0[2], l0[3], h0[0], h0[1], h0[2], h0[3]}, o[d0], 0, 0, 0);   \
        o[d0] = __builtin_amdgcn_mfma_f32_32x32x16_bf16(pa1, (bf16x8){l1[0], l1[1], l1[2], l1[3], h1[0], h1[1], h1[2], h1[3]}, o[d0], 0, 0, 0);   \
        o[d0] = __builtin_amdgcn_mfma_f32_32x32x16_bf16(pa2, (bf16x8){l2[0], l2[1], l2[2], l2[3], h2[0], h2[1], h2[2], h2[3]}, o[d0], 0, 0, 0);   \
        o[d0] = __builtin_amdgcn_mfma_f32_32x32x16_bf16(pa3, (bf16x8){l3[0], l3[1], l3[2], l3[3], h3[0], h3[1], h3[2], h3[3]}, o[d0], 0, 0, 0); } while (0)
    PV_D0(0); PV_D0(1); PV_D0(2); PV_D0(3);
#undef PV_D0
#undef TRRD
}
struct BlockRef { int P0, j_lo, j_hi; int uid, pid; unsigned* cnt; unsigned* ycnt; };
struct Bufs { bf16* YBh; const char* Qh; const char* Kh; const char* Vh; const char* Mh0; const char* Mh1; };
__device__ __forceinline__ bf16x8 bload8(__amdgpu_buffer_rsrc_t r, unsigned voff, unsigned soff) { return __builtin_bit_cast(bf16x8, __builtin_amdgcn_raw_buffer_load_b128(r, voff, soff, 0)); }
typedef unsigned u32x2 __attribute__((ext_vector_type(2)));
__device__ __forceinline__ u64 bload_u64(__amdgpu_buffer_rsrc_t r, unsigned voff, unsigned soff) { const u32x2 w = __builtin_amdgcn_raw_buffer_load_b64(r, voff, soff, 0); return (u64)w.x | ((u64)w.y << 32); }
struct Seam { bf16x8 qr[8]; bf16x8 st_v0, st_v1, st_k0, st_k1; };
#define VMW() asm volatile("s_waitcnt vmcnt(0)" ::: "memory")
#define VMWN(n) asm volatile("s_waitcnt vmcnt(%0)" :: "i"(n) : "memory")
#define GLD8(base_, voff_) (*(const bf16x8*)((const char*)(base_) + (size_t)(unsigned)(voff_)))
#define SLOAD_H(k0) do { const char* kb_ = B.Kh + (size_t)(k0) * (PITCH * 2); const char* vb_ = B.Vh + (size_t)(k0) * (PITCH * 2);                    \
                         S.st_v0 = GLD8(vb_, voff); S.st_v1 = GLD8(vb_ + 32 * PITCH * 2, voff); S.st_k0 = GLD8(kb_, voff); S.st_k1 = GLD8(kb_ + 32 * PITCH * 2, voff); } while (0)
#define QLOAD(R_) do { const char* qb_ = B.Qh + (size_t)((R_).P0) * (PITCH * 2); _Pragma("unroll") for (int d0 = 0; d0 < 8; ++d0) S.qr[d0] = GLD8(qb_ + d0 * 32, voffq); } while (0)
#define SWRITE_HK(bf) do { *(bf16x8*)(K_lds + (bf) * SHM_K + kws) = S.st_k0; *(bf16x8*)(K_lds + (bf) * SHM_K + kws + 32 * 256) = S.st_k1; } while (0)
#define SWRITE_HV(bf) do { *(bf16x8*)(V_lds + (bf) * SHM_V + vst0) = S.st_v0; *(bf16x8*)(V_lds + (bf) * SHM_V + vst1) = S.st_v1; } while (0)
#define SWRITE_H(bf) do { SWRITE_HV(bf); SWRITE_HK(bf); } while (0)
__device__ __forceinline__ void prime(const BlockRef& cur, const Bufs& B, char* lds, Seam& S) {
    const int tid = threadIdx.x, wid = __builtin_amdgcn_readfirstlane(tid >> 6), lane = tid & 63, r32 = lane & 31, hi = lane >> 5;
    const int sr = tid >> 4, sc = (tid & 15) * 8, kws = KSWZ(sr, sc * 2); char* K_lds = lds + 2 * SHM_V;
    const unsigned voff = (unsigned)(sr * PITCH + sc) * 2u, voffq = (unsigned)((wid * QBLK + r32) * PITCH + hi * 8) * 2u;
    const int kb0 = cur.j_lo * KVBLK;
    QLOAD(cur);
    SLOAD_H(kb0); VMW(); SWRITE_HK(0);
    __syncthreads();
}
__device__ __forceinline__ void block(const BlockRef& cur, const BlockRef& nxt, const Bufs& B, float* PART, f32x2* ML, char* lds, Seam& S) {
    const int tid = threadIdx.x, wid = __builtin_amdgcn_readfirstlane(tid >> 6), lane = tid & 63, r32 = lane & 31, hi = lane >> 5;
    const int j_lo = cur.j_lo, NT = cur.j_hi - cur.j_lo;
    const int kbn = nxt.j_lo * KVBLK;
    char* V_lds = lds; char* K_lds = lds + 2 * SHM_V;
    float* ws = (float*)(lds + 2 * SHM_V + 2 * SHM_K) + wid * 64; float* li_l = ws, * al_l = ws + 32;
    float m_reg = -1e30f, l_reg = 0; f32x16 o[4] = {};
    const int sr = tid >> 4, sc = (tid & 15) * 8, vst0 = v_st(sr, sc), vst1 = v_st(32 + sr, sc), kws = KSWZ(sr, sc * 2);
    const int vb0 = (int)(uintptr_t)V_lds + v_rd_base(lane);
    const unsigned voff = (unsigned)(sr * PITCH + sc) * 2u, voffq = (unsigned)((wid * QBLK + r32) * PITCH + hi * 8) * 2u;
    const unsigned voffm = (unsigned)((wid * QBLK + r32) * 64 + hi * 32);
#define MBASE(t) (((j_lo + (t)) < 64 ? B.Mh0 : B.Mh1) + (size_t)(j_lo + (t)) * 524288u + (size_t)cur.P0 * 64u)
#define MLOAD(WA, WB, t) do { const char* mb_ = MBASE(t); WA = *(const u32x4*)(mb_ + (size_t)voffm); WB = *(const u32x4*)(mb_ + 16 + (size_t)voffm); } while (0)
#define RESC(a) do { if (__any((a) < 1.f)) { if (hi == 0) al_l[r32] = (a); asm volatile("s_waitcnt lgkmcnt(0)" ::: "memory");              \
                     for (int d_ = 0; d_ < 4; ++d_) for (int r = 0; r < 16; ++r) o[d_][r] *= al_l[crow(r, hi)]; } } while (0)
#define KBASE(t) ((j_lo + (t)) * KVBLK)
    constexpr int NQL = 8;
#define SEAM_K0() do { VMWN(NQL); SWRITE_HK(0); SBAR(); } while (0)
    f32x16 pA0, pA1, pB0, pB1; float mnA, mnB, alA, alB; bf16x8 pa0, pa1, pa2, pa3;
    u32x4 wcA, wcB, wnA = {0u, 0u, 0u, 0u}, wnB = {0u, 0u, 0u, 0u}; MLOAD(wcA, wcB, 0);
    SWRITE_HV(0); SBAR();
    if (NT > 1) { SLOAD_H(KBASE(1)); MLOAD(wnA, wnB, 1); }
    SBAR(); qkt<0>(pA0, pA1, K_lds, r32, hi, S.qr, wcA, wcB);
    partialSM(pA0, pA1, m_reg, mnA, alA);
    if (NT > 1) { VMW(); SWRITE_H(1); }
    __syncthreads();
#define HALF_STEP(PX0, PX1, mnX, alX, PY0, PY1, alY, t, KB, VB, SB) do {                                                      \
        wcA = wnA; wcB = wnB;                                                                                                 \
        SBAR(); qkt<KB>(PX0, PX1, K_lds, r32, hi, S.qr, wcA, wcB);                                                           \
        finishSM(PY0, PY1, alY, l_reg, pa0, pa1, pa2, pa3); SBAR();                                                           \
        if ((t) + 1 < NT) { SLOAD_H(KBASE((t) + 1)); MLOAD(wnA, wnB, (t) + 1); SBAR(); }               \
        pv_tile<VB>(o, vb0, pa0, pa1, pa2, pa3); partialSM(PX0, PX1, m_reg, mnX, alX);                                        \
        __syncthreads();                                                                                                      \
        if ((t) + 1 < NT) { VMW(); SWRITE_H(SB); }                                                                            \
        RESC(alX); __syncthreads(); } while (0)
    for (int t = 1; t + 1 < NT; t += 2) {
        HALF_STEP(pB0, pB1, mnB, alB, pA0, pA1, alA, t, 1, 0, 0);
        HALF_STEP(pA0, pA1, mnA, alA, pB0, pB1, alB, t + 1, 0, 1, 1);
    }
    const bool even = (NT & 1) == 0;
    if (even) { wcA = wnA; wcB = wnB; SBAR(); qkt<1>(pB0, pB1, K_lds, r32, hi, S.qr, wcA, wcB); SBAR(); }
    SLOAD_H(kbn); SBAR();
    QLOAD(nxt);
    SBAR();
    finishSM(pA0, pA1, alA, l_reg, pa0, pa1, pa2, pa3); SBAR();
    pv_tile<0>(o, vb0, pa0, pa1, pa2, pa3);
    if (even) { partialSM(pB0, pB1, m_reg, mnB, alB); __syncthreads(); RESC(alB);
        finishSM(pB0, pB1, alB, l_reg, pa0, pa1, pa2, pa3); SBAR(); pv_tile<1>(o, vb0, pa0, pa1, pa2, pa3); }
    SBAR(); SEAM_K0();
    {
        u32x4* po = (u32x4*)(PART + ((size_t)cur.uid * NW + wid) * 2048) + lane;
#pragma unroll
        for (int d0 = 0; d0 < 4; ++d0)
#pragma unroll
            for (int j = 0; j < 2; ++j) po[(d0 * 2 + j) * 64] = (u32x4){cvtpk(o[d0][8 * j], o[d0][8 * j + 1]), cvtpk(o[d0][8 * j + 2], o[d0][8 * j + 3]), cvtpk(o[d0][8 * j + 4], o[d0][8 * j + 5]), cvtpk(o[d0][8 * j + 6], o[d0][8 * j + 7])};
        ML[((size_t)cur.uid * NW + wid) * 64 + lane] = (f32x2){m_reg, l_reg};
    }
    VMW();
    __syncthreads();
    unsigned* flag = (unsigned*)(lds + 2 * SHM_V + 2 * SHM_K + NW * 64 * 4);
    if (tid == 0) {
        __builtin_amdgcn_fence(__ATOMIC_RELEASE, "agent");
        asm volatile("s_waitcnt vmcnt(0)" ::: "memory");
        const unsigned old = __hip_atomic_fetch_add(cur.cnt, 1u, __ATOMIC_RELAXED, __HIP_MEMORY_SCOPE_AGENT);
        if (old == 1u) { __builtin_amdgcn_fence(__ATOMIC_ACQUIRE, "agent"); asm volatile("s_waitcnt vmcnt(0)" ::: "memory"); }
        *flag = old;
    }
    asm volatile("s_waitcnt lgkmcnt(0)" ::: "memory");
    __syncthreads();
    const bool last = (*(volatile unsigned*)flag) == 1u;
    if (last) {
        const f32x2 ml2 = ML[((size_t)cur.pid * NW + wid) * 64 + lane];
        const float m2 = ml2.x, l2 = ml2.y, mm = fmaxf(m_reg, m2);
        const float a1 = __builtin_amdgcn_exp2f((m_reg - mm) * C2), a2 = __builtin_amdgcn_exp2f((m2 - mm) * C2);
        const float linv = __builtin_amdgcn_rcpf(__fadd_rn(__fmul_rn(l_reg, a1), __fmul_rn(l2, a2)));
        if (hi == 0) { li_l[r32] = a1 * linv; al_l[r32] = a2 * linv; }
        asm volatile("s_waitcnt lgkmcnt(0)" ::: "memory");
        float o2[64];
        { const u32x4* pp = (const u32x4*)(PART + ((size_t)cur.pid * NW + wid) * 2048) + lane;
        u32x4 t8[8];
#pragma unroll
        for (int i = 0; i < 8; ++i) t8[i] = pp[i * 64];
#pragma unroll
        for (int d0 = 0; d0 < 4; ++d0)
#pragma unroll
            for (int j = 0; j < 2; ++j) { const u32x4 w = t8[d0 * 2 + j]; const unsigned ww[4] = {w.x, w.y, w.z, w.w};
#pragma unroll
                for (int e = 0; e < 4; ++e) { o2[(8 * j + 2 * e) * 4 + d0] = __uint_as_float(ww[e] << 16); o2[(8 * j + 2 * e + 1) * 4 + d0] = __uint_as_float(ww[e] & 0xffff0000u); } } }
#pragma unroll
        for (int r = 0; r < 16; ++r) { const int orow = crow(r, hi); const float f1 = li_l[orow], f2 = al_l[orow];
#pragma unroll
            for (int d0 = 0; d0 < 4; ++d0) { const unsigned pk = cvtpk(o[d0][r & ~1], o[d0][r | 1]); const float os = __uint_as_float((r & 1) ? (pk & 0xffff0000u) : (pk << 16));
                o2[r * 4 + d0] = __fadd_rn(__fmul_rn(os, f1), __fmul_rn(o2[r * 4 + d0], f2)); } }
        const unsigned vo = (unsigned)(hi * 4 * PITCH + r32) * 2u, so = (unsigned)(cur.P0 + wid * QBLK) * (PITCH * 2);
#pragma unroll
        for (int r = 0; r < 16; ++r)
#pragma unroll
            for (int d0 = 0; d0 < 4; ++d0) { const float v = o2[r * 4 + d0]; const float vn = __shfl_xor(v, 1);
                if ((r32 & 1) == 0) __hip_atomic_store((unsigned*)((char*)B.YBh + (size_t)(so + ((r & 3) + 8 * (r >> 2)) * (PITCH * 2) + d0 * 64) + vo), cvtpk(v, vn), __ATOMIC_RELAXED, __HIP_MEMORY_SCOPE_AGENT); }
        asm volatile("s_waitcnt vmcnt(0)" ::: "memory");
    }
    __syncthreads();
    if (last && tid == 0) __hip_atomic_fetch_add(cur.ycnt, 1u, __ATOMIC_RELAXED, __HIP_MEMORY_SCOPE_AGENT);
#undef RESC
#undef KBASE
#undef SEAM_K0
#undef HALF_STEP
#undef MLOAD
#undef MBASE
}
#undef QLOAD
#undef GLD8
#undef VMW
#undef VMWN
#undef SLOAD_H
#undef SWRITE_HK
#undef SWRITE_HV
#undef SWRITE_H
#undef KSWZ
#undef SBAR
}
struct Args { const float* in[24]; float* out; unsigned char* ws; int ph_lo, ph_hi, li, pad; };
__global__ void __launch_bounds__(NWAVES * 64, 2) skel_fwd(Args args) {
    extern __shared__ __attribute__((aligned(16))) unsigned char lds[];
    Frame F;
    F.lds = (LAS unsigned char*)lds;
    F.MISC = (volatile LAS unsigned*)(F.lds + MISC_OFF);
    F.tid = threadIdx.x; F.lane = F.tid & 63; F.wave = __builtin_amdgcn_readfirstlane(F.tid >> 6);
    F.G = gridDim.x; { const int bx = blockIdx.x; F.vcu = (F.G % 8 == 0) ? (bx % 8) * (F.G / 8) + bx / 8 : bx; }
#pragma unroll
    for (int i = 0; i < 24; ++i) F.in[i] = args.in[i];
    F.out = args.out; F.ws = args.ws;
    F.ctl = (gu32*)(args.ws + WS_CTL);
    for (int u = F.tid; u < (LDS_BYTES - LDSCTL_OFF) / 4; u += NWAVES * 64) ((LAS unsigned*)(F.lds + LDSCTL_OFF))[u] = 0u;
    __syncthreads();
    XcdBarrier bar; bar.bar = (unsigned*)(F.ctl + CW_BAR); bar.x = 0; bar.st = nullptr;
    if (N_LAUNCHES == 1) bar = xcd_barrier_post((unsigned*)(F.ctl + CW_BAR), F.MISC + 8);
#define GRID_BAR() do { if (N_LAUNCHES == 1) xcd_barrier(bar); } while (0)
    const int lo = args.ph_lo, hi = args.ph_hi;
#define IN(k) (lo <= (k) && (k) < hi)
#define BOTH(k) (IN(k) && IN((k) + 1))
    unsigned char* ws = args.ws;
    const float* cosA = (const float*)(ws + WS_COSA); const float* sinA = (const float*)(ws + WS_SINA); const float* cosI = (const float*)(ws + WS_COSI); const float* sinI = (const float*)(ws + WS_SINI);

    if (IN(0)) { p0_prologue(F); }
    if (IN(1)) { p1_prenorm(F); if (BOTH(1)) GRID_BAR(); }
    if (IN(2)) {
        pg8::Gemm g{(const pg8::bf16_t*)(ws + WS_H), (const pg8::bf16_t*)(ws + WS_WIN), S, NPROJ, D}; pg8::StaticOrder So; So.init(S, NPROJ, F.G, (int)blockIdx.x);
        pg8::EpiProj E{(pg8::bf16_t*)(ws + WS_U), (pg8::bf16_t*)(ws + WS_VG), (pg8::bf16_t*)(ws + WS_QLAT), (pg8::bf16_t*)(ws + WS_K), (pg8::bf16_t*)(ws + WS_V), (pg8::bf16_t*)(ws + WS_GATE), (pg8::bf16_t*)(ws + WS_SMALL),
                       (float*)(ws + WS_STATS), (float*)(ws + WS_STATS2), cosA, sinA};
        { const int nun = (S / 256) * (NPROJ / 256), rem = nun % F.G;
          if (rem != 0 && (int)blockIdx.x >= rem && (((int)blockIdx.x - rem) & 1) == 0) p_late_convert(F, 0, (int)blockIdx.x - rem, F.G - rem);
          __syncthreads(); }
        pg8::gemm_phase<pg8::EpiProj, pg8::StaticOrder, true, true>(F.lds + RING_OFF, g, So, E);
        { const int nun = (S / 256) * (NPROJ / 256), rem = nun % F.G;
          if (rem != 0 && (int)blockIdx.x >= rem && (((int)blockIdx.x - rem) & 1) == 1) p_late_convert(F, 0, (int)blockIdx.x - rem, F.G - rem); else if (rem == 0) p_late_convert(F, 0, (int)blockIdx.x, F.G); }
        if (BOTH(2)) GRID_BAR();
    }
    if (IN(3)) {
        pg8::Gemm g{(const pg8::bf16_t*)(ws + WS_QLAT), (const pg8::bf16_t*)(ws + WS_WQQ), S, 2048, QL}; pg8::StaticOrder So; So.init(S, 2048, F.G, (int)blockIdx.x);
        LAS float* rt = (LAS float*)(F.lds + AUX_OFF);
        { pg8::Unit u0; if (So.next(0, u0)) p3_rt(F, u0.pm, rt); }
        LDS_WAIT(); __syncthreads();
        pg8::EpiQ E{(pg8::bf16_t*)(ws + WS_Q), (pg8::bf16_t*)(ws + WS_QIDX), (const PG8_LAS float*)rt, cosA, sinA, cosI, sinI, 1.0f};
        pg8::gemm_phase<pg8::EpiQ, pg8::StaticOrder, true, true>(F.lds + RING_OFF, g, So, E);
        __syncthreads();
        { SpatialW Wm; p3_spatial_load(F, F.vcu & 7, Wm);
          for (int it = F.vcu; it < 512; it += F.G) p3_spatial_item(F, it >> 3, it & 7, Wm); }
        p3_kidx(F);
        if (BOTH(3)) GRID_BAR();
    }
    if (IN(4)) {
        const float kmax = idx_kmax(F);
        {
            X8Regs R;
#define P4_ITEM(rr_) ((rr_) * F.G + (((rr_) & 1) ? (F.G - 1 - F.vcu) : F.vcu))
            if (P4_ITEM(0) < S / 8) { x8_prefetch(F, 8 * P4_ITEM(0), R); x8_stage_wq(F, 8 * P4_ITEM(0)); }
            x8_zero_hist(F); LDS_WAIT(); __syncthreads();
            for (int rr = 0; rr * F.G < S / 8; ++rr) { const int it = P4_ITEM(rr), itn = P4_ITEM(rr + 1); if (it < S / 8) x8_item(F, 8 * it, (itn < S / 8) ? 8 * itn : 8 * it, kmax, R); }
#undef P4_ITEM
        }
        asm volatile("s_waitcnt vmcnt(0)" ::: "memory"); __syncthreads();
        if (F.tid == 0) { for (int rr = 0; rr * F.G < S / 8; ++rr) { const int it = rr * F.G + ((rr & 1) ? (F.G - 1 - F.vcu) : F.vcu);
            if (it < S / 8) __hip_atomic_fetch_add((unsigned*)(ws + WS_CTL) + CW_MASKCNT + 64 * (it >> 5), 1u, __ATOMIC_RELAXED, __HIP_MEMORY_SCOPE_AGENT); } }
    }
    if (IN(5)) {
        const int v = F.vcu & 255, h = v >> 5, i = v & 31, a = i & 15, zz = i >> 4;
        const att::bf16* Qb = (const att::bf16*)(ws + WS_Q); const att::bf16* Kb = (const att::bf16*)(ws + WS_K); const att::bf16* Vb = (const att::bf16*)(ws + WS_V); att::bf16* YB = (att::bf16*)(ws + WS_YB);
        att::BlockRef u0, u1;
#define MKREF(R, x_) do { const int x = (x_); R.P0 = 256 * x; const int half = 2 * (x + 1); R.j_lo = zz * half; R.j_hi = R.j_lo + half; R.uid = (h * 32 + x) * 2 + zz; R.pid = R.uid ^ 1; \
        R.cnt = (unsigned*)(F.ctl + CW_ATT) + (h * 32 + x) * 64; R.ycnt = (unsigned*)(ws + WS_CTL) + CW_YBCNT + 32 * x; } while (0)
        MKREF(u0, a); MKREF(u1, 31 - a);
#undef MKREF
        att::Bufs B;
        B.YBh = YB + h * 128;
        B.Qh = (const char*)(Qb + h * 128); B.Kh = (const char*)(Kb + h * 128); B.Vh = (const char*)(Vb + h * 128); B.Mh0 = (const char*)(ws + WS_MASKB0); B.Mh1 = (const char*)(ws + WS_MASKB1) - (size_t)64 * 524288;
        att::Seam Sm;
        float* PART = F.out; att::f32x2* ML = (att::f32x2*)(ws + WS_WIN);
#define MASK_WAIT(x_) do { if (F.wave == 0) { unsigned sp_ = 0u; unsigned* c_ = (unsigned*)(ws + WS_CTL) + CW_MASKCNT + 64 * (x_); \
            while ((unsigned)__builtin_amdgcn_readfirstlane(__hip_atomic_load(c_, __ATOMIC_RELAXED, __HIP_MEMORY_SCOPE_AGENT)) < 32u) { __builtin_amdgcn_s_sleep(2); if (++sp_ > (1u << 24)) break; } \
            __builtin_amdgcn_fence(__ATOMIC_ACQUIRE, "agent"); } \
            asm volatile("s_waitcnt vmcnt(0) lgkmcnt(0)" ::: "memory"); __syncthreads(); } while (0)
        { MASK_WAIT(a);
        att::prime(u0, B, (char*)lds + RING_OFF, Sm);
        att::block(u0, u1, B, PART, ML, (char*)lds + RING_OFF, Sm);
        MASK_WAIT(31 - a);
        att::block(u1, u1, B, PART, ML, (char*)lds + RING_OFF, Sm); }
#undef MASK_WAIT
    }
    if (IN(6)) {
        pg8::Gemm g{(const pg8::bf16_t*)(ws + WS_U), (const pg8::bf16_t*)(ws + WS_WPA), S, D, GW, (const pg8::bf16_t*)(ws + WS_YB), (const pg8::bf16_t*)(ws + WS_WPB)};
        pg8::PairOrder So; So.init(S, D, F.G, (int)blockIdx.x);
        { pg8::Unit u0; if (So.next(0, u0)) { if (F.wave == 0) { unsigned sp_ = 0u; unsigned* c_ = (unsigned*)(ws + WS_CTL) + CW_YBCNT + 32 * u0.pm;
              while ((unsigned)__builtin_amdgcn_readfirstlane(__hip_atomic_load(c_, __ATOMIC_RELAXED, __HIP_MEMORY_SCOPE_AGENT)) < 8u) { __builtin_amdgcn_s_sleep(2); if (++sp_ > (1u << 24)) break; }
              __builtin_amdgcn_fence(__ATOMIC_ACQUIRE, "agent"); } }
          asm volatile("s_waitcnt vmcnt(0) lgkmcnt(0)" ::: "memory"); __syncthreads(); }
        pg8::EpiGate2 E{(const pg8::bf16_t*)(ws + WS_GATE), (pg8::bf16_t*)(F.out + (size_t)8 * 1024 * 1024)};
        pg8::gemm_phase<pg8::EpiGate2, pg8::PairOrder, true, true>(F.lds + RING_OFF, g, So, E);
    }
    if (IN(7)) { if (BOTH(7)) GRID_BAR(); }
    if (IN(8)) {
        pg8::Gemm g{(const pg8::bf16_t*)(F.out + (size_t)8 * 1024 * 1024), (const pg8::bf16_t*)(ws + WS_WOUT), S, D, D}; pg8::StaticOrder So; So.init(S, D, F.G, (int)blockIdx.x);
        const float* mod = (const float*)(ws + WS_MOD); float* xch = (float*)(ws + WS_XCH); unsigned* xc = (unsigned*)(F.ctl + CW_XCH);
        pg8::RowSq st1{xch, xc, (unsigned*)(F.ctl + CW_TMO), NORM_EPS}, st2{xch + (size_t)S * 8, xc + 32 * 64, (unsigned*)(F.ctl + CW_TMO), NORM_EPS};
        pg8::EpiMixNorm E{F.in[0], (pg8::bf16_t*)(ws + WS_F2), (pg8::bf16_t*)(ws + WS_F), mod + 2 * D, F.in[5], F.in[19], mod + 4 * D, mod + 3 * D, st1, st2};
        pg8::gemm_phase<pg8::EpiMixNorm, pg8::StaticOrder, false, true>(F.lds + RING_OFF, g, So, E);
        if (BOTH(8)) GRID_BAR();
    }
    if (IN(10)) {
        pg8::Gemm g{(const pg8::bf16_t*)(ws + WS_F), (const pg8::bf16_t*)(ws + WS_WGU), S, 2 * FF, D}; pg8::StaticOrder So; So.init(S, 2 * FF, F.G, (int)blockIdx.x);
        pg8::EpiSwiGLU E{(pg8::bf16_t*)(ws + WS_ACT), FF};
        { const int nun = (S / 256) * (2 * FF / 256), rem = nun % F.G;
          if (rem != 0 && (int)blockIdx.x >= rem && (((int)blockIdx.x - rem) & 1) == 0) { p_late_convert(F, 1, (int)blockIdx.x - rem, F.G - rem); __syncthreads(); p_mod_strips(F, MOD_P10 + (((int)blockIdx.x - rem) >> 1), 256, F.G); }
          __syncthreads(); }
        pg8::gemm_phase<pg8::EpiSwiGLU, pg8::StaticOrder, true, true>(F.lds + RING_OFF, g, So, E);
        { const int nun = (S / 256) * (2 * FF / 256), rem = nun % F.G;
          if (rem != 0 && (int)blockIdx.x >= rem && (((int)blockIdx.x - rem) & 1) == 1) p_late_convert(F, 1, (int)blockIdx.x - rem, F.G - rem); else if (rem == 0) p_late_convert(F, 1, (int)blockIdx.x, F.G); }
        if (BOTH(10)) GRID_BAR();
    }
    if (IN(11)) {
        pg8::Gemm g{(const pg8::bf16_t*)(ws + WS_ACT), (const pg8::bf16_t*)(ws + WS_WDOWN), S, D, FF}; pg8::StaticOrder So; So.init(S, D, F.G, (int)blockIdx.x);
        const float* mod = (const float*)(ws + WS_MOD); float* xch = (float*)(ws + WS_XCH) + (size_t)2 * S * 8; unsigned* xc = (unsigned*)(F.ctl + CW_XCH) + 2 * 32 * 64;
        pg8::RowSq st{xch, xc, (unsigned*)(F.ctl + CW_TMO), NORM_EPS};
        pg8::EpiFfnOut E{(const pg8::bf16_t*)(ws + WS_F2), F.out, mod + 5 * D, F.in[20], st};
        pg8::gemm_phase<pg8::EpiFfnOut, pg8::StaticOrder, false, true>(F.lds + RING_OFF, g, So, E);
    }
#undef IN
#undef BOTH
#undef GRID_BAR
}

extern "C" void kernel_launch(void* const* d_in, const int* in_sizes, int n_in, void* d_out, int out_size, void* d_ws, size_t ws_size, hipStream_t stream) {
    static int grid = 0;
    if (grid == 0) {
        if (n_in != 24 || out_size != S * D || ws_size < WS_END) { fprintf(stderr, "kernel_launch: unexpected problem (n_in %d, out %d, ws %zu)\n", n_in, out_size, ws_size); grid = -1; return; }
        if (hipFuncSetAttribute((const void*)skel_fwd, hipFuncAttributeMaxDynamicSharedMemorySize, LDS_BYTES) != hipSuccess) { fprintf(stderr, "kernel_launch: hipFuncSetAttribute failed\n"); grid = -1; return; }
        int dev = 0, cus = 0;
        if (hipGetDevice(&dev) != hipSuccess || hipDeviceGetAttribute(&cus, hipDeviceAttributeMultiprocessorCount, dev) != hipSuccess) { grid = -1; return; }
        (void)hipGetLastError();
        grid = 256;
        if (cus != 256) fprintf(stderr, "kernel_launch: device reports %d CUs; this kernel is built for 256\n", cus);
    }
    if (grid < 0) return;
    if (hipMemsetAsync((char*)d_ws + WS_CTL, 0, CTL_ZERO_BYTES, stream) != hipSuccess) return;
    Args a{};
    for (int i = 0; i < 24; ++i) a.in[i] = (const float*)d_in[i];
    a.out = (float*)d_out; a.ws = (unsigned char*)d_ws;
    if (N_LAUNCHES == 1) {
        a.ph_lo = 0; a.ph_hi = N_PHASES; a.li = 0;
        hipLaunchKernelGGL(skel_fwd, dim3(grid), dim3(NWAVES * 64), LDS_BYTES, stream, a);
    } else {
        for (int p = 0; p < N_PHASES; ++p) { a.ph_lo = p; a.ph_hi = p + 1; a.li = p; hipLaunchKernelGGL(skel_fwd, dim3(grid), dim3(NWAVES * 64), LDS_BYTES, stream, a); }
    }
}
```
